# Optimizing an MI355X kernel written in HIP

```python
import math
import jax, jax.numpy as jnp
from jax import lax
import numpy as np

D_MODEL = 1024
BATCH = 8
SEQ = 2048
DEPTH = 1

CHUNK = 64
D_MIX = D_MODEL

HG_HEADS = 4
HG_DK = 128
HG_DV = 128
HG_WIDTH = HG_HEADS * HG_DV

AT_HEADS = 8
AT_DH = 64
AT_WIDTH = AT_HEADS * AT_DH
Q_RANK = 256
KV_RANK = 128
IDX_HEADS = 4
IDX_DH = 64
TOPK_MAX = 256

IN_SIZES = (
    HG_HEADS * HG_DK,
    HG_HEADS * HG_DK,
    HG_HEADS * HG_DV,
    HG_HEADS * HG_DV,
    Q_RANK,
    KV_RANK,
    IDX_DH,
    IDX_HEADS,
)
D_IN = sum(IN_SIZES)
IN_SPLITS = tuple(int(v) for v in np.cumsum(IN_SIZES)[:-1])

N_EXPERTS = 64
TOP_K = 8
N_GROUPS = 8
TOPK_GROUPS = 4
D_EXPERT = 256
D_SHARED = 256
ROUTED_SCALE = 2.5

ALPHA = (2.0 * DEPTH) ** 0.25
BETA = (8.0 * DEPTH) ** -0.25
LN_EPS = 1e-5
RMS_EPS = 1e-6

kernel_name = "hybrid_hgrn2_dsa_moe_deepnorm"


def layer_norm(x, g, b):
    xf = x.astype(jnp.float32)
    mu = jnp.mean(xf, axis=-1, keepdims=True)
    var = jnp.mean(jnp.square(xf - mu), axis=-1, keepdims=True)
    return ((xf - mu) * lax.rsqrt(var + LN_EPS) * g + b).astype(x.dtype)


def rms_norm(x, g):
    xf = x.astype(jnp.float32)
    return xf * lax.rsqrt(jnp.mean(jnp.square(xf), axis=-1, keepdims=True) + RMS_EPS) * g


def alibi_slopes(n_heads):
    return jnp.exp2(-8.0 * (jnp.arange(n_heads, dtype=jnp.float32) + 1.0) / n_heads)


def hgrn2_mixer(q, f_logit, inp, gate, lb, norm_g):
    B, S, _ = q.shape
    n_c = S // CHUNK

    def heads(t, d):
        return t.reshape(B, n_c, CHUNK, HG_HEADS, d).transpose(0, 3, 1, 2, 4)

    qf = jax.nn.silu(q.astype(jnp.float32))
    f = lb + (1.0 - lb) * jax.nn.sigmoid(f_logit.astype(jnp.float32))
    kf = 1.0 - f
    qh, kh, lfh = heads(qf, HG_DK), heads(kf, HG_DK), heads(jnp.log(f), HG_DK)
    vh = heads(inp.astype(jnp.float32), HG_DV)

    b = jnp.cumsum(lfh, axis=3)
    b_last = b[:, :, :, -1:, :]
    q_dec = qh * jnp.exp(b)
    k_inv = kh * jnp.exp(-b)

    causal = jnp.tril(jnp.ones((CHUNK, CHUNK), dtype=bool))
    scores = jnp.where(causal, jnp.einsum('bhncd,bhnsd->bhncs', q_dec, k_inv), 0.0)
    o_intra = jnp.einsum('bhncs,bhnsv->bhncv', scores, vh)

    d_state = jnp.einsum('bhncd,bhncv->bhndv', kh * jnp.exp(b_last - b), vh)
    chunk_decay = jnp.exp(b_last[:, :, :, 0, :])

    def step(state, xs):
        ds, dec = xs
        return dec[..., None] * state + ds, state

    s0 = jnp.zeros((B, HG_HEADS, HG_DK, HG_DV), jnp.float32)
    _, s_prev = lax.scan(step, s0, (jnp.moveaxis(d_state, 2, 0), jnp.moveaxis(chunk_decay, 2, 0)))
    s_prev = jnp.moveaxis(s_prev, 0, 2)
    o_inter = jnp.einsum('bhncd,bhndv->bhncv', q_dec, s_prev)

    o = (o_intra + o_inter).transpose(0, 2, 3, 1, 4).reshape(B, S, HG_HEADS, HG_DV)
    o = rms_norm(o, norm_g) * jax.nn.silu(gate.astype(jnp.float32).reshape(B, S, HG_HEADS, HG_DV))
    return o.reshape(B, S, HG_WIDTH)


def dsa_mixer(c_q, c_kv, k_idx_raw, w_idx, q_norm_g, w_q_up, w_qidx_up, kv_norm_g, w_kv_up,
              idx_ln_g, idx_ln_b):
    B, S, _ = c_q.shape
    dt = c_q.dtype
    cq = rms_norm(c_q, q_norm_g).astype(dt)
    q = (cq @ w_q_up).reshape(B, S, AT_HEADS, AT_DH)
    q_idx = (cq @ w_qidx_up).reshape(B, S, IDX_HEADS, IDX_DH)
    ckv = rms_norm(c_kv, kv_norm_g).astype(dt)
    kv = ckv @ w_kv_up
    k = kv[..., :AT_WIDTH].reshape(B, S, AT_HEADS, AT_DH)
    v = kv[..., AT_WIDTH:].reshape(B, S, AT_HEADS, AT_DH)
    k_idx = layer_norm(k_idx_raw, idx_ln_g, idx_ln_b)
    w_heads = w_idx.astype(jnp.float32) * (IDX_HEADS ** -0.5) * (IDX_DH ** -0.5)

    k_top = min(TOPK_MAX, S // 4)
    slopes = alibi_slopes(AT_HEADS)
    scale = AT_DH ** -0.5
    key_pos = jnp.arange(S)

    def block(c):
        start = c * CHUNK
        end = start + CHUNK
        qb = lax.dynamic_slice_in_dim(q, start, CHUNK, axis=1)
        qib = lax.dynamic_slice_in_dim(q_idx, start, CHUNK, axis=1)
        wb = lax.dynamic_slice_in_dim(w_heads, start, CHUNK, axis=1)
        logits = jnp.einsum('bcid,bsd->bcis', qib, k_idx, preferred_element_type=jnp.float32)
        idx_score = jnp.einsum('bci,bcis->bcs', wb, jax.nn.relu(logits))
        idx_score = jnp.where(key_pos < end, idx_score, -jnp.inf)
        _, sel = lax.top_k(idx_score, k_top)
        k_sel = jax.vmap(lambda kk, ii: kk[ii])(k, sel)
        v_sel = jax.vmap(lambda vv, ii: vv[ii])(v, sel)
        s = jnp.einsum('bchd,bckhd->bchk', qb, k_sel, preferred_element_type=jnp.float32) * scale
        q_pos = start + jnp.arange(CHUNK)
        dist = jnp.abs(q_pos[None, :, None] - sel).astype(jnp.float32)
        s = s - slopes[None, None, :, None] * dist[:, :, None, :]
        s = jnp.where((sel < end)[:, :, None, :], s, -jnp.inf)
        p = jax.nn.softmax(s, axis=-1)
        return jnp.einsum('bchk,bckhd->bchd', p, v_sel.astype(jnp.float32))

    out = lax.map(block, jnp.arange(S // CHUNK))
    return out.transpose(1, 0, 2, 3, 4).reshape(B, S, AT_WIDTH)


def moe_ffn(x, w_router, router_bias, w_e_gate, w_e_up, w_e_down, w_s_gate, w_s_up, w_s_down):
    B, S, D = x.shape
    t = x.reshape(-1, D)
    T = t.shape[0]
    scores = jax.nn.sigmoid((t @ w_router).astype(jnp.float32))
    sel_scores = scores + router_bias.astype(jnp.float32)
    per_group = N_EXPERTS // N_GROUPS
    grp_score = lax.top_k(sel_scores.reshape(T, N_GROUPS, per_group), 2)[0].sum(-1)
    _, g_idx = lax.top_k(grp_score, TOPK_GROUPS)
    g_mask = jnp.any(g_idx[..., None] == jnp.arange(N_GROUPS), axis=1)
    e_mask = jnp.repeat(g_mask, per_group, axis=1)
    _, e_idx = lax.top_k(jnp.where(e_mask, sel_scores, -jnp.inf), TOP_K)
    w = jnp.take_along_axis(scores, e_idx, axis=1)
    w = w / jnp.sum(w, axis=-1, keepdims=True) * ROUTED_SCALE
    gates = jnp.zeros((T, N_EXPERTS), jnp.float32).at[jnp.arange(T)[:, None], e_idx].set(w)
    gates = gates.astype(t.dtype)

    def expert(acc, xs):
        wg, wu, wd, g = xs
        h = jax.nn.silu(t @ wg) * (t @ wu)
        return acc + g[:, None] * (h @ wd), None

    routed, _ = lax.scan(expert, jnp.zeros_like(t), (w_e_gate, w_e_up, w_e_down, gates.T))
    shared = (jax.nn.silu(t @ w_s_gate) * (t @ w_s_up)) @ w_s_down
    return (routed + shared).reshape(B, S, D)


def setup_inputs(seed: int = 0) -> dict:
    key = jax.random.key(seed)
    ks = jax.random.split(key, 32)
    f32 = jnp.float32
    L = DEPTH

    def nrm(k, shape, s):
        return jax.random.normal(k, shape, f32) * s

    return {
        "x": jax.random.normal(ks[0], (BATCH, SEQ, D_MODEL), f32),
        "w_in": nrm(ks[1], (L, D_MODEL, D_IN), D_MODEL ** -0.5),
        "hg_lb_logits": nrm(ks[2], (DEPTH + 1, HG_HEADS * HG_DK), 0.1),
        "hg_norm_g": 1.0 + nrm(ks[3], (L, HG_DV), 0.02),
        "q_norm_g": 1.0 + nrm(ks[4], (L, Q_RANK), 0.02),
        "w_q_up": nrm(ks[5], (L, Q_RANK, AT_WIDTH), Q_RANK ** -0.5),
        "w_qidx_up": nrm(ks[6], (L, Q_RANK, IDX_HEADS * IDX_DH), Q_RANK ** -0.5),
        "kv_norm_g": 1.0 + nrm(ks[7], (L, KV_RANK), 0.02),
        "w_kv_up": nrm(ks[8], (L, KV_RANK, 2 * AT_WIDTH), KV_RANK ** -0.5),
        "idx_ln_g": 1.0 + nrm(ks[9], (L, IDX_DH), 0.02),
        "idx_ln_b": nrm(ks[10], (L, IDX_DH), 0.02),
        "w_out": nrm(ks[11], (L, D_MIX, D_MODEL), BETA * D_MIX ** -0.5),
        "ln1_g": 1.0 + nrm(ks[12], (L, D_MODEL), 0.02),
        "ln1_b": nrm(ks[13], (L, D_MODEL), 0.02),
        "w_router": nrm(ks[14], (L, D_MODEL, N_EXPERTS), D_MODEL ** -0.5),
        "router_bias": nrm(ks[15], (L, N_EXPERTS), 0.01),
        "w_e_gate": nrm(ks[16], (L, N_EXPERTS, D_MODEL, D_EXPERT), D_MODEL ** -0.5),
        "w_e_up": nrm(ks[17], (L, N_EXPERTS, D_MODEL, D_EXPERT), D_MODEL ** -0.5),
        "w_e_down": nrm(ks[18], (L, N_EXPERTS, D_EXPERT, D_MODEL), BETA * D_EXPERT ** -0.5),
        "w_s_gate": nrm(ks[19], (L, D_MODEL, D_SHARED), D_MODEL ** -0.5),
        "w_s_up": nrm(ks[20], (L, D_MODEL, D_SHARED), D_MODEL ** -0.5),
        "w_s_down": nrm(ks[21], (L, D_SHARED, D_MODEL), BETA * D_SHARED ** -0.5),
        "ln2_g": 1.0 + nrm(ks[22], (L, D_MODEL), 0.02),
        "ln2_b": nrm(ks[23], (L, D_MODEL), 0.02),
    }


def reference(x, w_in, hg_lb_logits, hg_norm_g, q_norm_g, w_q_up, w_qidx_up, kv_norm_g, w_kv_up,
              idx_ln_g, idx_ln_b, w_out, ln1_g, ln1_b, w_router, router_bias, w_e_gate, w_e_up,
              w_e_down, w_s_gate, w_s_up, w_s_down, ln2_g, ln2_b):
    h = x
    lb_all = jnp.cumsum(jax.nn.softmax(hg_lb_logits.astype(jnp.float32), axis=0), axis=0)
    for l in range(DEPTH):
        proj = h @ w_in[l]
        hq, hf, hi, hg, cq, ckv, kidx, widx = jnp.split(proj, IN_SPLITS, axis=-1)
        o_a = hgrn2_mixer(hq, hf, hi, hg, lb_all[l], hg_norm_g[l])
        o_b = dsa_mixer(cq, ckv, kidx, widx, q_norm_g[l], w_q_up[l], w_qidx_up[l], kv_norm_g[l],
                        w_kv_up[l], idx_ln_g[l], idx_ln_b[l])
        mix = jnp.concatenate([o_a.astype(h.dtype), o_b.astype(h.dtype)], axis=-1) @ w_out[l]
        h = layer_norm(ALPHA * h + mix, ln1_g[l], ln1_b[l])
        ffn = moe_ffn(h, w_router[l], router_bias[l], w_e_gate[l], w_e_up[l], w_e_down[l],
                      w_s_gate[l], w_s_up[l], w_s_down[l])
        h = layer_norm(ALPHA * h + ffn, ln2_g[l], ln2_b[l])
    return h
```

```cpp
#include <hip/hip_runtime.h>
#include <cstdint>
#include <cstdio>

#define LAS __attribute__((address_space(3)))
#define GAS __attribute__((address_space(1)))
typedef unsigned short bf16;
typedef short bf16x8 __attribute__((ext_vector_type(8)));
typedef short s16x4 __attribute__((ext_vector_type(4)));
typedef float f32x2 __attribute__((ext_vector_type(2)));
typedef float f32x4 __attribute__((ext_vector_type(4)));
typedef float f32x16 __attribute__((ext_vector_type(16)));
typedef unsigned u32x2 __attribute__((ext_vector_type(2)));
typedef unsigned u32x4 __attribute__((ext_vector_type(4)));
typedef GAS unsigned gu32;
#define RLX_AGENT __ATOMIC_RELAXED, __HIP_MEMORY_SCOPE_AGENT

#ifndef MK_N_LAUNCHES
#define MK_N_LAUNCHES 1
#endif

constexpr int NB = 8, SEQ = 2048, T = NB * SEQ, D = 1024, DIN = 2500, DINP = 2560;
constexpr int NE = 64, NEX = 65  , DE = 256, TOPK = 8;
constexpr int KUP = 384, NUP = 1792;
constexpr float ALPHA = 1.18920711500272f;
constexpr float LOG2E = 1.4426950408889634f;
constexpr int HROWS = 147456 + T;
constexpr int NWAVES = 8, NTHR = 512;

constexpr size_t MiB = 1u << 20;
constexpr size_t WS_CTL = 0, CTL_ZERO_BYTES = 1 * MiB;
constexpr size_t WS_RSQ = 1 * MiB, WS_RSKV = WS_RSQ + 256 * 1024, WS_WH = WS_RSKV + 256 * 1024, WS_DEC = WS_WH + 256 * 1024;
constexpr size_t WS_ROUTE = 2 * MiB + 512 * 1024;
constexpr size_t WS_WUP = 4 * MiB, WS_WOUT = 6 * MiB, WS_MASK = 8 * MiB, WS_KIDX = 12 * MiB, WS_LTOK = 14 * MiB, WS_LW = 18 * MiB;
constexpr size_t WS_XB = 24 * MiB;
constexpr size_t WS_WIN = 56 * MiB, WS_P = 61 * MiB, WS_Q = 141 * MiB, WS_QI = 157 * MiB, WS_K = 165 * MiB, WS_VT = 181 * MiB, WS_DS = 197 * MiB, WS_SP = 229 * MiB;
constexpr size_t WS_WD = 56 * MiB, WS_WGU = 89 * MiB, WS_Y = 89 * MiB, WS_HB = 169 * MiB, WS_END = 249 * MiB;
constexpr int CW_TMO = 0, CW_CNT = 256, CW_BAR = 4096;

constexpr int RING_BYTES = 131072;
constexpr int TAB_OFF = RING_BYTES;
constexpr int MISC_OFF = RING_BYTES + 12288;
constexpr int LDS_BYTES = 147456;

__device__ __forceinline__ unsigned f2bf(float f) { unsigned u = __builtin_bit_cast(unsigned, f); return (u + 0x7fffu + ((u >> 16) & 1u)) >> 16; }
__device__ __forceinline__ unsigned pk2(float lo, float hi) { return f2bf(lo) | (f2bf(hi) << 16); }
__device__ __forceinline__ float bf2f(unsigned h) { return __builtin_bit_cast(float, h << 16); }
__device__ __forceinline__ float bflo(unsigned w) { return __builtin_bit_cast(float, w << 16); }
__device__ __forceinline__ float bfhi(unsigned w) { return __builtin_bit_cast(float, w & 0xffff0000u); }
__device__ __forceinline__ float sigmoidf_(float x) { return 1.0f / (1.0f + __expf(-x)); }
__device__ __forceinline__ float siluf_(float x) { return x / (1.0f + __expf(-x)); }
__device__ __forceinline__ float wave_sum(float v) {
#pragma unroll
    for (int o = 1; o < 64; o <<= 1) v += __shfl_xor(v, o);
    return v;
}
#define LDS_WAIT() asm volatile("s_waitcnt lgkmcnt(0)" ::: "memory")
#define VM_WAIT() asm volatile("s_waitcnt vmcnt(0)" ::: "memory")

namespace pg8 {
constexpr int BM = 256, BK = 64, HALF = 128, HTB = HALF * BK * 2, STAGE_BYTES = 8 * HTB;
__host__ __device__ __forceinline__ int lds_byte(int r, int c) { const int st = (r >> 4) * 2 + (c >> 5), rr = r & 15, cc = c & 31, ob = rr * 64 + cc * 2; return st * 1024 + (ob ^ (((ob >> 9) & 1) << 5)); }
__host__ __device__ __forceinline__ void stage_rc(int b, int& R, int& C) { const int st = b / 1024, sb = b % 1024, swz = sb ^ (((sb >> 9) & 1) << 5); R = (st >> 1) * 16 + swz / 64; C = (st & 1) * 32 + (swz % 64) / 2; }
__host__ __device__ __forceinline__ int perm32(int rho) { const int n = rho >> 4, i = rho & 15; return 8 * (i >> 2) + 4 * n + (i & 3); }

struct Unit { int pm, pn, aux, slot; const char* A; const char* B; };

__device__ __forceinline__ unsigned cvt_pk_bf16(float lo, float hi) { unsigned r; asm volatile("v_cvt_pk_bf16_f32 %0, %1, %2" : "=v"(r) : "v"(lo), "v"(hi)); return r; }

template <class Epi, class Sched, bool GATHER>
__device__ __forceinline__ void gemm_phase(LAS unsigned char* lds, const int K, const int lda, const Sched& S, const Epi& E) {
    const int tid = threadIdx.x, wid = __builtin_amdgcn_readfirstlane(tid >> 6), lane = tid & 63, wr = wid >> 2, wc = wid & 3, fr = lane & 15, fq = lane >> 4;
    const int nt = K / BK;
    int sR[2], sC[2];
    unsigned voffB[2];
#pragma unroll
    for (int i = 0; i < 2; ++i) { stage_rc(tid * 16 + i * 8192, sR[i], sC[i]); const int Rb = Epi::PERM ? ((sR[i] & ~31) + perm32(sR[i] & 31)) : sR[i]; voffB[i] = (unsigned)(Rb * K + sC[i]) * 2u; }
    const size_t kstep = (size_t)(BK * 2);
    const size_t hstepB = (size_t)HALF * K * 2;
    const unsigned ldsw = (unsigned)wid * 1024u;
    const int aoff = lds_byte(wr * 64 + fr, fq * 8), boff = lds_byte(wc * 32 + fr, fq * 8);
#define PG8_SA(b, h) (((b) * 2 + (h)) * HTB)
#define PG8_SB(b, h) ((4 + (b) * 2 + (h)) * HTB)
#define PG8_STAGE(bufoff, gbase, voff) do { _Pragma("unroll") for (int _i = 0; _i < 2; ++_i) \
        __builtin_amdgcn_global_load_lds((const unsigned*)((const char*)(gbase) + (voff)[_i]), (LAS unsigned*)(lds + (bufoff) + ldsw + _i * 8192), 16, 0, 0); } while (0)
#define PG8_LDA(dst, b, h) do { _Pragma("unroll") for (int m = 0; m < 4; ++m) _Pragma("unroll") for (int k = 0; k < 2; ++k) dst[m][k] = *(const LAS bf16x8*)(lds + PG8_SA(b, h) + aoff + m * 2048 + k * 1024); } while (0)
#define PG8_LDB(dst, b, h) do { _Pragma("unroll") for (int n = 0; n < 2; ++n) _Pragma("unroll") for (int k = 0; k < 2; ++k) dst[n][k] = *(const LAS bf16x8*)(lds + PG8_SB(b, h) + boff + n * 2048 + k * 1024); } while (0)
#define PG8_MMA(ai, bj, At, Bt) do { __builtin_amdgcn_s_setprio(1); _Pragma("unroll") for (int m = 0; m < 4; ++m) _Pragma("unroll") for (int n = 0; n < 2; ++n) _Pragma("unroll") for (int k = 0; k < 2; ++k) \
        acc[ai][bj][m][n] = __builtin_amdgcn_mfma_f32_16x16x32_bf16(Bt[n][k], At[m][k], acc[ai][bj][m][n], 0, 0, 0); __builtin_amdgcn_s_setprio(0); } while (0)
#define PG8_WAIT_V(n) asm volatile("s_waitcnt vmcnt(" #n ")" ::: "memory")
#define PG8_WAIT_L(n) asm volatile("s_waitcnt lgkmcnt(" #n ")" ::: "memory")
#define PG8_BAR __builtin_amdgcn_s_barrier()
#define PG8_SCHED __builtin_amdgcn_sched_barrier(0)
#define PG8_AOFF(dst, u) do { _Pragma("unroll") for (int _h = 0; _h < 2; ++_h) _Pragma("unroll") for (int _i = 0; _i < 2; ++_i) { \
        const int _r = _h * HALF + sR[_i]; const int _src = GATHER ? S.row((u), _r) : _r; dst[_h][_i] = (unsigned)(_src * lda + sC[_i]) * 2u; } } while (0)
    Unit cur, nxt; int ui = 0;
    if (!S.next(0, cur)) return;
    f32x4 acc[2][2][4][2];
#pragma unroll
    for (int a = 0; a < 2; ++a)
#pragma unroll
        for (int b = 0; b < 2; ++b)
#pragma unroll
            for (int m = 0; m < 4; ++m)
#pragma unroll
                for (int n = 0; n < 2; ++n) acc[a][b][m][n] = (f32x4){0.f, 0.f, 0.f, 0.f};
    bf16x8 At[4][2], B0[2][2], B1[2][2];
    unsigned vA[2][2], vN[2][2];
    PG8_AOFF(vA, cur);
#pragma unroll
    for (int h = 0; h < 2; ++h)
#pragma unroll
        for (int i = 0; i < 2; ++i) vN[h][i] = vA[h][i];
    const char* cA = cur.A; const char* cB = cur.B;
    PG8_STAGE(PG8_SB(0, 0), cB, voffB); PG8_STAGE(PG8_SB(0, 1), cB + hstepB, voffB); PG8_STAGE(PG8_SA(0, 0), cA, vA[0]); PG8_STAGE(PG8_SA(0, 1), cA, vA[1]);
    if (wr == 1) PG8_BAR;
    PG8_WAIT_V(2); PG8_BAR;
    PG8_STAGE(PG8_SB(1, 0), cB + kstep, voffB); PG8_STAGE(PG8_SA(1, 0), cA + kstep, vA[0]); PG8_STAGE(PG8_SB(1, 1), cB + hstepB + kstep, voffB);
    PG8_WAIT_V(6); PG8_BAR;
    for (;;) {
        const bool has_next = S.next(ui + 1, nxt);
        const char* nA = has_next ? nxt.A : cA; const char* nB = has_next ? nxt.B : cB;
#pragma unroll 1
        for (int t = 0; t < nt; t += 2) {
            const bool last = (t == nt - 2);
            const char* a1 = cA + (size_t)(t + 1) * kstep;
            const char* a2 = last ? nA : cA + (size_t)(t + 2) * kstep; const char* b2 = last ? nB : cB + (size_t)(t + 2) * kstep;
            const char* a3 = a2 + kstep; const char* b3 = b2 + kstep;
            if (last && has_next) { PG8_AOFF(vN, nxt); }
            unsigned w0[2], w1[2];
#pragma unroll
            for (int i = 0; i < 2; ++i) { w0[i] = last ? vN[0][i] : vA[0][i]; w1[i] = last ? vN[1][i] : vA[1][i]; }
            PG8_LDB(B0, 0, 0); PG8_LDB(B1, 0, 1); PG8_SCHED; PG8_LDA(At, 0, 0); PG8_STAGE(PG8_SA(1, 1), a1, vA[1]);
            PG8_WAIT_V(8); PG8_WAIT_L(0); PG8_BAR; PG8_MMA(0, 0, At, B0); PG8_MMA(0, 1, At, B1); PG8_BAR; PG8_SCHED;
            PG8_LDA(At, 0, 1); PG8_STAGE(PG8_SB(0, 0), b2, voffB); PG8_STAGE(PG8_SB(0, 1), b2 + hstepB, voffB); PG8_STAGE(PG8_SA(0, 0), a2, w0);
            PG8_WAIT_V(8); PG8_WAIT_L(0); PG8_BAR; PG8_MMA(1, 0, At, B0); PG8_MMA(1, 1, At, B1); PG8_BAR; PG8_SCHED;
            PG8_LDB(B0, 1, 0); PG8_LDB(B1, 1, 1); PG8_SCHED; PG8_LDA(At, 1, 0); PG8_STAGE(PG8_SA(0, 1), a2, w1);
            PG8_WAIT_V(8); PG8_WAIT_L(0); PG8_BAR; PG8_MMA(0, 0, At, B0); PG8_MMA(0, 1, At, B1); PG8_BAR; PG8_SCHED;
            PG8_LDA(At, 1, 1); PG8_STAGE(PG8_SB(1, 0), b3, voffB); PG8_STAGE(PG8_SB(1, 1), b3 + hstepB, voffB); PG8_STAGE(PG8_SA(1, 0), a3, w0);
            PG8_WAIT_V(8); PG8_WAIT_L(0); PG8_BAR; PG8_MMA(1, 0, At, B0); PG8_MMA(1, 1, At, B1); PG8_BAR; PG8_SCHED;
        }
        if (wr == 0) PG8_BAR;
        E(acc, cur, wr, wc, fr, fq);
        if (!has_next) break;
#pragma unroll
        for (int a = 0; a < 2; ++a)
#pragma unroll
            for (int b = 0; b < 2; ++b)
#pragma unroll
                for (int m = 0; m < 4; ++m)
#pragma unroll
                    for (int n = 0; n < 2; ++n) acc[a][b][m][n] = (f32x4){0.f, 0.f, 0.f, 0.f};
        cur = nxt; cA = nA; cB = nB; ++ui;
#pragma unroll
        for (int h = 0; h < 2; ++h)
#pragma unroll
            for (int i = 0; i < 2; ++i) vA[h][i] = vN[h][i];
        if (wr == 1) PG8_BAR;
    }
    PG8_WAIT_V(0);
    PG8_BAR;
#undef PG8_SA
#undef PG8_SB
#undef PG8_STAGE
#undef PG8_LDA
#undef PG8_LDB
#undef PG8_MMA
#undef PG8_WAIT_V
#undef PG8_WAIT_L
#undef PG8_BAR
#undef PG8_SCHED
#undef PG8_AOFF
}
}

struct DenseSched {
    int nM, nN, nwg, G, c; const char* A; const char* B; size_t tstepA, tstepB;
    __device__ __forceinline__ void init(int M, int N, int K, int lda, const bf16* A_, const bf16* B_, int G_, int c_) { nM = M / 256; nN = N / 256; nwg = nM * nN; G = G_; c = c_; A = (const char*)A_; B = (const char*)B_; tstepA = (size_t)256 * lda * 2; tstepB = (size_t)256 * K * 2; }
    __device__ __forceinline__ bool next(int i, pg8::Unit& u) const {
        const long L = (long)i * G + c; if (L >= nwg) return false;
        int wgid = (int)L; { const int q = nwg / 8, r = nwg % 8, xcd = wgid % 8, off = wgid / 8; wgid = (xcd < r ? xcd * (q + 1) : r * (q + 1) + (xcd - r) * q) + off; }
        const int nig = 8 * nN, gid = wgid / nig, fm = gid * 8, gsz = (nM - fm) < 8 ? (nM - fm) : 8;
        u.pm = fm + ((wgid % nig) % gsz); u.pn = (wgid % nig) / gsz; u.aux = 0; u.slot = i;
        u.A = A + (size_t)u.pm * tstepA; u.B = B + (size_t)u.pn * tstepB; return true;
    }
    __device__ __forceinline__ int row(const pg8::Unit&, int r) const { return r; }
};
constexpr int MOE_MAXU = 8;
struct MoeSched {
    LAS const int* tab; int nunits; const char* A; const char* B; size_t strideA_tile, strideB_e, strideB_pn;
    __device__ __forceinline__ bool next(int i, pg8::Unit& u) const {
        if (i >= nunits) return false;
        const int tile = tab[128 + 4 * i], pn = tab[129 + 4 * i], e = tab[130 + 4 * i];
        u.pm = tile; u.pn = pn; u.aux = e | (tab[131 + 4 * i] << 8); u.slot = i;
        u.A = A + (size_t)tile * strideA_tile; u.B = B + (size_t)e * strideB_e + (size_t)pn * strideB_pn; return true;
    }
    __device__ __forceinline__ int row(const pg8::Unit& u, int r) const { return tab[256 + 256 * u.slot + r]; }
};

using pg8::cvt_pk_bf16;
#define EPI_ARGS const f32x4 (&acc)[2][2][4][2], const pg8::Unit& u, int wr, int wc, int fr, int fq

struct EpiProj {
    static constexpr bool PERM = true;
    bf16* P; float* rsq; float* rskv;
    __device__ __forceinline__ void operator()(EPI_ARGS) const {
        const int row0 = u.pm * 256 + wr * 64 + fr, col0 = u.pn * 256 + wc * 32 + 8 * fq;
#pragma unroll
        for (int ai = 0; ai < 2; ++ai)
#pragma unroll
            for (int m = 0; m < 4; ++m) {
                const int row = row0 + ai * 128 + m * 16; bf16* rowp = P + (size_t)row * DINP + col0;
                float ss0 = 0.f, ss1 = 0.f;
#pragma unroll
                for (int bj = 0; bj < 2; ++bj) { const f32x4 v0 = acc[ai][bj][m][0], v1 = acc[ai][bj][m][1];
                    u32x4 w; w.x = cvt_pk_bf16(v0[0], v0[1]); w.y = cvt_pk_bf16(v0[2], v0[3]); w.z = cvt_pk_bf16(v1[0], v1[1]); w.w = cvt_pk_bf16(v1[2], v1[3]);
                    *(u32x4*)(rowp + bj * 128) = w;
                    const float s = (v0[0] * v0[0] + v0[1] * v0[1]) + (v0[2] * v0[2] + v0[3] * v0[3]) + (v1[0] * v1[0] + v1[1] * v1[1]) + (v1[2] * v1[2] + v1[3] * v1[3]);
                    if (bj == 0) ss0 = s; else ss1 = s; }
                if (u.pn == 8) { float s = ss0 + ss1; s += __shfl_xor(s, 16); s += __shfl_xor(s, 32); if (fq == 0) rsq[row * 4 + wc] = s; }
                if (u.pn == 9) { float s = ss0; s += __shfl_xor(s, 16); s += __shfl_xor(s, 32); if (fq == 0) rskv[row * 4 + wc] = s; }
            }
    }
};
struct EpiUp {
    static constexpr bool PERM = true;
    bf16 *Q, *QI, *Kk, *VT; const float* rsq; const float* rskv;
    __device__ __forceinline__ void operator()(EPI_ARGS) const {
        const int row0 = u.pm * 256 + wr * 64 + fr, cl = wc * 32 + 8 * fq;
        const bool isq = u.pn < 3;
#pragma unroll
        for (int ai = 0; ai < 2; ++ai)
#pragma unroll
            for (int m = 0; m < 4; ++m) {
                const int row = row0 + ai * 128 + m * 16;
                const f32x4 pr = *(const f32x4*)((isq ? rsq : rskv) + row * 4);
                float rs = __builtin_amdgcn_rsqf(((pr[0] + pr[1]) + (pr[2] + pr[3])) * (isq ? (1.0f / 256.0f) : (1.0f / 128.0f)) + 1e-6f);
                if (u.pn < 2) rs *= 0.125f * LOG2E;
#pragma unroll
                for (int bj = 0; bj < 2; ++bj) { const f32x4 v0 = acc[ai][bj][m][0] * rs, v1 = acc[ai][bj][m][1] * rs; const int c = cl + bj * 128;
                    if (u.pn < 5) {
                        u32x4 w; w.x = cvt_pk_bf16(v0[0], v0[1]); w.y = cvt_pk_bf16(v0[2], v0[3]); w.z = cvt_pk_bf16(v1[0], v1[1]); w.w = cvt_pk_bf16(v1[2], v1[3]);
                        bf16* dst = u.pn < 2 ? Q + (size_t)row * 512 + u.pn * 256 + c : (u.pn == 2 ? QI + (size_t)row * 256 + c : Kk + (size_t)row * 512 + (u.pn - 3) * 256 + c);
                        *(u32x4*)dst = w;
                    } else {
                        const int vc = (u.pn - 5) * 256 + c, h = vc >> 6, d = vc & 63, b = row >> 11, t = row & 2047;
                        bf16* dst = VT + ((size_t)(b * 8 + h) * 64 + d) * SEQ + t;
#pragma unroll
                        for (int j = 0; j < 4; ++j) { dst[(size_t)j * SEQ] = (bf16)f2bf(v0[j]); dst[(size_t)(4 + j) * SEQ] = (bf16)f2bf(v1[j]); }
                    } }
            }
    }
};
struct EpiOut {
    static constexpr bool PERM = false;
    const float* x; float* pre;
    __device__ __forceinline__ void operator()(EPI_ARGS) const {
        const int row0 = u.pm * 256 + wr * 64 + fr, col0 = u.pn * 256 + wc * 32 + 4 * fq;
#pragma unroll
        for (int ai = 0; ai < 2; ++ai)
#pragma unroll
            for (int m = 0; m < 4; ++m) { const size_t off = (size_t)(row0 + ai * 128 + m * 16) * D + col0;
#pragma unroll
                for (int bj = 0; bj < 2; ++bj)
#pragma unroll
                    for (int n = 0; n < 2; ++n) { const f32x4 xv = *(const f32x4*)(x + off + bj * 128 + n * 16); *(f32x4*)(pre + off + bj * 128 + n * 16) = xv * ALPHA + acc[ai][bj][m][n]; } }
    }
};
struct EpiGU {
    static constexpr bool PERM = true;
    bf16* H;
    __device__ __forceinline__ void operator()(EPI_ARGS) const {
        const int row0 = u.pm * 256 + wr * 64 + fr, col0 = u.pn * 128 + wc * 32 + 8 * fq;
#pragma unroll
        for (int ai = 0; ai < 2; ++ai)
#pragma unroll
            for (int m = 0; m < 4; ++m) { const f32x4 g0 = acc[ai][0][m][0], g1 = acc[ai][0][m][1], u0 = acc[ai][1][m][0], u1 = acc[ai][1][m][1];
                float h[8];
#pragma unroll
                for (int j = 0; j < 4; ++j) { h[j] = siluf_(g0[j]) * u0[j]; h[4 + j] = siluf_(g1[j]) * u1[j]; }
                u32x4 w; w.x = cvt_pk_bf16(h[0], h[1]); w.y = cvt_pk_bf16(h[2], h[3]); w.z = cvt_pk_bf16(h[4], h[5]); w.w = cvt_pk_bf16(h[6], h[7]);
                *(u32x4*)(H + (size_t)(row0 + ai * 128 + m * 16) * DE + col0) = w; }
    }
};
struct EpiDown {
    static constexpr bool PERM = true;
    bf16* Y; const float* lw;
    __device__ __forceinline__ void operator()(EPI_ARGS) const {
        const int e = u.aux & 255, mt = u.aux >> 8;
        const int lr0 = wr * 64 + fr, col0 = wc * 32 + 8 * fq;
#pragma unroll
        for (int ai = 0; ai < 2; ++ai)
#pragma unroll
            for (int m = 0; m < 4; ++m) { const int lr = lr0 + ai * 128 + m * 16;
                const float wgt = e < NE ? lw[(size_t)e * T + mt * 256 + lr] : 1.0f;
                bf16* rowp = Y + (size_t)(u.pm * 256 + lr) * 256 + col0;
#pragma unroll
                for (int bj = 0; bj < 2; ++bj) { const f32x4 v0 = acc[ai][bj][m][0] * wgt, v1 = acc[ai][bj][m][1] * wgt;
                    u32x4 w; w.x = cvt_pk_bf16(v0[0], v0[1]); w.y = cvt_pk_bf16(v0[2], v0[3]); w.z = cvt_pk_bf16(v1[0], v1[1]); w.w = cvt_pk_bf16(v1[2], v1[3]);
                    *(u32x4*)(rowp + bj * 128) = w; } }
    }
};

__device__ __forceinline__ void tr_item(const float* src, int ldn, int k0, int n0, int nvalid, bf16* dst, int ldk, const float* kscale, LAS float* scr, int lane) {
#pragma unroll 8
    for (int i = 0; i < 32; ++i) { const int kk = 2 * i + (lane >> 5), n = lane & 31; float v = n < nvalid ? src[(size_t)(k0 + kk) * ldn + n0 + n] : 0.f; if (kscale) v *= kscale[k0 + kk]; scr[kk * 33 + n] = v; }
    LDS_WAIT();
    const int c = lane & 7;
#pragma unroll
    for (int j = 0; j < 4; ++j) { const int n = (lane >> 3) + 8 * j; const LAS float* s = scr + (8 * c) * 33 + n;
        u32x4 o; o.x = pk2(s[0 * 33], s[1 * 33]); o.y = pk2(s[2 * 33], s[3 * 33]); o.z = pk2(s[4 * 33], s[5 * 33]); o.w = pk2(s[6 * 33], s[7 * 33]);
        *(u32x4*)(dst + (size_t)n * ldk + 8 * c) = o; }
    LDS_WAIT();
}

struct Ptrs {
    const float* in[24]; float* out; unsigned char* ws;
};

__device__ __forceinline__ void phase_prep(const Ptrs& p, LAS unsigned char* lds, int vcu, int G) {
    const int tid = threadIdx.x, lane = tid & 63, wave = tid >> 6;
    LAS float* scr = (LAS float*)(lds + wave * 16384);
    const int gw = vcu * NWAVES + wave, NGW = G * NWAVES;
    bf16* WIN = (bf16*)(p.ws + WS_WIN); bf16* WUP = (bf16*)(p.ws + WS_WUP); bf16* WOUT = (bf16*)(p.ws + WS_WOUT); bf16* XB = (bf16*)(p.ws + WS_XB);
    constexpr int I_IN = 16 * 80, I_Q = 4 * 16, I_QI = 4 * 8, I_KV = 2 * 32, I_O = 16 * 32, NIT = I_IN + I_Q + I_QI + I_KV + I_O;
    for (int it = gw; it < NIT; it += NGW) {
        int r = it;
        if (r < I_IN) { const int kb = r / 80, nb = r % 80, n0 = nb * 32; int nv = DIN - n0; nv = nv < 0 ? 0 : (nv > 32 ? 32 : nv);
            tr_item(p.in[1], DIN, kb * 64, n0, nv, WIN + (size_t)n0 * D + kb * 64, D, nullptr, scr, lane); continue; } r -= I_IN;
        if (r < I_Q) { const int kb = r / 16, nb = r % 16; tr_item(p.in[5], 512, kb * 64, nb * 32, 32, WUP + (size_t)(nb * 32) * KUP + kb * 64, KUP, p.in[4], scr, lane); continue; } r -= I_Q;
        if (r < I_QI) { const int kb = r / 8, nb = r % 8; tr_item(p.in[6], 256, kb * 64, nb * 32, 32, WUP + (size_t)(512 + nb * 32) * KUP + kb * 64, KUP, p.in[4], scr, lane); continue; } r -= I_QI;
        if (r < I_KV) { const int kb = r / 32, nb = r % 32; tr_item(p.in[8], 1024, kb * 64, nb * 32, 32, WUP + (size_t)(768 + nb * 32) * KUP + 256 + kb * 64, KUP, p.in[7], scr, lane); continue; } r -= I_KV;
        { const int kb = r / 32, nb = r % 32; tr_item(p.in[11], D, kb * 64, nb * 32, 32, WOUT + (size_t)(nb * 32) * D + kb * 64, D, nullptr, scr, lane); }
    }
    const int gt = vcu * NTHR + tid, NGT = G * NTHR;
    for (int ch = gt; ch < NUP * KUP / 8; ch += NGT) { const int r = ch / (KUP / 8), c = (ch % (KUP / 8)) * 8; if (r < 768 ? c >= 256 : c < 256) *(u32x4*)(WUP + (size_t)r * KUP + c) = (u32x4){0u, 0u, 0u, 0u}; }
    const float* x = p.in[0];
    for (int ch = gt; ch < T * D / 8; ch += NGT) { const f32x4 a = *(const f32x4*)(x + (size_t)ch * 8), b = *(const f32x4*)(x + (size_t)ch * 8 + 4);
        u32x4 o; o.x = pk2(a[0], a[1]); o.y = pk2(a[2], a[3]); o.z = pk2(b[0], b[1]); o.w = pk2(b[2], b[3]); *(u32x4*)(XB + (size_t)ch * 8) = o; }
}

__device__ __forceinline__ void phase_convert_experts(const Ptrs& p, LAS unsigned char* lds, int vcu, int G) {
    const int tid = threadIdx.x, lane = tid & 63, wave = tid >> 6;
    LAS float* scr = (LAS float*)(lds + wave * 16384);
    const int gw = vcu * NWAVES + wave, NGW = G * NWAVES;
    bf16* WGU = (bf16*)(p.ws + WS_WGU); bf16* WD = (bf16*)(p.ws + WS_WD);
    for (int it = gw; it < NEX * 384; it += NGW) {
        const int e = it / 384, r = it % 384, which = r / 128, r2 = r % 128;
        if (which < 2) {
            const float* src = e < NE ? p.in[16 + which] + (size_t)e * D * DE : p.in[19 + which];
            const int kb = r2 / 8, nb = r2 % 8, n0 = nb * 32, row0 = (n0 >> 7) * 256 + (n0 & 127) + which * 128;
            tr_item(src, DE, kb * 64, n0, 32, WGU + ((size_t)e * 512 + row0) * D + kb * 64, D, nullptr, scr, lane);
        } else {
            const float* src = e < NE ? p.in[18] + (size_t)e * DE * D : p.in[21];
            const int kb = r2 / 32, nb = r2 % 32;
            tr_item(src, D, kb * 64, nb * 32, 32, WD + ((size_t)e * D + nb * 32) * DE + kb * 64, DE, nullptr, scr, lane);
        }
    }
}

__device__ __forceinline__ void phase_kidx(const Ptrs& p, int vcu, int G) {
    const int tid = threadIdx.x, lane = tid & 63, wave = tid >> 6;
    const bf16* P = (const bf16*)(p.ws + WS_P); bf16* KIDX = (bf16*)(p.ws + WS_KIDX); float* WH = (float*)(p.ws + WS_WH);
    const float g = p.in[9][lane], bb = p.in[10][lane];
    for (int tok = vcu * NWAVES + wave; tok < T; tok += G * NWAVES) {
        const float v = bf2f(P[(size_t)tok * DINP + 2432 + lane]);
        const float mean = wave_sum(v) * (1.0f / 64.0f); const float dv = v - mean;
        const float var = wave_sum(dv * dv) * (1.0f / 64.0f);
        KIDX[(size_t)tok * 64 + lane] = (bf16)f2bf(dv * __builtin_amdgcn_rsqf(var + 1e-5f) * g + bb);
        if (lane < 4) WH[tok * 4 + lane] = bf2f(P[(size_t)tok * DINP + 2496 + lane]) * 0.0625f;
    }
}

constexpr int HG_B = 0, HG_TOT = 32768, HG_VT = 34816, HG_KD = 53248, HG_PART = 71680;
__device__ __forceinline__ float lb_of(const float* lbl, int hd) { return 1.0f / (1.0f + __expf(lbl[512 + hd] - lbl[hd])); }
__device__ __forceinline__ void hgrn_prep(const bf16* P, const float* lbl, int b, int h, int c, LAS unsigned char* lds) {
    const int tid = threadIdx.x;
    LAS float* bc = (LAS float*)(lds + HG_B); LAS float* tot = (LAS float*)(lds + HG_TOT);
    { const int t = tid >> 3, blk = tid & 7; const size_t tok = (size_t)b * SEQ + c * 64 + t;
      const bf16* src = P + tok * DINP + 512 + h * 128 + blk * 16;
      const u32x4 a = *(const u32x4*)src, a2 = *(const u32x4*)(src + 8);
      const unsigned w[8] = {a.x, a.y, a.z, a.w, a2.x, a2.y, a2.z, a2.w};
#pragma unroll
      for (int j = 0; j < 8; ++j) {
          const int d = blk * 16 + 2 * j; const float lb0 = lb_of(lbl, h * 128 + d), lb1 = lb_of(lbl, h * 128 + d + 1);
          bc[t * 128 + d] = __logf(lb0 + (1.0f - lb0) * sigmoidf_(bflo(w[j])));
          bc[t * 128 + d + 1] = __logf(lb1 + (1.0f - lb1) * sigmoidf_(bfhi(w[j]))); } }
    __syncthreads();
    { const int d = tid & 127, part = tid >> 7; float s = 0.f;
#pragma unroll 4
      for (int i = 0; i < 16; ++i) { const int tt = part * 16 + i; s += bc[tt * 128 + d]; bc[tt * 128 + d] = s; }
      tot[part * 128 + d] = s;
      __syncthreads();
      float off = 0.f;
      for (int q = 0; q < part; ++q) off += tot[q * 128 + d];
      if (part > 0) {
#pragma unroll 4
          for (int i = 0; i < 16; ++i) bc[(part * 16 + i) * 128 + d] += off; } }
    __syncthreads();
}
__device__ __forceinline__ void hgrn_stage_vt(const bf16* P, int b, int h, int c, LAS unsigned char* lds) {
    const int tid = threadIdx.x, s = tid >> 3, blk = tid & 7; const size_t tok = (size_t)b * SEQ + c * 64 + s;
    LAS bf16* VT = (LAS bf16*)(lds + HG_VT);
    const bf16* src = P + tok * DINP + 1024 + h * 128 + blk * 16;
    const u32x4 a = *(const u32x4*)src, a2 = *(const u32x4*)(src + 8);
    const unsigned w[8] = {a.x, a.y, a.z, a.w, a2.x, a2.y, a2.z, a2.w};
#pragma unroll
    for (int j = 0; j < 8; ++j) { VT[(blk * 16 + 2 * j) * 72 + s] = (bf16)(w[j] & 0xffffu); VT[(blk * 16 + 2 * j + 1) * 72 + s] = (bf16)(w[j] >> 16); }
}
__device__ __forceinline__ void hgrn1_item(const Ptrs& p, int item, LAS unsigned char* lds) {
    const int tid = threadIdx.x, lane = tid & 63, w = tid >> 6;
    const int c = item & 31, h = (item >> 5) & 3, b = item >> 7;
    const bf16* P = (const bf16*)(p.ws + WS_P); const float* lbl = p.in[2];
    hgrn_prep(P, lbl, b, h, c, lds);
    LAS float* bc = (LAS float*)(lds + HG_B); LAS bf16* KD = (LAS bf16*)(lds + HG_KD); LAS bf16* VT = (LAS bf16*)(lds + HG_VT);
    if (tid < 128) ((float*)(p.ws + WS_DEC))[item * 128 + tid] = __expf(bc[63 * 128 + tid]);
    hgrn_stage_vt(P, b, h, c, lds);
    { const int s = tid >> 3, blk = tid & 7; const size_t tok = (size_t)b * SEQ + c * 64 + s;
      const bf16* src = P + tok * DINP + 512 + h * 128 + blk * 16;
      const u32x4 a = *(const u32x4*)src, a2 = *(const u32x4*)(src + 8);
      const unsigned wv[8] = {a.x, a.y, a.z, a.w, a2.x, a2.y, a2.z, a2.w};
#pragma unroll
      for (int j = 0; j < 16; ++j) { const int d = blk * 16 + j; const float lb = lb_of(lbl, h * 128 + d);
          const float x = (j & 1) ? bfhi(wv[j >> 1]) : bflo(wv[j >> 1]);
          const float k = (1.0f - lb) * (1.0f - sigmoidf_(x));
          KD[d * 72 + s] = (bf16)f2bf(k * __expf(bc[63 * 128 + d] - bc[s * 128 + d])); } }
    __syncthreads();
    bf16* DS = (bf16*)(p.ws + WS_DS) + (size_t)item * 16384;
    { const int cc = lane & 15, g = lane >> 4;
      bf16x8 af[2];
#pragma unroll
      for (int ks = 0; ks < 2; ++ks) af[ks] = *(const LAS bf16x8*)(KD + (16 * w + cc) * 72 + 32 * ks + 8 * g);
#pragma unroll
      for (int vt = 0; vt < 8; ++vt) {
          f32x4 C = {0.f, 0.f, 0.f, 0.f};
#pragma unroll
          for (int ks = 0; ks < 2; ++ks) { const bf16x8 bfm = *(const LAS bf16x8*)(VT + (16 * vt + cc) * 72 + 32 * ks + 8 * g); C = __builtin_amdgcn_mfma_f32_16x16x32_bf16(af[ks], bfm, C, 0, 0, 0); }
          u32x2 o; o.x = pk2(C[0], C[1]); o.y = pk2(C[2], C[3]);
          *(u32x2*)(DS + (size_t)(16 * vt + cc) * 128 + 16 * w + 4 * g) = o; } }
    __syncthreads();
}
__device__ __forceinline__ void phase_scan(const Ptrs& p, int vcu, int G) {
    const bf16* DS = (const bf16*)(p.ws + WS_DS); bf16* SP = (bf16*)(p.ws + WS_SP); const float* DEC = (const float*)(p.ws + WS_DEC);
    for (int gt = vcu * NTHR + threadIdx.x; gt < 32 * 4096; gt += G * NTHR) {
        const int bh = gt >> 12, e4 = gt & 4095, d0 = (e4 & 31) * 4; const size_t eo = (size_t)(e4 >> 5) * 128 + d0;
        float S0 = 0.f, S1 = 0.f, S2 = 0.f, S3 = 0.f;
#pragma unroll 4
        for (int c = 0; c < 32; ++c) { const size_t item = (size_t)bh * 32 + c;
            const u32x2 ds = *(const u32x2*)(DS + item * 16384 + eo); const f32x4 dc = *(const f32x4*)(DEC + item * 128 + d0);
            u32x2 o; o.x = pk2(S0, S1); o.y = pk2(S2, S3); *(u32x2*)(SP + item * 16384 + eo) = o;
            S0 = dc[0] * S0 + bflo(ds.x); S1 = dc[1] * S1 + bfhi(ds.x); S2 = dc[2] * S2 + bflo(ds.y); S3 = dc[3] * S3 + bfhi(ds.y); }
    }
}
__device__ __forceinline__ void hgrn3_item(const Ptrs& p, int item, LAS unsigned char* lds) {
    const int tid = threadIdx.x, lane = tid & 63, w = tid >> 6, cc = lane & 15, g = lane >> 4;
    const int c = item & 31, h = (item >> 5) & 3, b = item >> 7;
    const bf16* P = (const bf16*)(p.ws + WS_P); const float* lbl = p.in[2];
    hgrn_prep(P, lbl, b, h, c, lds);
    hgrn_stage_vt(P, b, h, c, lds);
    __syncthreads();
    LAS float* bc = (LAS float*)(lds + HG_B); LAS bf16* VT = (LAS bf16*)(lds + HG_VT); LAS float* part = (LAS float*)(lds + HG_PART);
    const int tt = w & 3, vh = w >> 2;
    const size_t tok0 = (size_t)b * SEQ + c * 64;
    bf16x8 qd[4];
    { const int t = 16 * tt + cc; const bf16* src = P + (tok0 + t) * DINP + h * 128 + 8 * g;
#pragma unroll
      for (int ks = 0; ks < 4; ++ks) { const u32x4 a = *(const u32x4*)(src + 32 * ks); const unsigned wv[4] = {a.x, a.y, a.z, a.w}; const LAS float* bp = bc + t * 128 + 32 * ks + 8 * g;
          unsigned o[4];
#pragma unroll
          for (int j = 0; j < 4; ++j) o[j] = pk2(siluf_(bflo(wv[j])) * __expf(bp[2 * j]), siluf_(bfhi(wv[j])) * __expf(bp[2 * j + 1]));
          qd[ks] = __builtin_bit_cast(bf16x8, (u32x4){o[0], o[1], o[2], o[3]}); } }
    u32x2 scb[4];
#pragma unroll
    for (int st = 0; st < 4; ++st) {
        scb[st] = (u32x2){0u, 0u};
        if (st <= tt) {
            f32x4 C = {0.f, 0.f, 0.f, 0.f}; const int s = 16 * st + cc; const bf16* src = P + (tok0 + s) * DINP + 512 + h * 128 + 8 * g;
#pragma unroll
            for (int ks = 0; ks < 4; ++ks) { const u32x4 a = *(const u32x4*)(src + 32 * ks); const unsigned wv[4] = {a.x, a.y, a.z, a.w}; const LAS float* bp = bc + s * 128 + 32 * ks + 8 * g;
                unsigned o[4];
#pragma unroll
                for (int j = 0; j < 4; ++j) { const int d = h * 128 + 32 * ks + 8 * g + 2 * j; const float lb0 = lb_of(lbl, d), lb1 = lb_of(lbl, d + 1);
                    o[j] = pk2((1.0f - lb0) * (1.0f - sigmoidf_(bflo(wv[j]))) * __expf(-bp[2 * j]), (1.0f - lb1) * (1.0f - sigmoidf_(bfhi(wv[j]))) * __expf(-bp[2 * j + 1])); }
                C = __builtin_amdgcn_mfma_f32_16x16x32_bf16(__builtin_bit_cast(bf16x8, (u32x4){o[0], o[1], o[2], o[3]}), qd[ks], C, 0, 0, 0); }
#pragma unroll
            for (int i = 0; i < 4; ++i) if (16 * st + 4 * g + i > 16 * tt + cc) C[i] = 0.f;
            scb[st] = (u32x2){pk2(C[0], C[1]), pk2(C[2], C[3])};
        }
    }
    const bf16* SPi = (const bf16*)(p.ws + WS_SP) + (size_t)item * 16384;
    f32x4 o[4]; float ss = 0.f;
#pragma unroll
    for (int vi = 0; vi < 4; ++vi) { const int vt = 4 * vh + vi; f32x4 C = {0.f, 0.f, 0.f, 0.f};
#pragma unroll
        for (int ks = 0; ks < 4; ++ks) { const bf16x8 sp = *(const bf16x8*)(SPi + (size_t)(16 * vt + cc) * 128 + 32 * ks + 8 * g); C = __builtin_amdgcn_mfma_f32_16x16x32_bf16(sp, qd[ks], C, 0, 0, 0); }
#pragma unroll
        for (int kp = 0; kp < 2; ++kp) if (2 * kp <= tt) {
            const u32x2 v0 = *(const LAS u32x2*)(VT + (16 * vt + cc) * 72 + 32 * kp + 4 * g), v1 = *(const LAS u32x2*)(VT + (16 * vt + cc) * 72 + 32 * kp + 16 + 4 * g);
            C = __builtin_amdgcn_mfma_f32_16x16x32_bf16(__builtin_bit_cast(bf16x8, (u32x4){v0.x, v0.y, v1.x, v1.y}), __builtin_bit_cast(bf16x8, (u32x4){scb[2 * kp].x, scb[2 * kp].y, scb[2 * kp + 1].x, scb[2 * kp + 1].y}), C, 0, 0, 0); }
        o[vi] = C; ss += (C[0] * C[0] + C[1] * C[1]) + (C[2] * C[2] + C[3] * C[3]); }
    ss += __shfl_xor(ss, 16); ss += __shfl_xor(ss, 32);
    if (g == 0) part[vh * 64 + 16 * tt + cc] = ss;
    __syncthreads();
    const float rstd = __builtin_amdgcn_rsqf((part[16 * tt + cc] + part[64 + 16 * tt + cc]) * (1.0f / 128.0f) + 1e-6f);
    bf16* OC = (bf16*)(p.ws + WS_XB);
    { const size_t tok = tok0 + 16 * tt + cc;
#pragma unroll
      for (int vi = 0; vi < 4; ++vi) { const int v0 = 16 * (4 * vh + vi) + 4 * g;
          const u32x2 gt = *(const u32x2*)(P + tok * DINP + 1536 + h * 128 + v0); const f32x4 ng = *(const f32x4*)(p.in[3] + v0);
          u32x2 ov; ov.x = pk2(o[vi][0] * rstd * ng[0] * siluf_(bflo(gt.x)), o[vi][1] * rstd * ng[1] * siluf_(bfhi(gt.x)));
          ov.y = pk2(o[vi][2] * rstd * ng[2] * siluf_(bflo(gt.y)), o[vi][3] * rstd * ng[3] * siluf_(bfhi(gt.y)));
          *(u32x2*)(OC + tok * D + h * 128 + v0) = ov; } }
    __syncthreads();
}

constexpr int IX_CNT = 0;
__device__ __forceinline__ void cnt_ge_u32(int& cnt, unsigned a, unsigned b) { asm("v_cmp_ge_u32 vcc, %1, %2\n\tv_addc_co_u32 %0, vcc, 0, %0, vcc" : "+v"(cnt) : "v"(a), "v"(b) : "vcc"); }
__device__ __forceinline__ void cnt_le_u32(int& cnt, unsigned a, unsigned b) { asm("v_cmp_le_u32 vcc, %1, %2\n\tv_addc_co_u32 %0, vcc, 0, %0, vcc" : "+v"(cnt) : "v"(a), "v"(b) : "vcc"); }
__device__ __forceinline__ void cnt_gt_u64(int& cnt, unsigned long long a, unsigned long long b) { asm("v_cmp_gt_u64 vcc, %1, %2\n\tv_addc_co_u32 %0, vcc, 0, %0, vcc" : "+v"(cnt) : "v"(a), "v"(b) : "vcc"); }
__device__ __forceinline__ unsigned ord_u32(float f) { unsigned b = __builtin_bit_cast(unsigned, f); if (b == 0x80000000u) b = 0u; return (b & 0x80000000u) ? ~b : (b | 0x80000000u); }
__device__ __forceinline__ void indexer_item(const Ptrs& p, int item, LAS unsigned char* lds) {
    const int tid = threadIdx.x, lane = tid & 63, w = __builtin_amdgcn_readfirstlane(tid >> 6), q = lane & 15, g = lane >> 4;
    const int b = item >> 7, qg = item & 127, c = qg >> 2, nw = 2 * (c + 1);
    unsigned* MASKT = (unsigned*)(p.ws + WS_MASK) + (size_t)b * 64 * SEQ;
    const int tq = qg * 16 + q;
    if (c < 4) { for (int idx = tid; idx < nw * 16; idx += NTHR) MASKT[(size_t)(idx >> 4) * SEQ + qg * 16 + (idx & 15)] = 0xFFFFFFFFu; return; }
    const bf16* QI = (const bf16*)(p.ws + WS_QI); const bf16* KIDX = (const bf16*)(p.ws + WS_KIDX); const float* WH = (const float*)(p.ws + WS_WH);
    const size_t tokq = (size_t)b * SEQ + tq;
    bf16x8 qf[4][2]; float wq[4];
#pragma unroll
    for (int h = 0; h < 4; ++h) { wq[h] = WH[tokq * 4 + h];
#pragma unroll
        for (int ks = 0; ks < 2; ++ks) qf[h][ks] = *(const bf16x8*)(QI + tokq * 256 + h * 64 + 32 * ks + 8 * g); }
    unsigned u[16][4];
#pragma unroll
    for (int li = 0; li < 8; ++li) { const int kt = w + 8 * li;
#pragma unroll
        for (int hf = 0; hf < 2; ++hf) { const int lt = 2 * li + hf;
            if (kt < nw) {
                const bf16* kp = KIDX + ((size_t)b * SEQ + 32 * kt + 16 * hf + q) * 64 + 8 * g;
                const bf16x8 k0 = *(const bf16x8*)kp, k1 = *(const bf16x8*)(kp + 32);
                float sc[4] = {0.f, 0.f, 0.f, 0.f};
#pragma unroll
                for (int h = 0; h < 4; ++h) { f32x4 C = {0.f, 0.f, 0.f, 0.f};
                    C = __builtin_amdgcn_mfma_f32_16x16x32_bf16(k0, qf[h][0], C, 0, 0, 0); C = __builtin_amdgcn_mfma_f32_16x16x32_bf16(k1, qf[h][1], C, 0, 0, 0);
#pragma unroll
                    for (int i = 0; i < 4; ++i) sc[i] += wq[h] * fmaxf(C[i], 0.f); }
#pragma unroll
                for (int i = 0; i < 4; ++i) u[lt][i] = ord_u32(sc[i]);
            } else {
#pragma unroll
                for (int i = 0; i < 4; ++i) u[lt][i] = 0u;
            } } }
    LAS int* cb = (LAS int*)(lds + IX_CNT);
    LAS int* cb2 = cb + 256; LAS int* flg = cb + 512;
    if (tid < 4) flg[tid] = 0;
    unsigned Tt = 0u; int it = 0;
#pragma unroll 1
    for (int bit = 31; bit >= 0; --bit, ++it) {
        const unsigned cand = Tt | (1u << bit); int cnt = 0;
#pragma unroll
        for (int lt = 0; lt < 16; ++lt)
#pragma unroll
            for (int i = 0; i < 4; ++i) cnt_ge_u32(cnt, u[lt][i], cand);
        cnt += __shfl_xor(cnt, 16); cnt += __shfl_xor(cnt, 32);
        LAS int* bufp = cb + (it & 1) * 128;
        if (g == 0) bufp[w * 16 + q] = cnt;
        __syncthreads();
        int tot = 0;
#pragma unroll
        for (int ww = 0; ww < 8; ++ww) tot += bufp[ww * 16 + q];
        if (tot >= 256) Tt = cand;
    }
    int cgt = 0, ceq = 0;
#pragma unroll
    for (int li = 0; li < 8; ++li)
#pragma unroll
        for (int hf = 0; hf < 2; ++hf)
#pragma unroll
            for (int i = 0; i < 4; ++i) { const unsigned uu = u[2 * li + hf][i]; const unsigned s1 = 1u + (unsigned)(32 * (w + 8 * li) + 16 * hf + 4 * g + i);
                const unsigned e = uu > Tt ? 0u : (uu == Tt ? s1 : 4096u); u[2 * li + hf][i] = e; cgt += (e == 0u) ? 1 : 0; ceq += (e - 1u < 2048u) ? 1 : 0; }
    cgt += __shfl_xor(cgt, 16); cgt += __shfl_xor(cgt, 32); ceq += __shfl_xor(ceq, 16); ceq += __shfl_xor(ceq, 32);
    { LAS int* b1 = cb + (it & 1) * 128; LAS int* b2 = cb2 + (it & 1) * 128; if (g == 0) { b1[w * 16 + q] = cgt; b2[w * 16 + q] = ceq; }
      __syncthreads();
      cgt = 0; ceq = 0;
#pragma unroll
      for (int ww = 0; ww < 8; ++ww) { cgt += b1[ww * 16 + q]; ceq += b2[ww * 16 + q]; }
      ++it; }
    const bool tie = cgt + ceq > 256;
    if (tie) flg[0] = 1;
    __syncthreads();
    unsigned X = 2048u;
    if (flg[0] != 0) {
        unsigned Xb = 0u;
#pragma unroll 1
        for (int bit = 11; bit >= 0; --bit, ++it) {
            const unsigned cand = Xb | (1u << bit); int cnt = 0;
#pragma unroll
            for (int lt = 0; lt < 16; ++lt)
#pragma unroll
                for (int i = 0; i < 4; ++i) cnt_le_u32(cnt, u[lt][i], cand);
            cnt += __shfl_xor(cnt, 16); cnt += __shfl_xor(cnt, 32);
            LAS int* bufp = cb + (it & 1) * 128;
            if (g == 0) bufp[w * 16 + q] = cnt;
            __syncthreads();
            int tot = 0;
#pragma unroll
            for (int ww = 0; ww < 8; ++ww) tot += bufp[ww * 16 + q];
            if (tot <= 256) Xb = cand;
        }
        if (tie) X = Xb;
    }
#pragma unroll
    for (int li = 0; li < 8; ++li) { const int kt = w + 8 * li;
        if (kt < nw) { unsigned word = 0u;
#pragma unroll
            for (int hf = 0; hf < 2; ++hf)
#pragma unroll
                for (int i = 0; i < 4; ++i) if (u[2 * li + hf][i] <= X) word |= 1u << (16 * hf + 4 * g + i);
            word |= __shfl_xor(word, 16); word |= __shfl_xor(word, 32);
            if (g == 0) MASKT[(size_t)kt * SEQ + tq] = word; } }
    __syncthreads();
}

__device__ __forceinline__ int crow(int r, int hi) { return (r & 3) + 8 * (r >> 2) + 4 * hi; }
__device__ __forceinline__ void attn_unit(const Ptrs& p, int b, int qb, int h, int lane) {
    const int q = lane & 31, hh = lane >> 5, tq = 32 * qb + q, nkt = 2 * ((qb >> 1) + 1);
    const size_t tok = (size_t)b * SEQ + tq;
    const bf16* Q = (const bf16*)(p.ws + WS_Q); const bf16* Kb = (const bf16*)(p.ws + WS_K) + (size_t)b * SEQ * 512 + h * 64;
    const bf16* VTb = (const bf16*)(p.ws + WS_VT) + (size_t)(b * 8 + h) * 64 * SEQ; const unsigned* MASKT = (const unsigned*)(p.ws + WS_MASK) + (size_t)b * 64 * SEQ;
    const float slope2 = __builtin_amdgcn_exp2f(-(float)(h + 1)) * LOG2E;
    bf16x8 qf[4];
#pragma unroll
    for (int ks = 0; ks < 4; ++ks) qf[ks] = *(const bf16x8*)(Q + tok * 512 + h * 64 + 16 * ks + 8 * hh);
    f32x16 o0 = {}, o1 = {}; float m = -INFINITY, l = 0.f;
    for (int kt = 0; kt < nkt; ++kt) {
        f32x16 S = {};
#pragma unroll
        for (int ks = 0; ks < 4; ++ks) { const bf16x8 kf = *(const bf16x8*)(Kb + (size_t)(32 * kt + q) * 512 + 16 * ks + 8 * hh); S = __builtin_amdgcn_mfma_f32_32x32x16_bf16(kf, qf[ks], S, 0, 0, 0); }
        const unsigned word = MASKT[(size_t)kt * SEQ + tq];
        u32x2 vlo[2][2], vhi[2][2];
#pragma unroll
        for (int dt = 0; dt < 2; ++dt)
#pragma unroll
            for (int s2 = 0; s2 < 2; ++s2) { const bf16* vp = VTb + (size_t)(32 * dt + q) * SEQ + 32 * kt + 16 * s2 + 4 * hh; vlo[dt][s2] = *(const u32x2*)vp; vhi[dt][s2] = *(const u32x2*)(vp + 8); }
        float rm = -INFINITY;
#pragma unroll
        for (int r = 0; r < 16; ++r) { const int cr = crow(r, hh), key = 32 * kt + cr; const int dist = tq > key ? tq - key : key - tq;
            const float sv = ((word >> cr) & 1u) ? S[r] - slope2 * (float)dist : -INFINITY; S[r] = sv; rm = fmaxf(rm, sv); }
        rm = fmaxf(rm, __shfl_xor(rm, 32));
        const float mn = fmaxf(m, rm), mu = (mn == -INFINITY) ? 0.f : mn, alpha = __builtin_amdgcn_exp2f(m - mu);
        float ls = 0.f;
#pragma unroll
        for (int r = 0; r < 16; ++r) { S[r] = __builtin_amdgcn_exp2f(S[r] - mu); ls += S[r]; }
        l = l * alpha + ls; m = mn;
#pragma unroll
        for (int r = 0; r < 16; ++r) { o0[r] *= alpha; o1[r] *= alpha; }
        bf16x8 pa[2];
#pragma unroll
        for (int s2 = 0; s2 < 2; ++s2) pa[s2] = __builtin_bit_cast(bf16x8, (u32x4){pk2(S[8 * s2], S[8 * s2 + 1]), pk2(S[8 * s2 + 2], S[8 * s2 + 3]), pk2(S[8 * s2 + 4], S[8 * s2 + 5]), pk2(S[8 * s2 + 6], S[8 * s2 + 7])});
#pragma unroll
        for (int s2 = 0; s2 < 2; ++s2) {
            o0 = __builtin_amdgcn_mfma_f32_32x32x16_bf16(__builtin_bit_cast(bf16x8, (u32x4){vlo[0][s2].x, vlo[0][s2].y, vhi[0][s2].x, vhi[0][s2].y}), pa[s2], o0, 0, 0, 0);
            o1 = __builtin_amdgcn_mfma_f32_32x32x16_bf16(__builtin_bit_cast(bf16x8, (u32x4){vlo[1][s2].x, vlo[1][s2].y, vhi[1][s2].x, vhi[1][s2].y}), pa[s2], o1, 0, 0, 0); }
    }
    l += __shfl_xor(l, 32);
    const float inv = 1.0f / l;
    bf16* OC = (bf16*)(p.ws + WS_XB) + tok * D + 512 + h * 64;
#pragma unroll
    for (int r4 = 0; r4 < 4; ++r4) {
        u32x2 a; a.x = pk2(o0[4 * r4] * inv, o0[4 * r4 + 1] * inv); a.y = pk2(o0[4 * r4 + 2] * inv, o0[4 * r4 + 3] * inv); *(u32x2*)(OC + 8 * r4 + 4 * hh) = a;
        u32x2 c; c.x = pk2(o1[4 * r4] * inv, o1[4 * r4 + 1] * inv); c.y = pk2(o1[4 * r4 + 2] * inv, o1[4 * r4 + 3] * inv); *(u32x2*)(OC + 32 + 8 * r4 + 4 * hh) = c; }
}

__device__ __forceinline__ void phase_ln1_router(const Ptrs& p, LAS unsigned char* lds, int vcu, int G) {
    const int tid = threadIdx.x, lane = tid & 63, wave = tid >> 6;
    LAS float* hrow = (LAS float*)(lds + wave * 16384);
    const float* pre = p.out; bf16* H1B = (bf16*)(p.ws + WS_XB);
    const float* g1 = p.in[12]; const float* b1 = p.in[13]; const float* Wr = p.in[14]; const float rbias = p.in[15][lane];
    unsigned* cnt = (unsigned*)(p.ws + WS_CTL) + CW_CNT; int* LTOK = (int*)(p.ws + WS_LTOK); float* LW = (float*)(p.ws + WS_LW); unsigned* ROUTE = (unsigned*)(p.ws + WS_ROUTE);
    for (int grp = vcu * NWAVES + wave; grp < T / 4; grp += G * NWAVES) {
        const int tok0 = grp * 4;
#pragma unroll
        for (int j4 = 0; j4 < 4; ++j4) { const size_t tok = tok0 + j4;
            f32x4 v[4]; float s = 0.f;
#pragma unroll
            for (int jj = 0; jj < 4; ++jj) { v[jj] = *(const f32x4*)(pre + tok * D + 4 * lane + 256 * jj); s += (v[jj][0] + v[jj][1]) + (v[jj][2] + v[jj][3]); }
            const float mean = wave_sum(s) * (1.0f / D); float s2 = 0.f;
#pragma unroll
            for (int jj = 0; jj < 4; ++jj) { v[jj] = v[jj] - mean; s2 += (v[jj][0] * v[jj][0] + v[jj][1] * v[jj][1]) + (v[jj][2] * v[jj][2] + v[jj][3] * v[jj][3]); }
            const float rstd = 1.0f / sqrtf(wave_sum(s2) * (1.0f / D) + 1e-5f);
#pragma unroll
            for (int jj = 0; jj < 4; ++jj) { const int c0 = 4 * lane + 256 * jj; const f32x4 gg = *(const f32x4*)(g1 + c0), bb = *(const f32x4*)(b1 + c0);
                const f32x4 hv = v[jj] * rstd * gg + bb;
                u32x2 o; o.x = pk2(hv[0], hv[1]); o.y = pk2(hv[2], hv[3]); *(u32x2*)(H1B + tok * D + c0) = o;
#pragma unroll
                for (int e = 0; e < 4; ++e) hrow[(c0 + e) * 4 + j4] = hv[e]; } }
        LDS_WAIT();
        f32x4 acc = {0.f, 0.f, 0.f, 0.f};
#pragma unroll 8
        for (int k = 0; k < D; ++k) { const float wv = Wr[k * 64 + lane]; const f32x4 hv = *(const LAS f32x4*)(hrow + k * 4); acc += hv * wv; }
#pragma unroll
        for (int j4 = 0; j4 < 4; ++j4) { const int tok = tok0 + j4;
            const float score = sigmoidf_(acc[j4]); const float sel = score + rbias;
            float m1 = sel; m1 = fmaxf(m1, __shfl_xor(m1, 1)); m1 = fmaxf(m1, __shfl_xor(m1, 2)); m1 = fmaxf(m1, __shfl_xor(m1, 4));
            const unsigned long long bm = __ballot(sel == m1) & (0xFFull << (lane & 56));
            const int first = __ffsll((long long)bm) - 1;
            float m2 = (lane == first) ? -INFINITY : sel; m2 = fmaxf(m2, __shfl_xor(m2, 1)); m2 = fmaxf(m2, __shfl_xor(m2, 2)); m2 = fmaxf(m2, __shfl_xor(m2, 4));
            const float gs = m1 + m2; const int grpi = lane >> 3; int grank = 0;
#pragma unroll
            for (int j = 0; j < 8; ++j) { const float gj = __shfl(gs, j * 8); grank += (gj > gs || (gj == gs && j < grpi)) ? 1 : 0; }
            const float selm = grank < 4 ? sel : -INFINITY; int rank = 0;
            const unsigned long long mykey = ((unsigned long long)ord_u32(selm) << 8) | (unsigned)(63 - lane);
#pragma unroll
            for (int j = 0; j < 64; ++j) { const unsigned long long kj = ((unsigned long long)(unsigned)__shfl((int)(mykey >> 8), j) << 8) | (unsigned)(63 - j); cnt_gt_u64(rank, kj, mykey); }
            const bool chosen = rank < TOPK;
            const float wsum = wave_sum(chosen ? score : 0.f); const float wgt = score / wsum * 2.5f;
            const unsigned long long cm = __ballot(chosen); const int k = __popcll(cm & ((1ull << lane) - 1ull));
            if (chosen) { const unsigned pos = atomicAdd(cnt + lane, 1u); LTOK[(size_t)lane * T + pos] = tok; LW[(size_t)lane * T + pos] = wgt; ROUTE[(size_t)tok * 8 + k] = ((unsigned)lane << 16) | pos; }
        }
        LDS_WAIT();
    }
}

__device__ __forceinline__ int moe_tables(const Ptrs& p, LAS int* tab, int nN, bool gather, int v, int G) {
    const int tid = threadIdx.x;
    const unsigned* cnt = (const unsigned*)(p.ws + WS_CTL) + CW_CNT; const int* LTOK = (const int*)(p.ws + WS_LTOK);
    if (tid == 0) { int s = 0; for (int e = 0; e < NE; ++e) { tab[e] = s; s += ((int)cnt[e] + 255) >> 8; } tab[NE] = s; tab[NE + 1] = s + T / 256; }
    __syncthreads();
    const int total = tab[NE + 1] * nN;
    int nunits = 0; for (int i = 0; i < MOE_MAXU; ++i) if ((long)i * G + v < total) nunits = i + 1;
    if (tid < nunits) { const int L = tid * G + v, tile = L / nN, pn = L % nN; int e = 0; while (tab[e + 1] <= tile) ++e;
        tab[128 + 4 * tid] = tile; tab[129 + 4 * tid] = pn; tab[130 + 4 * tid] = e; tab[131 + 4 * tid] = tile - tab[e]; }
    __syncthreads();
    if (gather) for (int idx = tid; idx < nunits * 256; idx += NTHR) { const int i = idx >> 8, r = idx & 255, e = tab[130 + 4 * i], mt = tab[131 + 4 * i], pos = mt * 256 + r;
        tab[256 + idx] = e < NE ? (pos < (int)cnt[e] ? LTOK[(size_t)e * T + pos] : 0) : pos; }
    __syncthreads();
    return nunits;
}

__device__ __forceinline__ void phase_combine(const Ptrs& p, LAS int* tab, int j, int vcu, int G) {
    const int tid = threadIdx.x, lane = tid & 63, wave = tid >> 6;
    const bf16* Y = (const bf16*)(p.ws + WS_Y); const bf16* H1B = (const bf16*)(p.ws + WS_XB); const unsigned* ROUTE = (const unsigned*)(p.ws + WS_ROUTE);
    for (int tok = vcu * NWAVES + wave; tok < T; tok += G * NWAVES) {
        const u32x2 hv = *(const u32x2*)(H1B + (size_t)tok * D + 256 * j + 4 * lane);
        f32x4 a = {ALPHA * bflo(hv.x), ALPHA * bfhi(hv.x), ALPHA * bflo(hv.y), ALPHA * bfhi(hv.y)};
        { const u32x2 y = *(const u32x2*)(Y + ((size_t)tab[NE] * 256 + tok) * 256 + 4 * lane); a[0] += bflo(y.x); a[1] += bfhi(y.x); a[2] += bflo(y.y); a[3] += bfhi(y.y); }
#pragma unroll
        for (int k = 0; k < TOPK; ++k) { const unsigned r = ROUTE[(size_t)tok * 8 + k]; const size_t row = (size_t)tab[r >> 16] * 256 + (r & 0xffffu);
            const u32x2 y = *(const u32x2*)(Y + row * 256 + 4 * lane); a[0] += bflo(y.x); a[1] += bfhi(y.x); a[2] += bflo(y.y); a[3] += bfhi(y.y); }
        *(f32x4*)(p.out + (size_t)tok * D + 256 * j + 4 * lane) = a;
    }
}
__device__ __forceinline__ void phase_ln2(const Ptrs& p, int vcu, int G) {
    const int tid = threadIdx.x, lane = tid & 63, wave = tid >> 6;
    const float* g2 = p.in[22]; const float* b2 = p.in[23];
    for (int tok = vcu * NWAVES + wave; tok < T; tok += G * NWAVES) {
        float* rowp = p.out + (size_t)tok * D;
        f32x4 v[4]; float s = 0.f;
#pragma unroll
        for (int jj = 0; jj < 4; ++jj) { v[jj] = *(const f32x4*)(rowp + 4 * lane + 256 * jj); s += (v[jj][0] + v[jj][1]) + (v[jj][2] + v[jj][3]); }
        const float mean = wave_sum(s) * (1.0f / D); float s2 = 0.f;
#pragma unroll
        for (int jj = 0; jj < 4; ++jj) { v[jj] = v[jj] - mean; s2 += (v[jj][0] * v[jj][0] + v[jj][1] * v[jj][1]) + (v[jj][2] * v[jj][2] + v[jj][3] * v[jj][3]); }
        const float rstd = 1.0f / sqrtf(wave_sum(s2) * (1.0f / D) + 1e-5f);
#pragma unroll
        for (int jj = 0; jj < 4; ++jj) { const int c0 = 4 * lane + 256 * jj; *(f32x4*)(rowp + c0) = v[jj] * rstd * *(const f32x4*)(g2 + c0) + *(const f32x4*)(b2 + c0); }
    }
}

#define XB_TMO      128
#define XB_XCNT(j)  (256  + 64 * (j))
#define XB_XSUB(j)  (1280 + 64 * (j))
#define XB_XGEN(j)  (2304 + 64 * (j))
#define XB_TOP      3328
#define XB_TOPGEN   3392
#define XCD_BAR_WORDS 3456
#define XB_SPIN_CAP (1u << 18)
__device__ __forceinline__ unsigned xb_ld(unsigned* p)              { return __hip_atomic_load(p, __ATOMIC_RELAXED, __HIP_MEMORY_SCOPE_AGENT); }
__device__ __forceinline__ unsigned xb_add(unsigned* p, unsigned v) { return __hip_atomic_fetch_add(p, v, __ATOMIC_RELAXED, __HIP_MEMORY_SCOPE_AGENT); }
__device__ __forceinline__ unsigned xb_xcc_id() { return (unsigned)__builtin_amdgcn_s_getreg((3 << 11) | 20) & 0xFu; }
#define XB_SPIN(cond, bar) do { unsigned _sp = 0; while (cond) { __builtin_amdgcn_s_sleep(1); \
    if ((++_sp & 255u) == 0u) { if (xb_ld(&(bar)[XB_TMO])) break; if (_sp > XB_SPIN_CAP) { atomicAdd(&(bar)[XB_TMO], 1u); break; } } } } while (0)
struct XcdBarrier { unsigned* bar; unsigned x; volatile LAS unsigned* st; };
__device__ __forceinline__ XcdBarrier xcd_barrier_post(unsigned* bar, volatile LAS unsigned* st) {
    XcdBarrier b; b.bar = bar; b.x = xb_xcc_id(); b.st = st;
    if (threadIdx.x == 0) (void)xb_add(&bar[XB_XCNT(b.x)], 1u);
    return b;
}
__device__ __forceinline__ void xcd_barrier_complete(unsigned* bar, unsigned x, unsigned& nloc, unsigned& nx) {
    const unsigned G = gridDim.x * gridDim.y * gridDim.z;
    unsigned sum, cnt, mine, sp = 0u;
    for (;;) {
        sum = 0u; cnt = 0u; mine = 0u;
#pragma unroll
        for (unsigned j = 0; j < 16; ++j) { const unsigned c = xb_ld(&bar[XB_XCNT(j)]); sum += c; cnt += (c > 0u) ? 1u : 0u; mine = (j == x) ? c : mine; }
        if (sum == G) break;
        __builtin_amdgcn_s_sleep(1);
        if ((++sp & 255u) == 0u) { if (xb_ld(&bar[XB_TMO])) break; if (sp > XB_SPIN_CAP) { atomicAdd(&bar[XB_TMO], 1u); break; } }
    }
    nloc = mine > 0u ? mine : 1u; nx = cnt > 0u ? cnt : 1u;
}
__device__ __forceinline__ void xcd_barrier(const XcdBarrier& b) {
    asm volatile("s_waitcnt vmcnt(0)" ::: "memory");
    __syncthreads();
    if (threadIdx.x == 0) {
        unsigned* bar = b.bar;
        __builtin_amdgcn_s_waitcnt(0);
        unsigned nloc = b.st[0], nx = b.st[1];
        if (nloc == 0u) { xcd_barrier_complete(bar, b.x, nloc, nx); b.st[0] = nloc; b.st[1] = nx; }
        const unsigned old = xb_add(&bar[XB_XSUB(b.x)], 1u);
        const unsigned gen = old / nloc;
        if (old + 1u == (gen + 1u) * nloc) {
            __builtin_amdgcn_fence(__ATOMIC_RELEASE, "agent");
            asm volatile("s_waitcnt vmcnt(0)" ::: "memory");
            const unsigned og = xb_add(&bar[XB_TOP], 1u);
            const unsigned tg = og / nx;
            if (og + 1u == (tg + 1u) * nx) xb_add(&bar[XB_TOPGEN], 1u);
            else XB_SPIN(xb_ld(&bar[XB_TOPGEN]) == tg, bar);
            __builtin_amdgcn_fence(__ATOMIC_ACQUIRE, "agent");
            xb_add(&bar[XB_XGEN(b.x)], 1u);
            asm volatile("s_waitcnt vmcnt(0)" ::: "memory");
        } else {
            XB_SPIN(xb_ld(&bar[XB_XGEN(b.x)]) == gen, bar);
            __builtin_amdgcn_fence(__ATOMIC_ACQUIRE, "agent");
            asm volatile("s_waitcnt vmcnt(0)" ::: "memory");
        }
    }
    __syncthreads();
}

constexpr int NPH = 17;
struct Args { Ptrs p; int ph_lo, ph_hi; };
__global__ void __launch_bounds__(NTHR, 2) mk_fwd(Args args) {
    extern __shared__ __attribute__((aligned(16))) unsigned char lds_raw[];
    LAS unsigned char* lds = (LAS unsigned char*)lds_raw;
    volatile LAS unsigned* MISC = (volatile LAS unsigned*)(lds + MISC_OFF);
    LAS int* tab = (LAS int*)(lds + TAB_OFF);
    const Ptrs& p = args.p;
    const int tid = threadIdx.x, lane = tid & 63, wave = __builtin_amdgcn_readfirstlane(tid >> 6);
    const int G = gridDim.x, bx = blockIdx.x, vcu = (G % 8 == 0) ? (bx % 8) * (G / 8) + bx / 8 : bx;
    if (tid < 32) MISC[tid] = 0u;
    __syncthreads();
    unsigned char* ws = p.ws;
    XcdBarrier bar; bar.bar = (unsigned*)(ws + WS_CTL) + CW_BAR; bar.x = 0; bar.st = nullptr;
    if (MK_N_LAUNCHES == 1) bar = xcd_barrier_post((unsigned*)(ws + WS_CTL) + CW_BAR, MISC + 8);
    const int lo = args.ph_lo, hi = args.ph_hi;
#ifndef PHMASK
#define PHMASK 0x1FFFF
#endif
#define IN(k) (((PHMASK >> (k)) & 1) && lo <= (k) && (k) < hi)
#define SEAM(k) do { if (IN(k) && IN((k) + 1)) xcd_barrier(bar); } while (0)

    if (IN(0)) { phase_prep(p, lds, vcu, G); } SEAM(0);

    if (IN(1)) {
        DenseSched S; S.init(T, DINP, D, D, (const bf16*)(ws + WS_XB), (const bf16*)(ws + WS_WIN), G, bx);
        EpiProj E{(bf16*)(ws + WS_P), (float*)(ws + WS_RSQ), (float*)(ws + WS_RSKV)};
        pg8::gemm_phase<EpiProj, DenseSched, false>(lds, D, D, S, E);
    } SEAM(1);

    if (IN(2)) {
        DenseSched S; S.init(T, NUP, KUP, DINP, (const bf16*)(ws + WS_P) + 2048, (const bf16*)(ws + WS_WUP), G, bx);
        EpiUp E{(bf16*)(ws + WS_Q), (bf16*)(ws + WS_QI), (bf16*)(ws + WS_K), (bf16*)(ws + WS_VT), (const float*)(ws + WS_RSQ), (const float*)(ws + WS_RSKV)};
        pg8::gemm_phase<EpiUp, DenseSched, false>(lds, KUP, DINP, S, E);
        phase_kidx(p, vcu, G);
        for (int item = vcu; item < 1024; item += G) hgrn1_item(p, item, lds);
    } SEAM(2);

    if (IN(3)) {
        for (int L = vcu; L < 1024; L += G) { const int i = L >> 8, idx = L & 255, b = idx >> 5, j = idx & 31;
            const int qg = (i == 0) ? j : (i == 1) ? 63 - j : (i == 2) ? 64 + j : 127 - j;
            indexer_item(p, b * 128 + qg, lds); }
        phase_scan(p, vcu, G);
    } SEAM(3);

    if (IN(4)) {
        for (int pr = vcu; pr < 256; pr += G) { const int b = pr >> 5, j = pr & 31;
            attn_unit(p, b, 63 - j, wave, lane); attn_unit(p, b, j, wave, lane); }
        __syncthreads();
        for (int item = vcu; item < 1024; item += G) hgrn3_item(p, item, lds);
    } SEAM(4);

    if (IN(5)) {
        DenseSched S; S.init(T, D, D, D, (const bf16*)(ws + WS_XB), (const bf16*)(ws + WS_WOUT), G, bx);
        EpiOut E{p.in[0], p.out};
        pg8::gemm_phase<EpiOut, DenseSched, false>(lds, D, D, S, E);
        phase_convert_experts(p, lds, vcu, G);
    } SEAM(5);

    if (IN(6)) { phase_ln1_router(p, lds, vcu, G); } SEAM(6);

    if (IN(7)) {
        const int nu = moe_tables(p, tab, 2, true, vcu, G);
        MoeSched S{tab, nu, (const char*)(ws + WS_XB), (const char*)(ws + WS_WGU), (size_t)0, (size_t)512 * D * 2, (size_t)256 * D * 2};
        EpiGU E{(bf16*)(ws + WS_HB)};
        pg8::gemm_phase<EpiGU, MoeSched, true>(lds, D, D, S, E);
    } SEAM(7);

#pragma unroll 1
    for (int j = 0; j < 4; ++j) {
        if (IN(8 + 2 * j)) {
            const int nu = moe_tables(p, tab, 1, false, vcu, G);
            MoeSched S{tab, nu, (const char*)(ws + WS_HB), (const char*)(ws + WS_WD) + (size_t)j * 256 * DE * 2, (size_t)256 * DE * 2, (size_t)D * DE * 2, (size_t)0};
            EpiDown E{(bf16*)(ws + WS_Y), (const float*)(ws + WS_LW)};
            pg8::gemm_phase<EpiDown, MoeSched, false>(lds, DE, DE, S, E);
        } SEAM(8 + 2 * j);
        if (IN(9 + 2 * j)) { (void)moe_tables(p, tab, 1, false, vcu, G); phase_combine(p, tab, j, vcu, G); } SEAM(9 + 2 * j);
    }
    if (IN(16)) phase_ln2(p, vcu, G);
#undef IN
#undef SEAM
}

extern "C" void kernel_launch(void* const* d_in, const int* in_sizes, int n_in, void* d_out, int out_size, void* d_ws, size_t ws_size, hipStream_t stream) {
    static int grid = 0;
    if (grid == 0) {
        if (n_in != 24 || out_size != T * D || ws_size < WS_END) { fprintf(stderr, "kernel_launch: unexpected problem (n_in %d, out %d, ws %zu)\n", n_in, out_size, ws_size); grid = -1; return; }
        int dev = 0, cus = 0, per_cu = 0;
        if (hipGetDevice(&dev) != hipSuccess || hipDeviceGetAttribute(&cus, hipDeviceAttributeMultiprocessorCount, dev) != hipSuccess) { grid = -1; return; }
        if (hipFuncSetAttribute((const void*)mk_fwd, hipFuncAttributeMaxDynamicSharedMemorySize, LDS_BYTES) != hipSuccess) { fprintf(stderr, "kernel_launch: hipFuncSetAttribute failed\n"); grid = -1; return; }
        if (hipOccupancyMaxActiveBlocksPerMultiprocessor(&per_cu, (const void*)mk_fwd, NTHR, LDS_BYTES) != hipSuccess || per_cu < 1) { fprintf(stderr, "kernel_launch: occupancy query says %d blocks per CU\n", per_cu); }
        (void)hipGetLastError();
        grid = cus;
    }
    if (grid < 0) return;
    (void)hipMemsetAsync((char*)d_ws + WS_CTL, 0, CTL_ZERO_BYTES, stream);
    Args a{};
    for (int i = 0; i < 24; ++i) a.p.in[i] = (const float*)d_in[i];
    a.p.out = (float*)d_out; a.p.ws = (unsigned char*)d_ws;
    if (MK_N_LAUNCHES == 1) { a.ph_lo = 0; a.ph_hi = NPH; hipLaunchKernelGGL(mk_fwd, dim3(grid), dim3(NTHR), LDS_BYTES, stream, a); }
    else for (int ph = 0; ph < NPH; ++ph) { a.ph_lo = ph; a.ph_hi = ph + 1; hipLaunchKernelGGL(mk_fwd, dim3(grid), dim3(NTHR), LDS_BYTES, stream, a); }
}
```

```cpp
#include <hip/hip_runtime.h>
#include <cstdint>
#include <cstdio>

#define LAS __attribute__((address_space(3)))
#define GAS __attribute__((address_space(1)))
typedef unsigned short bf16;
typedef short bf16x8 __attribute__((ext_vector_type(8)));
typedef short s16x4 __attribute__((ext_vector_type(4)));
typedef float f32x2 __attribute__((ext_vector_type(2)));
typedef float f32x4 __attribute__((ext_vector_type(4)));
typedef float f32x16 __attribute__((ext_vector_type(16)));
typedef unsigned u32x2 __attribute__((ext_vector_type(2)));
typedef unsigned u32x4 __attribute__((ext_vector_type(4)));
typedef GAS unsigned gu32;
#define RLX_AGENT __ATOMIC_RELAXED, __HIP_MEMORY_SCOPE_AGENT

#ifndef MK_N_LAUNCHES
#define MK_N_LAUNCHES 1
#endif

constexpr int NB = 8, SEQ = 2048, T = NB * SEQ, D = 1024, DIN = 2500, DINP = 2560;
constexpr int NE = 64, NEX = 65  , DE = 256, TOPK = 8;
constexpr int KUP = 384, NUP = 1792;
constexpr float ALPHA = 1.18920711500272f;
constexpr float LOG2E = 1.4426950408889634f;
constexpr int HROWS = 147456 + T;
constexpr int NWAVES = 8, NTHR = 512;

constexpr size_t MiB = 1u << 20;
constexpr size_t WS_CTL = 0, CTL_ZERO_BYTES = 1 * MiB;
constexpr size_t WS_RSQ = 1 * MiB, WS_RSKV = WS_RSQ + 256 * 1024, WS_WH = WS_RSKV + 256 * 1024, WS_DEC = WS_WH + 256 * 1024;
constexpr size_t WS_LB = 2 * MiB + 256 * 1024;
constexpr size_t WS_ROUTE = 2 * MiB + 512 * 1024;
constexpr size_t WS_WUP = 4 * MiB, WS_WOUT = 6 * MiB, WS_MASK = 8 * MiB, WS_KIDX = 12 * MiB, WS_LTOK = 14 * MiB, WS_LW = 18 * MiB;
constexpr size_t WS_XB = 24 * MiB;
constexpr size_t WS_WIN = 56 * MiB, WS_P = 61 * MiB, WS_Q = 141 * MiB, WS_QI = 157 * MiB, WS_K = 165 * MiB, WS_VT = 181 * MiB, WS_DS = 197 * MiB, WS_SP = 229 * MiB;
constexpr size_t WS_WD = 56 * MiB, WS_WGU = 89 * MiB, WS_Y = 89 * MiB, WS_HB = 169 * MiB, WS_END = 249 * MiB;
constexpr int CW_TMO = 0, CW_BAR = 4096, CW_CNT = 8192;

constexpr int RING_BYTES = 131072;
constexpr int TAB_OFF = RING_BYTES;
constexpr int MISC_OFF = RING_BYTES + 12288;
constexpr int LDS_BYTES = 147456;

__device__ __forceinline__ unsigned f2bf(float f) { unsigned u = __builtin_bit_cast(unsigned, f); return (u + 0x7fffu + ((u >> 16) & 1u)) >> 16; }
__device__ __forceinline__ unsigned pk2(float lo, float hi) { return f2bf(lo) | (f2bf(hi) << 16); }
__device__ __forceinline__ float bf2f(unsigned h) { return __builtin_bit_cast(float, h << 16); }
__device__ __forceinline__ float bflo(unsigned w) { return __builtin_bit_cast(float, w << 16); }
__device__ __forceinline__ float bfhi(unsigned w) { return __builtin_bit_cast(float, w & 0xffff0000u); }
__device__ __forceinline__ float sigmoidf_(float x) { return 1.0f / (1.0f + __expf(-x)); }
__device__ __forceinline__ float siluf_(float x) { return x / (1.0f + __expf(-x)); }
__device__ __forceinline__ float wave_sum(float v) {
#pragma unroll
    for (int o = 1; o < 64; o <<= 1) v += __shfl_xor(v, o);
    return v;
}
#define LDS_WAIT() asm volatile("s_waitcnt lgkmcnt(0)" ::: "memory")
#define VM_WAIT() asm volatile("s_waitcnt vmcnt(0)" ::: "memory")

namespace pg8 {
constexpr int BM = 256, BK = 64, HALF = 128, HTB = HALF * BK * 2, STAGE_BYTES = 8 * HTB;
__host__ __device__ __forceinline__ int lds_byte(int r, int c) { const int st = (r >> 4) * 2 + (c >> 5), rr = r & 15, cc = c & 31, ob = rr * 64 + cc * 2; return st * 1024 + (ob ^ (((ob >> 9) & 1) << 5)); }
__host__ __device__ __forceinline__ void stage_rc(int b, int& R, int& C) { const int st = b / 1024, sb = b % 1024, swz = sb ^ (((sb >> 9) & 1) << 5); R = (st >> 1) * 16 + swz / 64; C = (st & 1) * 32 + (swz % 64) / 2; }
__host__ __device__ __forceinline__ int perm32(int rho) { const int n = rho >> 4, i = rho & 15; return 8 * (i >> 2) + 4 * n + (i & 3); }

struct Unit { int pm, pn, aux, slot; const char* A; const char* B; };

__device__ __forceinline__ unsigned cvt_pk_bf16(float lo, float hi) { unsigned r; asm volatile("v_cvt_pk_bf16_f32 %0, %1, %2" : "=v"(r) : "v"(lo), "v"(hi)); return r; }

template <class Epi, class Sched, bool GATHER>
__device__ __forceinline__ void gemm_phase(LAS unsigned char* lds, const int K, const int lda, const Sched& S, const Epi& E) {
    const int tid = threadIdx.x, wid = __builtin_amdgcn_readfirstlane(tid >> 6), lane = tid & 63, wr = wid >> 2, wc = wid & 3, fr = lane & 15, fq = lane >> 4;
    const int nt = K / BK;
    int sR[2], sC[2];
    unsigned voffB[2];
#pragma unroll
    for (int i = 0; i < 2; ++i) { stage_rc(tid * 16 + i * 8192, sR[i], sC[i]); const int Rb = Epi::PERM ? ((sR[i] & ~31) + perm32(sR[i] & 31)) : sR[i]; voffB[i] = (unsigned)(Rb * K + sC[i]) * 2u; }
    const size_t kstep = (size_t)(BK * 2);
    const size_t hstepB = (size_t)HALF * K * 2, hstepA = (size_t)HALF * lda * 2;
    unsigned voffA[2];
#pragma unroll
    for (int i = 0; i < 2; ++i) voffA[i] = (unsigned)(sR[i] * lda + sC[i]) * 2u;
    const unsigned ldsw = (unsigned)wid * 1024u;
    const int aoff = lds_byte(wr * 64 + fr, fq * 8), boff = lds_byte(wc * 32 + fr, fq * 8);
#define PG8_SA(b, h) (((b) * 2 + (h)) * HTB)
#define PG8_SB(b, h) ((4 + (b) * 2 + (h)) * HTB)
#define PG8_STAGE(bufoff, gbase, voff) do { _Pragma("unroll") for (int _i = 0; _i < 2; ++_i) \
        __builtin_amdgcn_global_load_lds((const unsigned*)((const char*)(gbase) + (voff)[_i]), (LAS unsigned*)(lds + (bufoff) + ldsw + _i * 8192), 16, 0, 0); } while (0)
#define PG8_LDA(dst, b, h) do { _Pragma("unroll") for (int m = 0; m < 4; ++m) _Pragma("unroll") for (int k = 0; k < 2; ++k) dst[m][k] = *(const LAS bf16x8*)(lds + PG8_SA(b, h) + aoff + m * 2048 + k * 1024); } while (0)
#define PG8_LDB(dst, b, h) do { _Pragma("unroll") for (int n = 0; n < 2; ++n) _Pragma("unroll") for (int k = 0; k < 2; ++k) dst[n][k] = *(const LAS bf16x8*)(lds + PG8_SB(b, h) + boff + n * 2048 + k * 1024); } while (0)
#define PG8_MMA(ai, bj, At, Bt) do { __builtin_amdgcn_s_setprio(1); _Pragma("unroll") for (int m = 0; m < 4; ++m) _Pragma("unroll") for (int n = 0; n < 2; ++n) _Pragma("unroll") for (int k = 0; k < 2; ++k) \
        acc[ai][bj][m][n] = __builtin_amdgcn_mfma_f32_16x16x32_bf16(Bt[n][k], At[m][k], acc[ai][bj][m][n], 0, 0, 0); __builtin_amdgcn_s_setprio(0); } while (0)
#define PG8_WAIT_V(n) asm volatile("s_waitcnt vmcnt(" #n ")" ::: "memory")
#define PG8_WAIT_L(n) asm volatile("s_waitcnt lgkmcnt(" #n ")" ::: "memory")
#define PG8_BAR __builtin_amdgcn_s_barrier()
#define PG8_SCHED __builtin_amdgcn_sched_barrier(0)
#define PG8_AOFF(dst, u) do { if constexpr (GATHER) { _Pragma("unroll") for (int _h = 0; _h < 2; ++_h) _Pragma("unroll") for (int _i = 0; _i < 2; ++_i) { \
        const int _src = S.row((u), _h * HALF + sR[_i]); dst[_h][_i] = (unsigned)(_src * lda + sC[_i]) * 2u; } } } while (0)
#define PG8_STAGE_A(bufoff, gbase, v, h) do { if constexpr (GATHER) { PG8_STAGE(bufoff, gbase, (v)[h]); } else { PG8_STAGE(bufoff, (gbase) + (h) * hstepA, voffA); } } while (0)
    Unit cur, nxt; int ui = 0;
    if (!S.next(0, cur)) return;
    f32x4 acc[2][2][4][2];
#pragma unroll
    for (int a = 0; a < 2; ++a)
#pragma unroll
        for (int b = 0; b < 2; ++b)
#pragma unroll
            for (int m = 0; m < 4; ++m)
#pragma unroll
                for (int n = 0; n < 2; ++n) acc[a][b][m][n] = (f32x4){0.f, 0.f, 0.f, 0.f};
    bf16x8 At[4][2], B0[2][2], B1[2][2];
    unsigned vA[2][2], vN[2][2];
    PG8_AOFF(vA, cur);
#pragma unroll
    for (int h = 0; h < 2; ++h)
#pragma unroll
        for (int i = 0; i < 2; ++i) vN[h][i] = vA[h][i];
    const char* cA = cur.A; const char* cB = cur.B;
    PG8_STAGE(PG8_SB(0, 0), cB, voffB); PG8_STAGE(PG8_SB(0, 1), cB + hstepB, voffB); PG8_STAGE_A(PG8_SA(0, 0), cA, vA, 0); PG8_STAGE_A(PG8_SA(0, 1), cA, vA, 1);
    if (wr == 1) PG8_BAR;
    PG8_WAIT_V(2); PG8_BAR;
    PG8_STAGE(PG8_SB(1, 0), cB + kstep, voffB); PG8_STAGE_A(PG8_SA(1, 0), cA + kstep, vA, 0); PG8_STAGE(PG8_SB(1, 1), cB + hstepB + kstep, voffB);
    PG8_WAIT_V(6); PG8_BAR;
    for (;;) {
        const bool has_next = S.next(ui + 1, nxt);
        const char* nA = has_next ? nxt.A : cA; const char* nB = has_next ? nxt.B : cB;
#pragma unroll 1
        for (int t = 0; t < nt; t += 2) {
            const bool last = (t == nt - 2);
            const char* a1 = cA + (size_t)(t + 1) * kstep;
            const char* a2 = last ? nA : cA + (size_t)(t + 2) * kstep; const char* b2 = last ? nB : cB + (size_t)(t + 2) * kstep;
            const char* a3 = a2 + kstep; const char* b3 = b2 + kstep;
            if (last && has_next) { PG8_AOFF(vN, nxt); }
            unsigned wX[2][2];
            if constexpr (GATHER) {
#pragma unroll
                for (int h = 0; h < 2; ++h)
#pragma unroll
                    for (int i = 0; i < 2; ++i) wX[h][i] = last ? vN[h][i] : vA[h][i]; }
            PG8_LDB(B0, 0, 0); PG8_LDB(B1, 0, 1); PG8_SCHED; PG8_LDA(At, 0, 0); PG8_STAGE_A(PG8_SA(1, 1), a1, vA, 1);
            PG8_WAIT_V(8); PG8_WAIT_L(0); PG8_BAR; PG8_MMA(0, 0, At, B0); PG8_MMA(0, 1, At, B1); PG8_BAR; PG8_SCHED;
            PG8_LDA(At, 0, 1); PG8_STAGE(PG8_SB(0, 0), b2, voffB); PG8_STAGE(PG8_SB(0, 1), b2 + hstepB, voffB); PG8_STAGE_A(PG8_SA(0, 0), a2, wX, 0);
            PG8_WAIT_V(8); PG8_WAIT_L(0); PG8_BAR; PG8_MMA(1, 0, At, B0); PG8_MMA(1, 1, At, B1); PG8_BAR; PG8_SCHED;
            PG8_LDB(B0, 1, 0); PG8_LDB(B1, 1, 1); PG8_SCHED; PG8_LDA(At, 1, 0); PG8_STAGE_A(PG8_SA(0, 1), a2, wX, 1);
            PG8_WAIT_V(8); PG8_WAIT_L(0); PG8_BAR; PG8_MMA(0, 0, At, B0); PG8_MMA(0, 1, At, B1); PG8_BAR; PG8_SCHED;
            PG8_LDA(At, 1, 1); PG8_STAGE(PG8_SB(1, 0), b3, voffB); PG8_STAGE(PG8_SB(1, 1), b3 + hstepB, voffB); PG8_STAGE_A(PG8_SA(1, 0), a3, wX, 0);
            PG8_WAIT_V(8); PG8_WAIT_L(0); PG8_BAR; PG8_MMA(1, 0, At, B0); PG8_MMA(1, 1, At, B1); PG8_BAR; PG8_SCHED;
        }
        if (wr == 0) PG8_BAR;
        E(acc, cur, wr, wc, fr, fq);
        if (!has_next) break;
#pragma unroll
        for (int a = 0; a < 2; ++a)
#pragma unroll
            for (int b = 0; b < 2; ++b)
#pragma unroll
                for (int m = 0; m < 4; ++m)
#pragma unroll
                    for (int n = 0; n < 2; ++n) acc[a][b][m][n] = (f32x4){0.f, 0.f, 0.f, 0.f};
        cur = nxt; cA = nA; cB = nB; ++ui;
#pragma unroll
        for (int h = 0; h < 2; ++h)
#pragma unroll
            for (int i = 0; i < 2; ++i) vA[h][i] = vN[h][i];
        if (wr == 1) PG8_BAR;
    }
    PG8_WAIT_V(0);
    PG8_BAR;
#undef PG8_SA
#undef PG8_SB
#undef PG8_STAGE
#undef PG8_LDA
#undef PG8_LDB
#undef PG8_MMA
#undef PG8_WAIT_V
#undef PG8_WAIT_L
#undef PG8_BAR
#undef PG8_SCHED
#undef PG8_AOFF
#undef PG8_STAGE_A
}
}

struct DenseSched {
    int nM, nN, nwg, G, c; const char* A; const char* B; size_t tstepA, tstepB;
    __device__ __forceinline__ void init(int M, int N, int K, int lda, const bf16* A_, const bf16* B_, int G_, int c_) { nM = M / 256; nN = N / 256; nwg = nM * nN; G = G_; c = c_; A = (const char*)A_; B = (const char*)B_; tstepA = (size_t)256 * lda * 2; tstepB = (size_t)256 * K * 2; }
    __device__ __forceinline__ bool next(int i, pg8::Unit& u) const {
        const long L = (long)i * G + c; if (L >= nwg) return false;
        int wgid = (int)L; { const int q = nwg / 8, r = nwg % 8, xcd = wgid % 8, off = wgid / 8; wgid = (xcd < r ? xcd * (q + 1) : r * (q + 1) + (xcd - r) * q) + off; }
        const int nig = 8 * nN, gid = wgid / nig, fm = gid * 8, gsz = (nM - fm) < 8 ? (nM - fm) : 8;
        u.pm = fm + ((wgid % nig) % gsz); u.pn = (wgid % nig) / gsz; u.aux = 0; u.slot = i;
        u.A = A + (size_t)u.pm * tstepA; u.B = B + (size_t)u.pn * tstepB; return true;
    }
    __device__ __forceinline__ int row(const pg8::Unit&, int r) const { return r; }
};
constexpr int MOE_MAXU = 8;
struct MoeSched {
    LAS const int* tab; int nunits; const char* A; const char* B; size_t strideA_tile, strideB_e, strideB_pn;
    __device__ __forceinline__ bool next(int i, pg8::Unit& u) const {
        if (i >= nunits) return false;
        const int tile = tab[128 + 4 * i], pn = tab[129 + 4 * i], e = tab[130 + 4 * i];
        u.pm = tile; u.pn = pn; u.aux = e | (tab[131 + 4 * i] << 8); u.slot = i;
        u.A = A + (size_t)tile * strideA_tile; u.B = B + (size_t)e * strideB_e + (size_t)pn * strideB_pn; return true;
    }
    __device__ __forceinline__ int row(const pg8::Unit& u, int r) const { return tab[256 + 256 * u.slot + r]; }
};

using pg8::cvt_pk_bf16;
#define EPI_ARGS const f32x4 (&acc)[2][2][4][2], const pg8::Unit& u, int wr, int wc, int fr, int fq

struct EpiProj {
    static constexpr bool PERM = true;
    bf16* P; float* rsq; float* rskv;
    __device__ __forceinline__ void operator()(EPI_ARGS) const {
        const int row0 = u.pm * 256 + wr * 64 + fr, col0 = u.pn * 256 + wc * 32 + 8 * fq;
#pragma unroll
        for (int ai = 0; ai < 2; ++ai)
#pragma unroll
            for (int m = 0; m < 4; ++m) {
                const int row = row0 + ai * 128 + m * 16; bf16* rowp = P + (size_t)row * DINP + col0;
                float ss0 = 0.f, ss1 = 0.f;
#pragma unroll
                for (int bj = 0; bj < 2; ++bj) { const f32x4 v0 = acc[ai][bj][m][0], v1 = acc[ai][bj][m][1];
                    u32x4 w; w.x = cvt_pk_bf16(v0[0], v0[1]); w.y = cvt_pk_bf16(v0[2], v0[3]); w.z = cvt_pk_bf16(v1[0], v1[1]); w.w = cvt_pk_bf16(v1[2], v1[3]);
                    *(u32x4*)(rowp + bj * 128) = w;
                    const float s = (v0[0] * v0[0] + v0[1] * v0[1]) + (v0[2] * v0[2] + v0[3] * v0[3]) + (v1[0] * v1[0] + v1[1] * v1[1]) + (v1[2] * v1[2] + v1[3] * v1[3]);
                    if (bj == 0) ss0 = s; else ss1 = s; }
                if (u.pn == 8) { float s = ss0 + ss1; s += __shfl_xor(s, 16); s += __shfl_xor(s, 32); if (fq == 0) rsq[row * 4 + wc] = s; }
                if (u.pn == 9) { float s = ss0; s += __shfl_xor(s, 16); s += __shfl_xor(s, 32); if (fq == 0) rskv[row * 4 + wc] = s; }
            }
    }
};
struct EpiUp {
    static constexpr bool PERM = true;
    bf16 *Q, *QI, *Kk, *VT; const float* rsq; const float* rskv;
    __device__ __forceinline__ void operator()(EPI_ARGS) const {
        const int row0 = u.pm * 256 + wr * 64 + fr, cl = wc * 32 + 8 * fq;
        const bool isq = u.pn < 3;
#pragma unroll
        for (int ai = 0; ai < 2; ++ai)
#pragma unroll
            for (int m = 0; m < 4; ++m) {
                const int row = row0 + ai * 128 + m * 16;
                const f32x4 pr = *(const f32x4*)((isq ? rsq : rskv) + row * 4);
                float rs = __builtin_amdgcn_rsqf(((pr[0] + pr[1]) + (pr[2] + pr[3])) * (isq ? (1.0f / 256.0f) : (1.0f / 128.0f)) + 1e-6f);
                if (u.pn < 2) rs *= 0.125f * LOG2E;
#pragma unroll
                for (int bj = 0; bj < 2; ++bj) { const f32x4 v0 = acc[ai][bj][m][0] * rs, v1 = acc[ai][bj][m][1] * rs; const int c = cl + bj * 128;
                    if (u.pn < 5) {
                        u32x4 w; w.x = cvt_pk_bf16(v0[0], v0[1]); w.y = cvt_pk_bf16(v0[2], v0[3]); w.z = cvt_pk_bf16(v1[0], v1[1]); w.w = cvt_pk_bf16(v1[2], v1[3]);
                        bf16* dst = u.pn < 2 ? Q + (size_t)row * 512 + u.pn * 256 + c : (u.pn == 2 ? QI + (size_t)row * 256 + c : Kk + (size_t)row * 512 + (u.pn - 3) * 256 + c);
                        *(u32x4*)dst = w;
                    } else {
                        const int vc = (u.pn - 5) * 256 + c, h = vc >> 6, d = vc & 63, b = row >> 11, t = row & 2047;
                        bf16* dst = VT + ((size_t)(b * 8 + h) * 64 + d) * SEQ + t;
#pragma unroll
                        for (int j = 0; j < 4; ++j) { dst[(size_t)j * SEQ] = (bf16)f2bf(v0[j]); dst[(size_t)(4 + j) * SEQ] = (bf16)f2bf(v1[j]); }
                    } }
            }
    }
};
struct EpiOut {
    static constexpr bool PERM = false;
    const float* x; float* pre;
    __device__ __forceinline__ void operator()(EPI_ARGS) const {
        const int row0 = u.pm * 256 + wr * 64 + fr, col0 = u.pn * 256 + wc * 32 + 4 * fq;
#pragma unroll
        for (int ai = 0; ai < 2; ++ai)
#pragma unroll
            for (int m = 0; m < 4; ++m) { const size_t off = (size_t)(row0 + ai * 128 + m * 16) * D + col0;
#pragma unroll
                for (int bj = 0; bj < 2; ++bj)
#pragma unroll
                    for (int n = 0; n < 2; ++n) { const f32x4 xv = *(const f32x4*)(x + off + bj * 128 + n * 16); *(f32x4*)(pre + off + bj * 128 + n * 16) = xv * ALPHA + acc[ai][bj][m][n]; } }
    }
};
struct EpiGU {
    static constexpr bool PERM = true;
    bf16* H;
    __device__ __forceinline__ void operator()(EPI_ARGS) const {
        const int row0 = u.pm * 256 + wr * 64 + fr, col0 = u.pn * 128 + wc * 32 + 8 * fq;
#pragma unroll
        for (int ai = 0; ai < 2; ++ai)
#pragma unroll
            for (int m = 0; m < 4; ++m) { const f32x4 g0 = acc[ai][0][m][0], g1 = acc[ai][0][m][1], u0 = acc[ai][1][m][0], u1 = acc[ai][1][m][1];
                float h[8];
#pragma unroll
                for (int j = 0; j < 4; ++j) { h[j] = siluf_(g0[j]) * u0[j]; h[4 + j] = siluf_(g1[j]) * u1[j]; }
                u32x4 w; w.x = cvt_pk_bf16(h[0], h[1]); w.y = cvt_pk_bf16(h[2], h[3]); w.z = cvt_pk_bf16(h[4], h[5]); w.w = cvt_pk_bf16(h[6], h[7]);
                *(u32x4*)(H + (size_t)(row0 + ai * 128 + m * 16) * DE + col0) = w; }
    }
};
struct EpiDown {
    static constexpr bool PERM = true;
    bf16* Y; const float* lw;
    __device__ __forceinline__ void operator()(EPI_ARGS) const {
        const int e = u.aux & 255, mt = u.aux >> 8;
        const int lr0 = wr * 64 + fr, col0 = wc * 32 + 8 * fq;
#pragma unroll
        for (int ai = 0; ai < 2; ++ai)
#pragma unroll
            for (int m = 0; m < 4; ++m) { const int lr = lr0 + ai * 128 + m * 16;
                const float wgt = e < NE ? lw[(size_t)e * T + mt * 256 + lr] : 1.0f;
                bf16* rowp = Y + (size_t)(u.pm * 256 + lr) * 256 + col0;
#pragma unroll
                for (int bj = 0; bj < 2; ++bj) { const f32x4 v0 = acc[ai][bj][m][0] * wgt, v1 = acc[ai][bj][m][1] * wgt;
                    u32x4 w; w.x = cvt_pk_bf16(v0[0], v0[1]); w.y = cvt_pk_bf16(v0[2], v0[3]); w.z = cvt_pk_bf16(v1[0], v1[1]); w.w = cvt_pk_bf16(v1[2], v1[3]);
                    *(u32x4*)(rowp + bj * 128) = w; } }
    }
};

__device__ __forceinline__ void tr_item(const float* src, int ldn, int k0, int n0, int nvalid, bf16* dst, int ldk, const float* kscale, LAS float* scr, int lane) {
#pragma unroll 8
    for (int i = 0; i < 32; ++i) { const int kk = 2 * i + (lane >> 5), n = lane & 31; float v = n < nvalid ? src[(size_t)(k0 + kk) * ldn + n0 + n] : 0.f; if (kscale) v *= kscale[k0 + kk]; scr[kk * 33 + n] = v; }
    LDS_WAIT();
    const int c = lane & 7;
#pragma unroll
    for (int j = 0; j < 4; ++j) { const int n = (lane >> 3) + 8 * j; const LAS float* s = scr + (8 * c) * 33 + n;
        u32x4 o; o.x = pk2(s[0 * 33], s[1 * 33]); o.y = pk2(s[2 * 33], s[3 * 33]); o.z = pk2(s[4 * 33], s[5 * 33]); o.w = pk2(s[6 * 33], s[7 * 33]);
        *(u32x4*)(dst + (size_t)n * ldk + 8 * c) = o; }
    LDS_WAIT();
}

struct Ptrs {
    const float* in[24]; float* out; unsigned char* ws;
};

__device__ __forceinline__ void phase_prep(const Ptrs& p, LAS unsigned char* lds, int vcu, int G) {
    const int tid = threadIdx.x, lane = tid & 63, wave = tid >> 6;
    LAS float* scr = (LAS float*)(lds + wave * 16384);
    const int gw = vcu * NWAVES + wave, NGW = G * NWAVES;
    bf16* WIN = (bf16*)(p.ws + WS_WIN); bf16* WUP = (bf16*)(p.ws + WS_WUP); bf16* WOUT = (bf16*)(p.ws + WS_WOUT); bf16* XB = (bf16*)(p.ws + WS_XB);
    constexpr int I_IN = 16 * 80, I_Q = 4 * 16, I_QI = 4 * 8, I_KV = 2 * 32, I_O = 16 * 32, NIT = I_IN + I_Q + I_QI + I_KV + I_O;
    for (int it = gw; it < NIT; it += NGW) {
        int r = it;
        if (r < I_IN) { const int kb = r / 80, nb = r % 80, n0 = nb * 32; int nv = DIN - n0; nv = nv < 0 ? 0 : (nv > 32 ? 32 : nv);
            tr_item(p.in[1], DIN, kb * 64, n0, nv, WIN + (size_t)n0 * D + kb * 64, D, nullptr, scr, lane); continue; } r -= I_IN;
        if (r < I_Q) { const int kb = r / 16, nb = r % 16; tr_item(p.in[5], 512, kb * 64, nb * 32, 32, WUP + (size_t)(nb * 32) * KUP + kb * 64, KUP, p.in[4], scr, lane); continue; } r -= I_Q;
        if (r < I_QI) { const int kb = r / 8, nb = r % 8; tr_item(p.in[6], 256, kb * 64, nb * 32, 32, WUP + (size_t)(512 + nb * 32) * KUP + kb * 64, KUP, p.in[4], scr, lane); continue; } r -= I_QI;
        if (r < I_KV) { const int kb = r / 32, nb = r % 32; tr_item(p.in[8], 1024, kb * 64, nb * 32, 32, WUP + (size_t)(768 + nb * 32) * KUP + 256 + kb * 64, KUP, p.in[7], scr, lane); continue; } r -= I_KV;
        { const int kb = r / 32, nb = r % 32; tr_item(p.in[11], D, kb * 64, nb * 32, 32, WOUT + (size_t)(nb * 32) * D + kb * 64, D, nullptr, scr, lane); }
    }
    const int gt = vcu * NTHR + tid, NGT = G * NTHR;
    if (gt < 512) ((float*)(p.ws + WS_LB))[gt] = 1.0f / (1.0f + __expf(p.in[2][512 + gt] - p.in[2][gt]));
    for (int ch = gt; ch < NUP * KUP / 8; ch += NGT) { const int r = ch / (KUP / 8), c = (ch % (KUP / 8)) * 8; if (r < 768 ? c >= 256 : c < 256) *(u32x4*)(WUP + (size_t)r * KUP + c) = (u32x4){0u, 0u, 0u, 0u}; }
    const float* x = p.in[0];
    for (int ch = gt; ch < T * D / 8; ch += NGT) { const f32x4 a = *(const f32x4*)(x + (size_t)ch * 8), b = *(const f32x4*)(x + (size_t)ch * 8 + 4);
        u32x4 o; o.x = pk2(a[0], a[1]); o.y = pk2(a[2], a[3]); o.z = pk2(b[0], b[1]); o.w = pk2(b[2], b[3]); *(u32x4*)(XB + (size_t)ch * 8) = o; }
}

__device__ __forceinline__ void phase_convert_experts(const Ptrs& p, LAS unsigned char* lds, int vcu, int G) {
    const int tid = threadIdx.x, lane = tid & 63, wave = tid >> 6;
    LAS float* scr = (LAS float*)(lds + wave * 16384);
    const int gw = vcu * NWAVES + wave, NGW = G * NWAVES;
    bf16* WGU = (bf16*)(p.ws + WS_WGU); bf16* WD = (bf16*)(p.ws + WS_WD);
    for (int it = gw; it < NEX * 384; it += NGW) {
        const int e = it / 384, r = it % 384, which = r / 128, r2 = r % 128;
        if (which < 2) {
            const float* src = e < NE ? p.in[16 + which] + (size_t)e * D * DE : p.in[19 + which];
            const int kb = r2 / 8, nb = r2 % 8, n0 = nb * 32, row0 = (n0 >> 7) * 256 + (n0 & 127) + which * 128;
            tr_item(src, DE, kb * 64, n0, 32, WGU + ((size_t)e * 512 + row0) * D + kb * 64, D, nullptr, scr, lane);
        } else {
            const float* src = e < NE ? p.in[18] + (size_t)e * DE * D : p.in[21];
            const int kb = r2 / 32, nb = r2 % 32;
            tr_item(src, D, kb * 64, nb * 32, 32, WD + ((size_t)e * D + nb * 32) * DE + kb * 64, DE, nullptr, scr, lane);
        }
    }
}

__device__ __forceinline__ void phase_kidx(const Ptrs& p, int vcu, int G) {
    const int tid = threadIdx.x, lane = tid & 63, wave = tid >> 6;
    const bf16* P = (const bf16*)(p.ws + WS_P); bf16* KIDX = (bf16*)(p.ws + WS_KIDX); float* WH = (float*)(p.ws + WS_WH);
    const float g = p.in[9][lane], bb = p.in[10][lane];
    for (int tok = vcu * NWAVES + wave; tok < T; tok += G * NWAVES) {
        const float v = bf2f(P[(size_t)tok * DINP + 2432 + lane]);
        const float mean = wave_sum(v) * (1.0f / 64.0f); const float dv = v - mean;
        const float var = wave_sum(dv * dv) * (1.0f / 64.0f);
        KIDX[(size_t)tok * 64 + lane] = (bf16)f2bf(dv * __builtin_amdgcn_rsqf(var + 1e-5f) * g + bb);
        if (lane < 4) WH[tok * 4 + lane] = bf2f(P[(size_t)tok * DINP + 2496 + lane]) * 0.0625f;
    }
}

constexpr int HG_B = 0, HG_TOT = 32768, HG_VT = 34816, HG_QD = 53248, HG_KI = 70656, HG_KD = 53248, HG_PART = 88064;
constexpr int HG_QP = 136;
__device__ __forceinline__ float fast_sigmoid(float x) { return __builtin_amdgcn_rcpf(1.0f + __builtin_amdgcn_exp2f(-x * LOG2E)); }
__device__ __forceinline__ float fast_exp(float x) { return __builtin_amdgcn_exp2f(x * LOG2E); }
template <int MODE> __device__ __forceinline__ void hgrn_stage(const Ptrs& p, int item, LAS unsigned char* lds) {
    const int tid = threadIdx.x, t = tid >> 3, blk = tid & 7;
    const int c = item & 31, h = (item >> 5) & 3, b = item >> 7;
    const bf16* P = (const bf16*)(p.ws + WS_P); const float* LB = (const float*)(p.ws + WS_LB) + h * 128 + blk * 16;
    LAS float* bc = (LAS float*)(lds + HG_B); LAS float* tot = (LAS float*)(lds + HG_TOT); LAS bf16* VT = (LAS bf16*)(lds + HG_VT);
    const bf16* prow = P + ((size_t)b * SEQ + c * 64 + t) * DINP + h * 128 + blk * 16;
    float kk[16];
    { const u32x4 a = *(const u32x4*)(prow + 512), a2 = *(const u32x4*)(prow + 512 + 8);
      const unsigned w[8] = {a.x, a.y, a.z, a.w, a2.x, a2.y, a2.z, a2.w};
#pragma unroll
      for (int j = 0; j < 16; ++j) { const float x = (j & 1) ? bfhi(w[j >> 1]) : bflo(w[j >> 1]); const float lb = LB[j], sg = fast_sigmoid(x);
          kk[j] = (1.0f - lb) * (1.0f - sg); bc[t * 128 + blk * 16 + j] = __logf(1.0f - kk[j]); } }
    __syncthreads();
    { const int d = tid & 127, part = tid >> 7; float s = 0.f;
#pragma unroll 4
      for (int i = 0; i < 16; ++i) { const int tt = part * 16 + i; s += bc[tt * 128 + d]; bc[tt * 128 + d] = s; }
      tot[part * 128 + d] = s;
      __syncthreads();
      float off = 0.f;
      for (int q = 0; q < part; ++q) off += tot[q * 128 + d];
      if (part > 0) {
#pragma unroll 4
          for (int i = 0; i < 16; ++i) bc[(part * 16 + i) * 128 + d] += off; } }
    __syncthreads();
    { const u32x4 a = *(const u32x4*)(prow + 1024), a2 = *(const u32x4*)(prow + 1024 + 8);
      const unsigned w[8] = {a.x, a.y, a.z, a.w, a2.x, a2.y, a2.z, a2.w};
#pragma unroll
      for (int j = 0; j < 8; ++j) { VT[(blk * 16 + 2 * j) * 72 + t] = (bf16)(w[j] & 0xffffu); VT[(blk * 16 + 2 * j + 1) * 72 + t] = (bf16)(w[j] >> 16); } }
    if (MODE == 1) {
        LAS bf16* KD = (LAS bf16*)(lds + HG_KD);
#pragma unroll
        for (int j = 0; j < 16; ++j) { const int d = blk * 16 + j; KD[d * 72 + t] = (bf16)f2bf(kk[j] * fast_exp(bc[63 * 128 + d] - bc[t * 128 + d])); }
        if (tid < 128) ((float*)(p.ws + WS_DEC))[item * 128 + tid] = fast_exp(bc[63 * 128 + tid]);
    } else {
        LAS bf16* QD = (LAS bf16*)(lds + HG_QD); LAS bf16* KI = (LAS bf16*)(lds + HG_KI);
        const u32x4 a = *(const u32x4*)prow, a2 = *(const u32x4*)(prow + 8);
        const unsigned w[8] = {a.x, a.y, a.z, a.w, a2.x, a2.y, a2.z, a2.w};
        unsigned oq[8], ok[8];
#pragma unroll
        for (int j = 0; j < 8; ++j) { const float b0 = bc[t * 128 + blk * 16 + 2 * j], b1 = bc[t * 128 + blk * 16 + 2 * j + 1]; const float x0 = bflo(w[j]), x1 = bfhi(w[j]);
            oq[j] = pk2(x0 * fast_sigmoid(x0) * fast_exp(b0), x1 * fast_sigmoid(x1) * fast_exp(b1));
            ok[j] = pk2(kk[2 * j] * fast_exp(-b0), kk[2 * j + 1] * fast_exp(-b1)); }
        *(LAS u32x4*)(QD + t * HG_QP + blk * 16) = (u32x4){oq[0], oq[1], oq[2], oq[3]}; *(LAS u32x4*)(QD + t * HG_QP + blk * 16 + 8) = (u32x4){oq[4], oq[5], oq[6], oq[7]};
        *(LAS u32x4*)(KI + t * HG_QP + blk * 16) = (u32x4){ok[0], ok[1], ok[2], ok[3]}; *(LAS u32x4*)(KI + t * HG_QP + blk * 16 + 8) = (u32x4){ok[4], ok[5], ok[6], ok[7]};
    }
    __syncthreads();
}
__device__ __forceinline__ void hgrn1_item(const Ptrs& p, int item, LAS unsigned char* lds) {
    const int tid = threadIdx.x, lane = tid & 63, w = tid >> 6;
    hgrn_stage<1>(p, item, lds);
    LAS bf16* KD = (LAS bf16*)(lds + HG_KD); LAS bf16* VT = (LAS bf16*)(lds + HG_VT);
    bf16* DS = (bf16*)(p.ws + WS_DS) + (size_t)item * 16384;
    { const int cc = lane & 15, g = lane >> 4;
      bf16x8 af[2];
#pragma unroll
      for (int ks = 0; ks < 2; ++ks) af[ks] = *(const LAS bf16x8*)(KD + (16 * w + cc) * 72 + 32 * ks + 8 * g);
#pragma unroll
      for (int vt = 0; vt < 8; ++vt) {
          f32x4 C = {0.f, 0.f, 0.f, 0.f};
#pragma unroll
          for (int ks = 0; ks < 2; ++ks) { const bf16x8 bfm = *(const LAS bf16x8*)(VT + (16 * vt + cc) * 72 + 32 * ks + 8 * g); C = __builtin_amdgcn_mfma_f32_16x16x32_bf16(af[ks], bfm, C, 0, 0, 0); }
          u32x2 o; o.x = pk2(C[0], C[1]); o.y = pk2(C[2], C[3]);
          *(u32x2*)(DS + (size_t)(16 * vt + cc) * 128 + 16 * w + 4 * g) = o; } }
    __syncthreads();
}
__device__ __forceinline__ void phase_scan(const Ptrs& p, int vcu, int G) {
    const bf16* DS = (const bf16*)(p.ws + WS_DS); bf16* SP = (bf16*)(p.ws + WS_SP); const float* DEC = (const float*)(p.ws + WS_DEC);
    for (int gt = vcu * NTHR + threadIdx.x; gt < 32 * 4096; gt += G * NTHR) {
        const int bh = gt >> 12, e4 = gt & 4095, d0 = (e4 & 31) * 4; const size_t eo = (size_t)(e4 >> 5) * 128 + d0;
        float S0 = 0.f, S1 = 0.f, S2 = 0.f, S3 = 0.f;
#pragma unroll 4
        for (int c = 0; c < 32; ++c) { const size_t item = (size_t)bh * 32 + c;
            const u32x2 ds = *(const u32x2*)(DS + item * 16384 + eo); const f32x4 dc = *(const f32x4*)(DEC + item * 128 + d0);
            u32x2 o; o.x = pk2(S0, S1); o.y = pk2(S2, S3); *(u32x2*)(SP + item * 16384 + eo) = o;
            S0 = dc[0] * S0 + bflo(ds.x); S1 = dc[1] * S1 + bfhi(ds.x); S2 = dc[2] * S2 + bflo(ds.y); S3 = dc[3] * S3 + bfhi(ds.y); }
    }
}
__device__ __forceinline__ void hgrn3_item(const Ptrs& p, int item, LAS unsigned char* lds) {
    const int tid = threadIdx.x, lane = tid & 63, w = tid >> 6, cc = lane & 15, g = lane >> 4;
    const int c = item & 31, h = (item >> 5) & 3, b = item >> 7;
    const bf16* P = (const bf16*)(p.ws + WS_P);
    hgrn_stage<3>(p, item, lds);
    LAS bf16* VT = (LAS bf16*)(lds + HG_VT); LAS float* part = (LAS float*)(lds + HG_PART); LAS bf16* QD = (LAS bf16*)(lds + HG_QD); LAS bf16* KI = (LAS bf16*)(lds + HG_KI);
    const int tt = w & 3, vh = w >> 2;
    const size_t tok0 = (size_t)b * SEQ + c * 64;
    bf16x8 qd[4];
#pragma unroll
    for (int ks = 0; ks < 4; ++ks) qd[ks] = *(const LAS bf16x8*)(QD + (16 * tt + cc) * HG_QP + 32 * ks + 8 * g);
    u32x2 scb[4];
#pragma unroll
    for (int st = 0; st < 4; ++st) {
        scb[st] = (u32x2){0u, 0u};
        if (st <= tt) {
            f32x4 C = {0.f, 0.f, 0.f, 0.f};
#pragma unroll
            for (int ks = 0; ks < 4; ++ks) C = __builtin_amdgcn_mfma_f32_16x16x32_bf16(*(const LAS bf16x8*)(KI + (16 * st + cc) * HG_QP + 32 * ks + 8 * g), qd[ks], C, 0, 0, 0);
#pragma unroll
            for (int i = 0; i < 4; ++i) if (16 * st + 4 * g + i > 16 * tt + cc) C[i] = 0.f;
            scb[st] = (u32x2){pk2(C[0], C[1]), pk2(C[2], C[3])};
        }
    }
    const bf16* SPi = (const bf16*)(p.ws + WS_SP) + (size_t)item * 16384;
    f32x4 o[4]; float ss = 0.f;
#pragma unroll
    for (int vi = 0; vi < 4; ++vi) { const int vt = 4 * vh + vi; f32x4 C = {0.f, 0.f, 0.f, 0.f};
#pragma unroll
        for (int ks = 0; ks < 4; ++ks) { const bf16x8 sp = *(const bf16x8*)(SPi + (size_t)(16 * vt + cc) * 128 + 32 * ks + 8 * g); C = __builtin_amdgcn_mfma_f32_16x16x32_bf16(sp, qd[ks], C, 0, 0, 0); }
#pragma unroll
        for (int kp = 0; kp < 2; ++kp) if (2 * kp <= tt) {
            const u32x2 v0 = *(const LAS u32x2*)(VT + (16 * vt + cc) * 72 + 32 * kp + 4 * g), v1 = *(const LAS u32x2*)(VT + (16 * vt + cc) * 72 + 32 * kp + 16 + 4 * g);
            C = __builtin_amdgcn_mfma_f32_16x16x32_bf16(__builtin_bit_cast(bf16x8, (u32x4){v0.x, v0.y, v1.x, v1.y}), __builtin_bit_cast(bf16x8, (u32x4){scb[2 * kp].x, scb[2 * kp].y, scb[2 * kp + 1].x, scb[2 * kp + 1].y}), C, 0, 0, 0); }
        o[vi] = C; ss += (C[0] * C[0] + C[1] * C[1]) + (C[2] * C[2] + C[3] * C[3]); }
    ss += __shfl_xor(ss, 16); ss += __shfl_xor(ss, 32);
    if (g == 0) part[vh * 64 + 16 * tt + cc] = ss;
    __syncthreads();
    const float rstd = __builtin_amdgcn_rsqf((part[16 * tt + cc] + part[64 + 16 * tt + cc]) * (1.0f / 128.0f) + 1e-6f);
    bf16* OC = (bf16*)(p.ws + WS_XB);
    { const size_t tok = tok0 + 16 * tt + cc;
#pragma unroll
      for (int vi = 0; vi < 4; ++vi) { const int v0 = 16 * (4 * vh + vi) + 4 * g;
          const u32x2 gt = *(const u32x2*)(P + tok * DINP + 1536 + h * 128 + v0); const f32x4 ng = *(const f32x4*)(p.in[3] + v0);
          u32x2 ov; ov.x = pk2(o[vi][0] * rstd * ng[0] * siluf_(bflo(gt.x)), o[vi][1] * rstd * ng[1] * siluf_(bfhi(gt.x)));
          ov.y = pk2(o[vi][2] * rstd * ng[2] * siluf_(bflo(gt.y)), o[vi][3] * rstd * ng[3] * siluf_(bfhi(gt.y)));
          *(u32x2*)(OC + tok * D + h * 128 + v0) = ov; } }
    __syncthreads();
}

constexpr int IX_P = 2052;
__device__ __forceinline__ void cnt_ge_u32(int& cnt, unsigned a, unsigned b) { asm("v_cmp_ge_u32 vcc, %1, %2\n\tv_addc_co_u32 %0, vcc, 0, %0, vcc" : "+v"(cnt) : "v"(a), "v"(b) : "vcc"); }
__device__ __forceinline__ void cnt_le_u32(int& cnt, unsigned a, unsigned b) { asm("v_cmp_le_u32 vcc, %1, %2\n\tv_addc_co_u32 %0, vcc, 0, %0, vcc" : "+v"(cnt) : "v"(a), "v"(b) : "vcc"); }
__device__ __forceinline__ void cnt_gt_u64(int& cnt, unsigned long long a, unsigned long long b) { asm("v_cmp_gt_u64 vcc, %1, %2\n\tv_addc_co_u32 %0, vcc, 0, %0, vcc" : "+v"(cnt) : "v"(a), "v"(b) : "vcc"); }
__device__ __forceinline__ unsigned ord_u32(float f) { unsigned b = __builtin_bit_cast(unsigned, f); if (b == 0x80000000u) b = 0u; return (b & 0x80000000u) ? ~b : (b | 0x80000000u); }
__device__ __forceinline__ int bcnt_ge(unsigned a, unsigned sb) { int r; asm("v_cmp_le_u32 vcc, %2, %1\n\ts_bcnt1_i32_b64 %0, vcc" : "=s"(r) : "v"(a), "s"(sb) : "vcc", "scc"); return r; }
__device__ __forceinline__ int bcnt_le(unsigned a, unsigned sb) { int r; asm("v_cmp_ge_u32 vcc, %2, %1\n\ts_bcnt1_i32_b64 %0, vcc" : "=s"(r) : "v"(a), "s"(sb) : "vcc", "scc"); return r; }
template <int NR> __device__ __forceinline__ void topk_row(const LAS unsigned* srow, int nreg, int lane, unsigned* maskrow  ) {
    unsigned u[NR];
#pragma unroll
    for (int j = 0; j < NR; ++j) u[j] = srow[64 * j + lane];
    unsigned Tt = 0u;
#pragma unroll 1
    for (int bit = 31; bit >= 0; --bit) {
        const unsigned cand = (unsigned)__builtin_amdgcn_readfirstlane((int)(Tt | (1u << bit))); int cnt = 0;
#pragma unroll
        for (int j = 0; j < NR; ++j) cnt += bcnt_ge(u[j], cand);
        if (cnt >= 256) Tt = cand;
        if (cnt == 256) break;
    }
    int cgt = 0, ceq = 0;
#pragma unroll
    for (int j = 0; j < NR; ++j) { const unsigned uu = u[j]; cgt += __popcll(__ballot(uu > Tt)); ceq += __popcll(__ballot(uu == Tt));
        u[j] = uu > Tt ? 0u : (uu == Tt ? (unsigned)(1 + 64 * j + lane) : 4096u); }
    unsigned X = 2048u;
    if (cgt + ceq > 256) {
        unsigned Xb = 0u;
#pragma unroll 1
        for (int bit = 11; bit >= 0; --bit) {
            const unsigned cand = (unsigned)__builtin_amdgcn_readfirstlane((int)(Xb | (1u << bit))); int cnt = 0;
#pragma unroll
            for (int j = 0; j < NR; ++j) cnt += bcnt_le(u[j], cand);
            if (cnt <= 256) Xb = cand;
        }
        X = Xb;
    }
    unsigned myword = 0u;
#pragma unroll
    for (int j = 0; j < NR; ++j) { const unsigned long long bal = __ballot(u[j] <= X); if ((lane >> 1) == j) myword = (lane & 1) ? (unsigned)(bal >> 32) : (unsigned)bal; }
    if (lane < 2 * nreg) maskrow[(size_t)lane * SEQ] = myword;
}
__device__ __forceinline__ void indexer_item(const Ptrs& p, int item, LAS unsigned char* lds) {
    const int tid = threadIdx.x, lane = tid & 63, w = __builtin_amdgcn_readfirstlane(tid >> 6), q = lane & 15, g = lane >> 4;
    const int b = item >> 7, qg = item & 127, c = qg >> 2, nw = 2 * (c + 1);
    unsigned* MASKT = (unsigned*)(p.ws + WS_MASK) + (size_t)b * 64 * SEQ;
    if (c < 4) { for (int idx = tid; idx < nw * 16; idx += NTHR) MASKT[(size_t)(idx >> 4) * SEQ + qg * 16 + (idx & 15)] = 0xFFFFFFFFu; return; }
    const bf16* QI = (const bf16*)(p.ws + WS_QI); const bf16* KIDX = (const bf16*)(p.ws + WS_KIDX); const float* WH = (const float*)(p.ws + WS_WH);
    LAS unsigned* S = (LAS unsigned*)lds;
    {
        const size_t tokq = (size_t)b * SEQ + qg * 16 + q;
        bf16x8 qf[4][2]; float wq[4];
#pragma unroll
        for (int h = 0; h < 4; ++h) { wq[h] = WH[tokq * 4 + h];
#pragma unroll
            for (int ks = 0; ks < 2; ++ks) qf[h][ks] = *(const bf16x8*)(QI + tokq * 256 + h * 64 + 32 * ks + 8 * g); }
        const int ntile = 4 * (c + 1);
#pragma unroll 2
        for (int j = w; j < ntile; j += 8) {
            const bf16* kp = KIDX + ((size_t)b * SEQ + 16 * j + q) * 64 + 8 * g;
            const bf16x8 k0 = *(const bf16x8*)kp, k1 = *(const bf16x8*)(kp + 32);
            float sc[4] = {0.f, 0.f, 0.f, 0.f};
#pragma unroll
            for (int h = 0; h < 4; ++h) { f32x4 C = {0.f, 0.f, 0.f, 0.f};
                C = __builtin_amdgcn_mfma_f32_16x16x32_bf16(k0, qf[h][0], C, 0, 0, 0); C = __builtin_amdgcn_mfma_f32_16x16x32_bf16(k1, qf[h][1], C, 0, 0, 0);
#pragma unroll
                for (int i = 0; i < 4; ++i) sc[i] += wq[h] * fmaxf(C[i], 0.f); }
            *(LAS u32x4*)(S + q * IX_P + 16 * j + 4 * g) = (u32x4){ord_u32(sc[0]), ord_u32(sc[1]), ord_u32(sc[2]), ord_u32(sc[3])};
        }
    }
    {
        const int nend = ((c + 8) & ~7) * 64, n0 = 64 * (c + 1);
        for (int idx = tid; idx < 16 * ((nend - n0) >> 2); idx += NTHR) { const int per = (nend - n0) >> 2, r = idx / per, k4 = idx % per; *(LAS u32x4*)(S + r * IX_P + n0 + 4 * k4) = (u32x4){0u, 0u, 0u, 0u}; }
    }
    __syncthreads();
    {
        const int nreg = c + 1;
#pragma unroll 1
        for (int rr = 0; rr < 2; ++rr) { const int row = 2 * w + rr; const LAS unsigned* srow = S + row * IX_P; unsigned* mrow = MASKT + qg * 16 + row;
            if (nreg <= 8) topk_row<8>(srow, nreg, lane, mrow); else if (nreg <= 16) topk_row<16>(srow, nreg, lane, mrow);
            else if (nreg <= 24) topk_row<24>(srow, nreg, lane, mrow); else topk_row<32>(srow, nreg, lane, mrow); }
    }
    __syncthreads();
}

__device__ __forceinline__ int crow(int r, int hi) { return (r & 3) + 8 * (r >> 2) + 4 * hi; }
constexpr int AT_KP = 144, AT_VP = 136, AT_KB = 64 * AT_KP, AT_VB = 64 * AT_VP, AT_STAGE = AT_KB + AT_VB;
__device__ __forceinline__ void attn_unit(const Ptrs& p, int b, int h, int QB, LAS unsigned char* lds) {
    const int tid = threadIdx.x, lane = tid & 63, w = __builtin_amdgcn_readfirstlane(tid >> 6), q = lane & 31, hh = lane >> 5;
    const int tq = 256 * QB + 32 * w + q, NT = 4 * QB + 4, ntw = 4 * QB + (w >> 1) + 1;
    const size_t tok = (size_t)b * SEQ + tq;
    const bf16* Q = (const bf16*)(p.ws + WS_Q); const bf16* Kb = (const bf16*)(p.ws + WS_K) + (size_t)b * SEQ * 512 + h * 64;
    const bf16* VTb = (const bf16*)(p.ws + WS_VT) + (size_t)(b * 8 + h) * 64 * SEQ; const unsigned* MASKT = (const unsigned*)(p.ws + WS_MASK) + (size_t)b * 64 * SEQ;
    const float slope2 = __builtin_amdgcn_exp2f(-(float)(h + 1)) * LOG2E;
    bf16x8 qf[4];
#pragma unroll
    for (int ks = 0; ks < 4; ++ks) qf[ks] = *(const bf16x8*)(Q + tok * 512 + h * 64 + 16 * ks + 8 * hh);
    const int srow = tid >> 3, sch = tid & 7;
    const bf16* kg = Kb + (size_t)srow * 512 + sch * 8; const bf16* vg = VTb + (size_t)srow * SEQ + sch * 8;
    const int kso = srow * AT_KP + sch * 16, vso = AT_KB + srow * AT_VP + sch * 16;
    u32x4 kreg = *(const u32x4*)kg, vreg = *(const u32x4*)vg;
    *(LAS u32x4*)(lds + kso) = kreg; *(LAS u32x2*)(lds + vso) = (u32x2){vreg.x, vreg.y}; *(LAS u32x2*)(lds + vso + 8) = (u32x2){vreg.z, vreg.w};
    __syncthreads();
    f32x16 o0 = {}, o1 = {}; float m = -INFINITY, l = 0.f;
    for (int kt = 0; kt < NT; ++kt) {
        const bool more = kt + 1 < NT;
        if (more) { kreg = *(const u32x4*)(kg + (size_t)(kt + 1) * 64 * 512); vreg = *(const u32x4*)(vg + (kt + 1) * 64); }
        if (kt < ntw) {
            LAS const unsigned char* sb = lds + (kt & 1) * AT_STAGE;
            f32x16 S0 = {}, S1 = {};
#pragma unroll
            for (int ks = 0; ks < 4; ++ks) {
                const bf16x8 k0 = *(LAS const bf16x8*)(sb + q * AT_KP + 32 * ks + 16 * hh), k1 = *(LAS const bf16x8*)(sb + (32 + q) * AT_KP + 32 * ks + 16 * hh);
                S0 = __builtin_amdgcn_mfma_f32_32x32x16_bf16(k0, qf[ks], S0, 0, 0, 0); S1 = __builtin_amdgcn_mfma_f32_32x32x16_bf16(k1, qf[ks], S1, 0, 0, 0); }
            const unsigned w0 = MASKT[(size_t)(2 * kt) * SEQ + tq], w1 = MASKT[(size_t)(2 * kt + 1) * SEQ + tq];
            float rm = -INFINITY;
#pragma unroll
            for (int r = 0; r < 16; ++r) { const int cr = crow(r, hh), key = 64 * kt + cr; const int d0 = tq > key ? tq - key : key - tq; const int key1 = key + 32; const int d1 = tq > key1 ? tq - key1 : key1 - tq;
                const float a = ((w0 >> cr) & 1u) ? S0[r] - slope2 * (float)d0 : -INFINITY; const float c = ((w1 >> cr) & 1u) ? S1[r] - slope2 * (float)d1 : -INFINITY;
                S0[r] = a; S1[r] = c; rm = fmaxf(rm, fmaxf(a, c)); }
            rm = fmaxf(rm, __shfl_xor(rm, 32));
            const float mn = fmaxf(m, rm), mu = (mn == -INFINITY) ? 0.f : mn, alpha = __builtin_amdgcn_exp2f(m - mu);
            float ls = 0.f;
#pragma unroll
            for (int r = 0; r < 16; ++r) { S0[r] = __builtin_amdgcn_exp2f(S0[r] - mu); S1[r] = __builtin_amdgcn_exp2f(S1[r] - mu); ls += S0[r] + S1[r]; }
            l = l * alpha + ls; m = mn;
#pragma unroll
            for (int r = 0; r < 16; ++r) { o0[r] *= alpha; o1[r] *= alpha; }
            LAS const unsigned char* vb = sb + AT_KB;
#pragma unroll
            for (int s2 = 0; s2 < 4; ++s2) {
                const bf16x8 pa = (s2 < 2)
                    ? __builtin_bit_cast(bf16x8, (u32x4){pk2(S0[8 * (s2 & 1)], S0[8 * (s2 & 1) + 1]), pk2(S0[8 * (s2 & 1) + 2], S0[8 * (s2 & 1) + 3]), pk2(S0[8 * (s2 & 1) + 4], S0[8 * (s2 & 1) + 5]), pk2(S0[8 * (s2 & 1) + 6], S0[8 * (s2 & 1) + 7])})
                    : __builtin_bit_cast(bf16x8, (u32x4){pk2(S1[8 * (s2 & 1)], S1[8 * (s2 & 1) + 1]), pk2(S1[8 * (s2 & 1) + 2], S1[8 * (s2 & 1) + 3]), pk2(S1[8 * (s2 & 1) + 4], S1[8 * (s2 & 1) + 5]), pk2(S1[8 * (s2 & 1) + 6], S1[8 * (s2 & 1) + 7])});
                const u32x2 a0 = *(LAS const u32x2*)(vb + q * AT_VP + 32 * s2 + 8 * hh), a1 = *(LAS const u32x2*)(vb + q * AT_VP + 32 * s2 + 8 * hh + 16);
                const u32x2 c0 = *(LAS const u32x2*)(vb + (32 + q) * AT_VP + 32 * s2 + 8 * hh), c1 = *(LAS const u32x2*)(vb + (32 + q) * AT_VP + 32 * s2 + 8 * hh + 16);
                o0 = __builtin_amdgcn_mfma_f32_32x32x16_bf16(__builtin_bit_cast(bf16x8, (u32x4){a0.x, a0.y, a1.x, a1.y}), pa, o0, 0, 0, 0);
                o1 = __builtin_amdgcn_mfma_f32_32x32x16_bf16(__builtin_bit_cast(bf16x8, (u32x4){c0.x, c0.y, c1.x, c1.y}), pa, o1, 0, 0, 0); }
        }
        if (more) { const int so = ((kt + 1) & 1) * AT_STAGE; *(LAS u32x4*)(lds + so + kso) = kreg; *(LAS u32x2*)(lds + so + vso) = (u32x2){vreg.x, vreg.y}; *(LAS u32x2*)(lds + so + vso + 8) = (u32x2){vreg.z, vreg.w}; }
        __syncthreads();
    }
    l += __shfl_xor(l, 32);
    const float inv = 1.0f / l;
    bf16* OC = (bf16*)(p.ws + WS_XB) + tok * D + 512 + h * 64;
#pragma unroll
    for (int r4 = 0; r4 < 4; ++r4) {
        u32x2 a; a.x = pk2(o0[4 * r4] * inv, o0[4 * r4 + 1] * inv); a.y = pk2(o0[4 * r4 + 2] * inv, o0[4 * r4 + 3] * inv); *(u32x2*)(OC + 8 * r4 + 4 * hh) = a;
        u32x2 c; c.x = pk2(o1[4 * r4] * inv, o1[4 * r4 + 1] * inv); c.y = pk2(o1[4 * r4 + 2] * inv, o1[4 * r4 + 3] * inv); *(u32x2*)(OC + 32 + 8 * r4 + 4 * hh) = c; }
}

constexpr int R6_HP = 1028;
constexpr int R6_HBUF = 0, R6_PART = 16 * R6_HP * 4, R6_LCNT = R6_PART + 8 * 16 * 64 * 4, R6_GBASE = R6_LCNT + 256, R6_ENT = R6_GBASE + 256;
__device__ __forceinline__ void phase_ln1_router(const Ptrs& p, LAS unsigned char* lds, int vcu, int G) {
    const int tid = threadIdx.x, lane = tid & 63, wave = __builtin_amdgcn_readfirstlane(tid >> 6);
    LAS float* hbuf = (LAS float*)(lds + R6_HBUF); LAS float* part = (LAS float*)(lds + R6_PART);
    LAS int* lcnt = (LAS int*)(lds + R6_LCNT); LAS int* gbase = (LAS int*)(lds + R6_GBASE); LAS int* ent = (LAS int*)(lds + R6_ENT);
    const float* pre = (const float*)(p.ws + WS_HB); bf16* H1B = (bf16*)(p.ws + WS_XB);
    const float* g1 = p.in[12]; const float* b1 = p.in[13]; const float* Wr = p.in[14]; const float rbias = p.in[15][lane];
    unsigned* cnt = (unsigned*)(p.ws + WS_CTL) + CW_CNT; int* LTOK = (int*)(p.ws + WS_LTOK); float* LW = (float*)(p.ws + WS_LW); unsigned* ROUTE = (unsigned*)(p.ws + WS_ROUTE);
    for (int tile = vcu; tile < T / 64; tile += G) {
        if (tid < 64) lcnt[tid] = 0;
        for (int sub = 0; sub < 4; ++sub) {
            const int tok0 = tile * 64 + sub * 16;
#pragma unroll
            for (int j2 = 0; j2 < 2; ++j2) { const int tl = 2 * wave + j2; const size_t tok = tok0 + tl;
                f32x4 v[4]; float s = 0.f;
#pragma unroll
                for (int jj = 0; jj < 4; ++jj) { v[jj] = *(const f32x4*)(pre + tok * D + 4 * lane + 256 * jj); s += (v[jj][0] + v[jj][1]) + (v[jj][2] + v[jj][3]); }
                const float mean = wave_sum(s) * (1.0f / D); float s2 = 0.f;
#pragma unroll
                for (int jj = 0; jj < 4; ++jj) { v[jj] = v[jj] - mean; s2 += (v[jj][0] * v[jj][0] + v[jj][1] * v[jj][1]) + (v[jj][2] * v[jj][2] + v[jj][3] * v[jj][3]); }
                const float rstd = 1.0f / sqrtf(wave_sum(s2) * (1.0f / D) + 1e-5f);
#pragma unroll
                for (int jj = 0; jj < 4; ++jj) { const int c0 = 4 * lane + 256 * jj; const f32x4 gg = *(const f32x4*)(g1 + c0), bb = *(const f32x4*)(b1 + c0);
                    const f32x4 hv = v[jj] * rstd * gg + bb;
                    u32x2 o; o.x = pk2(hv[0], hv[1]); o.y = pk2(hv[2], hv[3]); *(u32x2*)(H1B + tok * D + c0) = o;
                    *(LAS f32x4*)(hbuf + tl * R6_HP + c0) = hv; } }
            __syncthreads();
            { f32x4 acc[4];
#pragma unroll
              for (int nt = 0; nt < 4; ++nt) acc[nt] = (f32x4){0.f, 0.f, 0.f, 0.f};
              const LAS float* ap = hbuf + (lane & 15) * R6_HP + 128 * wave + (lane >> 4); const float* bp = Wr + (size_t)(128 * wave + (lane >> 4)) * 64 + (lane & 15);
#pragma unroll 8
              for (int ks = 0; ks < 32; ++ks) { const float a = ap[4 * ks];
#pragma unroll
                  for (int nt = 0; nt < 4; ++nt) acc[nt] = __builtin_amdgcn_mfma_f32_16x16x4f32(a, bp[(size_t)ks * 256 + 16 * nt], acc[nt], 0, 0, 0); }
#pragma unroll
              for (int nt = 0; nt < 4; ++nt)
#pragma unroll
                  for (int r = 0; r < 4; ++r) part[(wave * 16 + (lane >> 4) * 4 + r) * 64 + 16 * nt + (lane & 15)] = acc[nt][r]; }
            __syncthreads();
#pragma unroll 1
            for (int j2 = 0; j2 < 2; ++j2) { const int tl = 2 * wave + j2; float logit = 0.f;
#pragma unroll
                for (int ww = 0; ww < 8; ++ww) logit += part[(ww * 16 + tl) * 64 + lane];
                const float score = sigmoidf_(logit); const float sel = score + rbias;
                float m1 = sel; m1 = fmaxf(m1, __shfl_xor(m1, 1)); m1 = fmaxf(m1, __shfl_xor(m1, 2)); m1 = fmaxf(m1, __shfl_xor(m1, 4));
                const unsigned long long bm = __ballot(sel == m1) & (0xFFull << (lane & 56));
                const int first = __ffsll((long long)bm) - 1;
                float m2 = (lane == first) ? -INFINITY : sel; m2 = fmaxf(m2, __shfl_xor(m2, 1)); m2 = fmaxf(m2, __shfl_xor(m2, 2)); m2 = fmaxf(m2, __shfl_xor(m2, 4));
                const float gs = m1 + m2; const int grpi = lane >> 3; int grank = 0;
#pragma unroll
                for (int j = 0; j < 8; ++j) { const float gj = __shfl(gs, j * 8); grank += (gj > gs || (gj == gs && j < grpi)) ? 1 : 0; }
                const float selm = grank < 4 ? sel : -INFINITY; int rank = 0;
                const unsigned long long mykey = ((unsigned long long)ord_u32(selm) << 8) | (unsigned)(63 - lane);
#pragma unroll
                for (int j = 0; j < 64; ++j) { const unsigned long long kj = ((unsigned long long)(unsigned)__shfl((int)(mykey >> 8), j) << 8) | (unsigned)(63 - j); cnt_gt_u64(rank, kj, mykey); }
                const bool chosen = rank < TOPK;
                const float wsum = wave_sum(chosen ? score : 0.f); const float wgt = score / wsum * 2.5f;
                const unsigned long long cm = __ballot(chosen); const int k = __popcll(cm & ((1ull << lane) - 1ull));
                if (chosen) { const int lpos = __hip_atomic_fetch_add(lcnt + lane, 1, __ATOMIC_RELAXED, __HIP_MEMORY_SCOPE_WORKGROUP);
                    LAS int* en = ent + ((sub * 16 + tl) * 8 + k) * 3; en[0] = lane; en[1] = lpos; en[2] = __builtin_bit_cast(int, wgt); } }
            __syncthreads();
        }
        if (tid < 64) gbase[tid] = (int)atomicAdd(cnt + 64 * tid, (unsigned)lcnt[tid]);
        __syncthreads();
        { const int tl = tid >> 3, k = tid & 7; const LAS int* en = ent + (tl * 8 + k) * 3; const int e = en[0], pos = gbase[e] + en[1], tok = tile * 64 + tl;
          LTOK[(size_t)e * T + pos] = tok; LW[(size_t)e * T + pos] = __builtin_bit_cast(float, en[2]); ROUTE[(size_t)tok * 8 + k] = ((unsigned)e << 16) | (unsigned)pos; }
        __syncthreads();
    }
}

__device__ __forceinline__ int moe_tables(const Ptrs& p, LAS int* tab, int nN, bool gather, int v, int G) {
    const int tid = threadIdx.x;
    const unsigned* cnt = (const unsigned*)(p.ws + WS_CTL) + CW_CNT; const int* LTOK = (const int*)(p.ws + WS_LTOK);
    if (tid == 0) { int s = 0; for (int e = 0; e < NE; ++e) { tab[e] = s; s += ((int)cnt[64 * e] + 255) >> 8; } tab[NE] = s; tab[NE + 1] = s + T / 256; }
    __syncthreads();
    const int total = tab[NE + 1] * nN;
    int nunits = 0; for (int i = 0; i < MOE_MAXU; ++i) if ((long)i * G + v < total) nunits = i + 1;
    if (tid < nunits) { const int L = tid * G + v, tile = L / nN, pn = L % nN; int e = 0; while (tab[e + 1] <= tile) ++e;
        tab[128 + 4 * tid] = tile; tab[129 + 4 * tid] = pn; tab[130 + 4 * tid] = e; tab[131 + 4 * tid] = tile - tab[e]; }
    __syncthreads();
    if (gather) for (int idx = tid; idx < nunits * 256; idx += NTHR) { const int i = idx >> 8, r = idx & 255, e = tab[130 + 4 * i], mt = tab[131 + 4 * i], pos = mt * 256 + r;
        tab[256 + idx] = e < NE ? (pos < (int)cnt[64 * e] ? LTOK[(size_t)e * T + pos] : 0) : pos; }
    __syncthreads();
    return nunits;
}

__device__ __forceinline__ void phase_combine(const Ptrs& p, LAS int* tab, int j, int vcu, int G) {
    const int tid = threadIdx.x, lane = tid & 63, wave = tid >> 6;
    const bf16* Y = (const bf16*)(p.ws + WS_Y); const bf16* H1B = (const bf16*)(p.ws + WS_XB); const unsigned* ROUTE = (const unsigned*)(p.ws + WS_ROUTE);
    for (int tok = vcu * NWAVES + wave; tok < T; tok += G * NWAVES) {
        const u32x2 hv = *(const u32x2*)(H1B + (size_t)tok * D + 256 * j + 4 * lane);
        f32x4 a = {ALPHA * bflo(hv.x), ALPHA * bfhi(hv.x), ALPHA * bflo(hv.y), ALPHA * bfhi(hv.y)};
        { const u32x2 y = *(const u32x2*)(Y + ((size_t)tab[NE] * 256 + tok) * 256 + 4 * lane); a[0] += bflo(y.x); a[1] += bfhi(y.x); a[2] += bflo(y.y); a[3] += bfhi(y.y); }
#pragma unroll
        for (int k = 0; k < TOPK; ++k) { const unsigned r = ROUTE[(size_t)tok * 8 + k]; const size_t row = (size_t)tab[r >> 16] * 256 + (r & 0xffffu);
            const u32x2 y = *(const u32x2*)(Y + row * 256 + 4 * lane); a[0] += bflo(y.x); a[1] += bfhi(y.x); a[2] += bflo(y.y); a[3] += bfhi(y.y); }
        *(f32x4*)(p.out + (size_t)tok * D + 256 * j + 4 * lane) = a;
    }
}
__device__ __forceinline__ void phase_ln2(const Ptrs& p, int vcu, int G) {
    const int tid = threadIdx.x, lane = tid & 63, wave = tid >> 6;
    const float* g2 = p.in[22]; const float* b2 = p.in[23];
    for (int tok = vcu * NWAVES + wave; tok < T; tok += G * NWAVES) {
        float* rowp = p.out + (size_t)tok * D;
        f32x4 v[4]; float s = 0.f;
#pragma unroll
        for (int jj = 0; jj < 4; ++jj) { v[jj] = *(const f32x4*)(rowp + 4 * lane + 256 * jj); s += (v[jj][0] + v[jj][1]) + (v[jj][2] + v[jj][3]); }
        const float mean = wave_sum(s) * (1.0f / D); float s2 = 0.f;
#pragma unroll
        for (int jj = 0; jj < 4; ++jj) { v[jj] = v[jj] - mean; s2 += (v[jj][0] * v[jj][0] + v[jj][1] * v[jj][1]) + (v[jj][2] * v[jj][2] + v[jj][3] * v[jj][3]); }
        const float rstd = 1.0f / sqrtf(wave_sum(s2) * (1.0f / D) + 1e-5f);
#pragma unroll
        for (int jj = 0; jj < 4; ++jj) { const int c0 = 4 * lane + 256 * jj; *(f32x4*)(rowp + c0) = v[jj] * rstd * *(const f32x4*)(g2 + c0) + *(const f32x4*)(b2 + c0); }
    }
}

#define XB_TMO      128
#define XB_XCNT(j)  (256  + 64 * (j))
#define XB_XSUB(j)  (1280 + 64 * (j))
#define XB_XGEN(j)  (2304 + 64 * (j))
#define XB_TOP      3328
#define XB_TOPGEN   3392
#define XCD_BAR_WORDS 3456
#define XB_SPIN_CAP (1u << 18)
__device__ __forceinline__ unsigned xb_ld(unsigned* p)              { return __hip_atomic_load(p, __ATOMIC_RELAXED, __HIP_MEMORY_SCOPE_AGENT); }
__device__ __forceinline__ unsigned xb_add(unsigned* p, unsigned v) { return __hip_atomic_fetch_add(p, v, __ATOMIC_RELAXED, __HIP_MEMORY_SCOPE_AGENT); }
__device__ __forceinline__ unsigned xb_xcc_id() { return (unsigned)__builtin_amdgcn_s_getreg((3 << 11) | 20) & 0xFu; }
#define XB_SPIN(cond, bar) do { unsigned _sp = 0; while (cond) { __builtin_amdgcn_s_sleep(1); \
    if ((++_sp & 255u) == 0u) { if (xb_ld(&(bar)[XB_TMO])) break; if (_sp > XB_SPIN_CAP) { atomicAdd(&(bar)[XB_TMO], 1u); break; } } } } while (0)
struct XcdBarrier { unsigned* bar; unsigned x; volatile LAS unsigned* st; };
__device__ __forceinline__ XcdBarrier xcd_barrier_post(unsigned* bar, volatile LAS unsigned* st) {
    XcdBarrier b; b.bar = bar; b.x = xb_xcc_id(); b.st = st;
    if (threadIdx.x == 0) (void)xb_add(&bar[XB_XCNT(b.x)], 1u);
    return b;
}
__device__ __forceinline__ void xcd_barrier_complete(unsigned* bar, unsigned x, unsigned& nloc, unsigned& nx) {
    const unsigned G = gridDim.x * gridDim.y * gridDim.z;
    unsigned sum, cnt, mine, sp = 0u;
    for (;;) {
        sum = 0u; cnt = 0u; mine = 0u;
#pragma unroll
        for (unsigned j = 0; j < 16; ++j) { const unsigned c = xb_ld(&bar[XB_XCNT(j)]); sum += c; cnt += (c > 0u) ? 1u : 0u; mine = (j == x) ? c : mine; }
        if (sum == G) break;
        __builtin_amdgcn_s_sleep(1);
        if ((++sp & 255u) == 0u) { if (xb_ld(&bar[XB_TMO])) break; if (sp > XB_SPIN_CAP) { atomicAdd(&bar[XB_TMO], 1u); break; } }
    }
    nloc = mine > 0u ? mine : 1u; nx = cnt > 0u ? cnt : 1u;
}
__device__ __forceinline__ void xcd_barrier(const XcdBarrier& b) {
    asm volatile("s_waitcnt vmcnt(0)" ::: "memory");
    __syncthreads();
    if (threadIdx.x == 0) {
        unsigned* bar = b.bar;
        __builtin_amdgcn_s_waitcnt(0);
        unsigned nloc = b.st[0], nx = b.st[1];
        if (nloc == 0u) { xcd_barrier_complete(bar, b.x, nloc, nx); b.st[0] = nloc; b.st[1] = nx; }
        const unsigned old = xb_add(&bar[XB_XSUB(b.x)], 1u);
        const unsigned gen = old / nloc;
        if (old + 1u == (gen + 1u) * nloc) {
            __builtin_amdgcn_fence(__ATOMIC_RELEASE, "agent");
            asm volatile("s_waitcnt vmcnt(0)" ::: "memory");
            const unsigned og = xb_add(&bar[XB_TOP], 1u);
            const unsigned tg = og / nx;
            if (og + 1u == (tg + 1u) * nx) xb_add(&bar[XB_TOPGEN], 1u);
            else XB_SPIN(xb_ld(&bar[XB_TOPGEN]) == tg, bar);
            __builtin_amdgcn_fence(__ATOMIC_ACQUIRE, "agent");
            xb_add(&bar[XB_XGEN(b.x)], 1u);
            asm volatile("s_waitcnt vmcnt(0)" ::: "memory");
        } else {
            XB_SPIN(xb_ld(&bar[XB_XGEN(b.x)]) == gen, bar);
            __builtin_amdgcn_fence(__ATOMIC_ACQUIRE, "agent");
            asm volatile("s_waitcnt vmcnt(0)" ::: "memory");
        }
    }
    __syncthreads();
}

__device__ __forceinline__ void probe_between(const XcdBarrier& bar, int k, unsigned* cnt) {
    xcd_barrier(bar);
    if (k == 6) { if (blockIdx.x == 0 && threadIdx.x < 64) cnt[threadIdx.x] = 0u; xcd_barrier(bar); }
}
__device__ __forceinline__ const Ptrs* kargs() { auto k = __builtin_amdgcn_kernarg_segment_ptr(); asm volatile("" : "+s"(k)); return (const Ptrs*)k; }
constexpr int NPH = 17;
struct Args { Ptrs p; int ph_lo, ph_hi; };
__global__ void __launch_bounds__(NTHR, 2) mk_fwd(Args args) {
    extern __shared__ __attribute__((aligned(16))) unsigned char lds_raw[];
    LAS unsigned char* lds = (LAS unsigned char*)lds_raw;
    volatile LAS unsigned* MISC = (volatile LAS unsigned*)(lds + MISC_OFF);
    LAS int* tab = (LAS int*)(lds + TAB_OFF);
    const int tid = threadIdx.x, lane = tid & 63, wave = __builtin_amdgcn_readfirstlane(tid >> 6);
    const int G = gridDim.x, bx = blockIdx.x, vcu = (G % 8 == 0) ? (bx % 8) * (G / 8) + bx / 8 : bx;
    if (tid < 32) MISC[tid] = 0u;
    __syncthreads();
    XcdBarrier bar; bar.bar = (unsigned*)(kargs()->ws + WS_CTL) + CW_BAR; bar.x = 0; bar.st = nullptr;
    if (MK_N_LAUNCHES == 1) bar = xcd_barrier_post((unsigned*)(kargs()->ws + WS_CTL) + CW_BAR, MISC + 8);
    const int lo = args.ph_lo, hi = args.ph_hi;
#ifndef PHMASK
#define PHMASK 0x1FFFF
#endif
#define IN(k) (((PHMASK >> (k)) & 1) && lo <= (k) && (k) < hi)
#define SEAM(k) do { if (IN(k) && IN((k) + 1)) xcd_barrier(bar); } while (0)
#ifndef PROBE_REP
#define PROBE_REP 0
#endif
#define REPEAT(k) for (int rep_ = 0; rep_ <= ((PROBE_REP >> (k)) & 1); ++rep_, ((PROBE_REP >> (k)) & 1) ? probe_between(bar, (k), (unsigned*)(kargs()->ws + WS_CTL) + CW_CNT) : (void)0)

    if (IN(0)) REPEAT(0) { const Ptrs& p = *kargs(); unsigned char* const ws = p.ws; (void)ws; phase_prep(p, lds, vcu, G); } SEAM(0);

    if (IN(1)) REPEAT(1) { const Ptrs& p = *kargs(); unsigned char* const ws = p.ws; (void)ws;
        DenseSched S; S.init(T, DINP, D, D, (const bf16*)(ws + WS_XB), (const bf16*)(ws + WS_WIN), G, bx);
        EpiProj E{(bf16*)(ws + WS_P), (float*)(ws + WS_RSQ), (float*)(ws + WS_RSKV)};
        pg8::gemm_phase<EpiProj, DenseSched, false>(lds, D, D, S, E);
    } SEAM(1);

    if (IN(2)) REPEAT(2) { const Ptrs& p = *kargs(); unsigned char* const ws = p.ws; (void)ws;
        DenseSched S; S.init(T, NUP, KUP, DINP, (const bf16*)(ws + WS_P) + 2048, (const bf16*)(ws + WS_WUP), G, bx);
        EpiUp E{(bf16*)(ws + WS_Q), (bf16*)(ws + WS_QI), (bf16*)(ws + WS_K), (bf16*)(ws + WS_VT), (const float*)(ws + WS_RSQ), (const float*)(ws + WS_RSKV)};
        pg8::gemm_phase<EpiUp, DenseSched, false>(lds, KUP, DINP, S, E);
        phase_kidx(p, vcu, G);
        for (int item = vcu; item < 1024; item += G) hgrn1_item(p, item, lds);
    } SEAM(2);

    if (IN(3)) REPEAT(3) { const Ptrs& p = *kargs(); unsigned char* const ws = p.ws; (void)ws;
        for (int L = vcu; L < 1024; L += G) { const int i = L >> 8, idx = L & 255, b = idx >> 5, j = idx & 31;
            const int qg = (i == 0) ? j : (i == 1) ? 63 - j : (i == 2) ? 64 + j : 127 - j;
            indexer_item(p, b * 128 + qg, lds); }
        phase_scan(p, vcu, G);
    } SEAM(3);

    if (IN(4)) REPEAT(4) { const Ptrs& p = *kargs(); unsigned char* const ws = p.ws; (void)ws;
        for (int pr = vcu; pr < 256; pr += G) { const int b = pr >> 5, h = (pr >> 2) & 7, j = pr & 3;
            attn_unit(p, b, h, 7 - j, lds); attn_unit(p, b, h, j, lds); }
        for (int item = vcu; item < 1024; item += G) hgrn3_item(p, item, lds);
    } SEAM(4);

    if (IN(5)) REPEAT(5) { const Ptrs& p = *kargs(); unsigned char* const ws = p.ws; (void)ws;
        DenseSched S; S.init(T, D, D, D, (const bf16*)(ws + WS_XB), (const bf16*)(ws + WS_WOUT), G, bx);
        EpiOut E{p.in[0], (float*)(ws + WS_HB)};
        pg8::gemm_phase<EpiOut, DenseSched, false>(lds, D, D, S, E);
        phase_convert_experts(p, lds, vcu, G);
    } SEAM(5);

    if (IN(6)) REPEAT(6) { const Ptrs& p = *kargs(); unsigned char* const ws = p.ws; (void)ws; phase_ln1_router(p, lds, vcu, G); } SEAM(6);

    if (IN(7)) REPEAT(7) { const Ptrs& p = *kargs(); unsigned char* const ws = p.ws; (void)ws;
        const int nu = moe_tables(p, tab, 2, true, vcu, G);
        MoeSched S{tab, nu, (const char*)(ws + WS_XB), (const char*)(ws + WS_WGU), (size_t)0, (size_t)512 * D * 2, (size_t)256 * D * 2};
        EpiGU E{(bf16*)(ws + WS_HB)};
        pg8::gemm_phase<EpiGU, MoeSched, true>(lds, D, D, S, E);
    } SEAM(7);

#pragma unroll 1
    for (int j = 0; j < 4; ++j) {
        if (IN(8 + 2 * j)) REPEAT(8) { const Ptrs& p = *kargs(); unsigned char* const ws = p.ws; (void)ws;
            const int nu = moe_tables(p, tab, 1, false, vcu, G);
            MoeSched S{tab, nu, (const char*)(ws + WS_HB), (const char*)(ws + WS_WD) + (size_t)j * 256 * DE * 2, (size_t)256 * DE * 2, (size_t)D * DE * 2, (size_t)0};
            EpiDown E{(bf16*)(ws + WS_Y), (const float*)(ws + WS_LW)};
            pg8::gemm_phase<EpiDown, MoeSched, false>(lds, DE, DE, S, E);
        } SEAM(8 + 2 * j);
        if (IN(9 + 2 * j)) REPEAT(9) { const Ptrs& p = *kargs(); unsigned char* const ws = p.ws; (void)ws; (void)moe_tables(p, tab, 1, false, vcu, G); phase_combine(p, tab, j, vcu, G); } SEAM(9 + 2 * j);
    }
    if (IN(16)) { const Ptrs& p = *kargs(); phase_ln2(p, vcu, G); }
#undef IN
#undef SEAM
}

extern "C" void kernel_launch(void* const* d_in, const int* in_sizes, int n_in, void* d_out, int out_size, void* d_ws, size_t ws_size, hipStream_t stream) {
    static int grid = 0;
    if (grid == 0) {
        if (n_in != 24 || out_size != T * D || ws_size < WS_END) { fprintf(stderr, "kernel_launch: unexpected problem (n_in %d, out %d, ws %zu)\n", n_in, out_size, ws_size); grid = -1; return; }
        int dev = 0, cus = 0, per_cu = 0;
        if (hipGetDevice(&dev) != hipSuccess || hipDeviceGetAttribute(&cus, hipDeviceAttributeMultiprocessorCount, dev) != hipSuccess) { grid = -1; return; }
        if (hipFuncSetAttribute((const void*)mk_fwd, hipFuncAttributeMaxDynamicSharedMemorySize, LDS_BYTES) != hipSuccess) { fprintf(stderr, "kernel_launch: hipFuncSetAttribute failed\n"); grid = -1; return; }
        if (hipOccupancyMaxActiveBlocksPerMultiprocessor(&per_cu, (const void*)mk_fwd, NTHR, LDS_BYTES) != hipSuccess || per_cu < 1) { fprintf(stderr, "kernel_launch: occupancy query says %d blocks per CU\n", per_cu); }
        (void)hipGetLastError();
        grid = cus;
    }
    if (grid < 0) return;
    (void)hipMemsetAsync((char*)d_ws + WS_CTL, 0, CTL_ZERO_BYTES, stream);
    Args a{};
    for (int i = 0; i < 24; ++i) a.p.in[i] = (const float*)d_in[i];
    a.p.out = (float*)d_out; a.p.ws = (unsigned char*)d_ws;
    if (MK_N_LAUNCHES == 1) { a.ph_lo = 0; a.ph_hi = NPH; hipLaunchKernelGGL(mk_fwd, dim3(grid), dim3(NTHR), LDS_BYTES, stream, a); }
    else for (int ph = 0; ph < NPH; ++ph) { a.ph_lo = ph; a.ph_hi = ph + 1; hipLaunchKernelGGL(mk_fwd, dim3(grid), dim3(NTHR), LDS_BYTES, stream, a); }
}
```

```cpp
#include <hip/hip_runtime.h>
#include <cstdint>
#include <cstdio>

#define LAS __attribute__((address_space(3)))
#define GAS __attribute__((address_space(1)))
typedef unsigned short bf16;
typedef short bf16x8 __attribute__((ext_vector_type(8)));
typedef short s16x4 __attribute__((ext_vector_type(4)));
typedef float f32x2 __attribute__((ext_vector_type(2)));
typedef float f32x4 __attribute__((ext_vector_type(4)));
typedef float f32x16 __attribute__((ext_vector_type(16)));
typedef unsigned u32x2 __attribute__((ext_vector_type(2)));
typedef unsigned u32x4 __attribute__((ext_vector_type(4)));
typedef GAS unsigned gu32;
#define RLX_AGENT __ATOMIC_RELAXED, __HIP_MEMORY_SCOPE_AGENT

#ifndef MK_N_LAUNCHES
#define MK_N_LAUNCHES 1
#endif

constexpr int NB = 8, SEQ = 2048, T = NB * SEQ, D = 1024, DIN = 2500, DINP = 2560;
constexpr int NE = 64, NEX = 65  , DE = 256, TOPK = 8;
constexpr int KUP = 384, NUP = 1792;
constexpr float ALPHA = 1.18920711500272f;
constexpr float LOG2E = 1.4426950408889634f;
constexpr int HROWS = 147456 + T;
constexpr int NWAVES = 8, NTHR = 512;

constexpr size_t MiB = 1u << 20;
constexpr size_t WS_CTL = 0, CTL_ZERO_BYTES = 1 * MiB;
constexpr size_t WS_RSQ = 1 * MiB, WS_RSKV = WS_RSQ + 256 * 1024, WS_WH = WS_RSKV + 256 * 1024, WS_DEC = WS_WH + 256 * 1024;
constexpr size_t WS_LB = 2 * MiB + 256 * 1024;
constexpr size_t WS_ROUTE = 2 * MiB + 512 * 1024;
constexpr size_t WS_WUP = 4 * MiB, WS_WOUT = 6 * MiB, WS_MASK = 8 * MiB, WS_KIDX = 12 * MiB, WS_LTOK = 14 * MiB, WS_LW = 18 * MiB;
constexpr size_t WS_XB = 24 * MiB;
constexpr size_t WS_WIN = 56 * MiB, WS_P = 61 * MiB, WS_Q = 141 * MiB, WS_QI = 157 * MiB, WS_K = 165 * MiB, WS_VT = 181 * MiB, WS_DS = 197 * MiB, WS_SP = 229 * MiB;
constexpr size_t WS_WD = 56 * MiB, WS_WGU = 89 * MiB, WS_Y = 89 * MiB, WS_HB = 169 * MiB, WS_END = 249 * MiB;
constexpr int CW_TMO = 0, CW_BAR = 4096, CW_CNT = 8192;

constexpr int RING_BYTES = 131072;
constexpr int TAB_OFF = RING_BYTES;
constexpr int MISC_OFF = RING_BYTES + 12288;
constexpr int LDS_BYTES = 147456;

__device__ __forceinline__ unsigned f2bf(float f) { unsigned u = __builtin_bit_cast(unsigned, f); return (u + 0x7fffu + ((u >> 16) & 1u)) >> 16; }
__device__ __forceinline__ unsigned pk2(float lo, float hi) { return f2bf(lo) | (f2bf(hi) << 16); }
__device__ __forceinline__ float bf2f(unsigned h) { return __builtin_bit_cast(float, h << 16); }
__device__ __forceinline__ float bflo(unsigned w) { return __builtin_bit_cast(float, w << 16); }
__device__ __forceinline__ float bfhi(unsigned w) { return __builtin_bit_cast(float, w & 0xffff0000u); }
__device__ __forceinline__ float sigmoidf_(float x) { return 1.0f / (1.0f + __expf(-x)); }
__device__ __forceinline__ float siluf_(float x) { return x / (1.0f + __expf(-x)); }
__device__ __forceinline__ float wave_sum(float v) {
#pragma unroll
    for (int o = 1; o < 64; o <<= 1) v += __shfl_xor(v, o);
    return v;
}
#define LDS_WAIT() asm volatile("s_waitcnt lgkmcnt(0)" ::: "memory")
#define VM_WAIT() asm volatile("s_waitcnt vmcnt(0)" ::: "memory")

namespace pg8 {
constexpr int BM = 256, BK = 64, HALF = 128, HTB = HALF * BK * 2, STAGE_BYTES = 8 * HTB;
__host__ __device__ __forceinline__ int lds_byte(int r, int c) { const int st = (r >> 4) * 2 + (c >> 5), rr = r & 15, cc = c & 31, ob = rr * 64 + cc * 2; return st * 1024 + (ob ^ (((ob >> 9) & 1) << 5)); }
__host__ __device__ __forceinline__ void stage_rc(int b, int& R, int& C) { const int st = b / 1024, sb = b % 1024, swz = sb ^ (((sb >> 9) & 1) << 5); R = (st >> 1) * 16 + swz / 64; C = (st & 1) * 32 + (swz % 64) / 2; }
__host__ __device__ __forceinline__ int perm32(int rho) { const int n = rho >> 4, i = rho & 15; return 8 * (i >> 2) + 4 * n + (i & 3); }

struct Unit { int pm, pn, aux, slot; const char* A; const char* B; };

__device__ __forceinline__ unsigned cvt_pk_bf16(float lo, float hi) { unsigned r; asm volatile("v_cvt_pk_bf16_f32 %0, %1, %2" : "=v"(r) : "v"(lo), "v"(hi)); return r; }

template <class Epi, class Sched, bool GATHER>
__device__ __forceinline__ void gemm_phase(LAS unsigned char* lds, const int K, const int lda, const Sched& S, const Epi& E) {
    const int tid = threadIdx.x, wid = __builtin_amdgcn_readfirstlane(tid >> 6), lane = tid & 63, wr = wid >> 2, wc = wid & 3, fr = lane & 15, fq = lane >> 4;
    const int nt = K / BK;
    int sR[2], sC[2];
    unsigned voffB[2];
#pragma unroll
    for (int i = 0; i < 2; ++i) { stage_rc(tid * 16 + i * 8192, sR[i], sC[i]); const int Rb = Epi::PERM ? ((sR[i] & ~31) + perm32(sR[i] & 31)) : sR[i]; voffB[i] = (unsigned)(Rb * K + sC[i]) * 2u; }
    const size_t kstep = (size_t)(BK * 2);
    const size_t hstepB = (size_t)HALF * K * 2, hstepA = (size_t)HALF * lda * 2;
    unsigned voffA[2];
#pragma unroll
    for (int i = 0; i < 2; ++i) voffA[i] = (unsigned)(sR[i] * lda + sC[i]) * 2u;
    const unsigned ldsw = (unsigned)wid * 1024u;
    const int aoff = lds_byte(wr * 64 + fr, fq * 8), boff = lds_byte(wc * 32 + fr, fq * 8);
#define PG8_SA(b, h) (((b) * 2 + (h)) * HTB)
#define PG8_SB(b, h) ((4 + (b) * 2 + (h)) * HTB)
#define PG8_STAGE(bufoff, gbase, voff) do { _Pragma("unroll") for (int _i = 0; _i < 2; ++_i) \
        __builtin_amdgcn_global_load_lds((const unsigned*)((const char*)(gbase) + (voff)[_i]), (LAS unsigned*)(lds + (bufoff) + ldsw + _i * 8192), 16, 0, 0); } while (0)
#define PG8_LDA(dst, b, h) do { _Pragma("unroll") for (int m = 0; m < 4; ++m) _Pragma("unroll") for (int k = 0; k < 2; ++k) dst[m][k] = *(const LAS bf16x8*)(lds + PG8_SA(b, h) + aoff + m * 2048 + k * 1024); } while (0)
#define PG8_LDB(dst, b, h) do { _Pragma("unroll") for (int n = 0; n < 2; ++n) _Pragma("unroll") for (int k = 0; k < 2; ++k) dst[n][k] = *(const LAS bf16x8*)(lds + PG8_SB(b, h) + boff + n * 2048 + k * 1024); } while (0)
#define PG8_MMA(ai, bj, At, Bt) do { __builtin_amdgcn_s_setprio(1); _Pragma("unroll") for (int m = 0; m < 4; ++m) _Pragma("unroll") for (int n = 0; n < 2; ++n) _Pragma("unroll") for (int k = 0; k < 2; ++k) \
        acc[ai][bj][m][n] = __builtin_amdgcn_mfma_f32_16x16x32_bf16(Bt[n][k], At[m][k], acc[ai][bj][m][n], 0, 0, 0); __builtin_amdgcn_s_setprio(0); } while (0)
#define PG8_WAIT_V(n) asm volatile("s_waitcnt vmcnt(" #n ")" ::: "memory")
#define PG8_WAIT_L(n) asm volatile("s_waitcnt lgkmcnt(" #n ")" ::: "memory")
#define PG8_BAR __builtin_amdgcn_s_barrier()
#define PG8_SCHED __builtin_amdgcn_sched_barrier(0)
#define PG8_AOFF(dst, u) do { if constexpr (GATHER) { _Pragma("unroll") for (int _h = 0; _h < 2; ++_h) _Pragma("unroll") for (int _i = 0; _i < 2; ++_i) { \
        const int _src = S.row((u), _h * HALF + sR[_i]); dst[_h][_i] = (unsigned)(_src * lda + sC[_i]) * 2u; } } } while (0)
#define PG8_STAGE_A(bufoff, gbase, v, h) do { if constexpr (GATHER) { PG8_STAGE(bufoff, gbase, (v)[h]); } else { PG8_STAGE(bufoff, (gbase) + (h) * hstepA, voffA); } } while (0)
    Unit cur, nxt; int ui = 0;
    if (!S.next(0, cur)) return;
    f32x4 acc[2][2][4][2];
#pragma unroll
    for (int a = 0; a < 2; ++a)
#pragma unroll
        for (int b = 0; b < 2; ++b)
#pragma unroll
            for (int m = 0; m < 4; ++m)
#pragma unroll
                for (int n = 0; n < 2; ++n) acc[a][b][m][n] = (f32x4){0.f, 0.f, 0.f, 0.f};
    bf16x8 At[4][2], B0[2][2], B1[2][2];
    unsigned vA[2][2], vN[2][2];
    PG8_AOFF(vA, cur);
#pragma unroll
    for (int h = 0; h < 2; ++h)
#pragma unroll
        for (int i = 0; i < 2; ++i) vN[h][i] = vA[h][i];
    const char* cA = cur.A; const char* cB = cur.B;
    PG8_STAGE(PG8_SB(0, 0), cB, voffB); PG8_STAGE(PG8_SB(0, 1), cB + hstepB, voffB); PG8_STAGE_A(PG8_SA(0, 0), cA, vA, 0); PG8_STAGE_A(PG8_SA(0, 1), cA, vA, 1);
    if (wr == 1) PG8_BAR;
    PG8_WAIT_V(2); PG8_BAR;
    PG8_STAGE(PG8_SB(1, 0), cB + kstep, voffB); PG8_STAGE_A(PG8_SA(1, 0), cA + kstep, vA, 0); PG8_STAGE(PG8_SB(1, 1), cB + hstepB + kstep, voffB);
    PG8_WAIT_V(6); PG8_BAR;
    for (;;) {
        const bool has_next = S.next(ui + 1, nxt);
        const char* nA = has_next ? nxt.A : cA; const char* nB = has_next ? nxt.B : cB;
#pragma unroll 1
        for (int t = 0; t < nt; t += 2) {
            const bool last = (t == nt - 2);
            const char* a1 = cA + (size_t)(t + 1) * kstep;
            const char* a2 = last ? nA : cA + (size_t)(t + 2) * kstep; const char* b2 = last ? nB : cB + (size_t)(t + 2) * kstep;
            const char* a3 = a2 + kstep; const char* b3 = b2 + kstep;
            if (last && has_next) { PG8_AOFF(vN, nxt); }
            unsigned wX[2][2];
            if constexpr (GATHER) {
#pragma unroll
                for (int h = 0; h < 2; ++h)
#pragma unroll
                    for (int i = 0; i < 2; ++i) wX[h][i] = last ? vN[h][i] : vA[h][i]; }
            PG8_LDB(B0, 0, 0); PG8_LDB(B1, 0, 1); PG8_SCHED; PG8_LDA(At, 0, 0); PG8_STAGE_A(PG8_SA(1, 1), a1, vA, 1);
            PG8_WAIT_V(8); PG8_WAIT_L(0); PG8_BAR; PG8_MMA(0, 0, At, B0); PG8_MMA(0, 1, At, B1); PG8_BAR; PG8_SCHED;
            PG8_LDA(At, 0, 1); PG8_STAGE(PG8_SB(0, 0), b2, voffB); PG8_STAGE(PG8_SB(0, 1), b2 + hstepB, voffB); PG8_STAGE_A(PG8_SA(0, 0), a2, wX, 0);
            PG8_WAIT_V(8); PG8_WAIT_L(0); PG8_BAR; PG8_MMA(1, 0, At, B0); PG8_MMA(1, 1, At, B1); PG8_BAR; PG8_SCHED;
            PG8_LDB(B0, 1, 0); PG8_LDB(B1, 1, 1); PG8_SCHED; PG8_LDA(At, 1, 0); PG8_STAGE_A(PG8_SA(0, 1), a2, wX, 1);
            PG8_WAIT_V(8); PG8_WAIT_L(0); PG8_BAR; PG8_MMA(0, 0, At, B0); PG8_MMA(0, 1, At, B1); PG8_BAR; PG8_SCHED;
            PG8_LDA(At, 1, 1); PG8_STAGE(PG8_SB(1, 0), b3, voffB); PG8_STAGE(PG8_SB(1, 1), b3 + hstepB, voffB); PG8_STAGE_A(PG8_SA(1, 0), a3, wX, 0);
            PG8_WAIT_V(8); PG8_WAIT_L(0); PG8_BAR; PG8_MMA(1, 0, At, B0); PG8_MMA(1, 1, At, B1); PG8_BAR; PG8_SCHED;
        }
        if (wr == 0) PG8_BAR;
        E(acc, cur, wr, wc, fr, fq);
        if (!has_next) break;
#pragma unroll
        for (int a = 0; a < 2; ++a)
#pragma unroll
            for (int b = 0; b < 2; ++b)
#pragma unroll
                for (int m = 0; m < 4; ++m)
#pragma unroll
                    for (int n = 0; n < 2; ++n) acc[a][b][m][n] = (f32x4){0.f, 0.f, 0.f, 0.f};
        cur = nxt; cA = nA; cB = nB; ++ui;
#pragma unroll
        for (int h = 0; h < 2; ++h)
#pragma unroll
            for (int i = 0; i < 2; ++i) vA[h][i] = vN[h][i];
        if (wr == 1) PG8_BAR;
    }
    PG8_WAIT_V(0);
    PG8_BAR;
#undef PG8_SA
#undef PG8_SB
#undef PG8_STAGE
#undef PG8_LDA
#undef PG8_LDB
#undef PG8_MMA
#undef PG8_WAIT_V
#undef PG8_WAIT_L
#undef PG8_BAR
#undef PG8_SCHED
#undef PG8_AOFF
#undef PG8_STAGE_A
}
}

struct DenseSched {
    int nM, nN, nwg, G, c; const char* A; const char* B; size_t tstepA, tstepB;
    __device__ __forceinline__ void init(int M, int N, int K, int lda, const bf16* A_, const bf16* B_, int G_, int c_) { nM = M / 256; nN = N / 256; nwg = nM * nN; G = G_; c = c_; A = (const char*)A_; B = (const char*)B_; tstepA = (size_t)256 * lda * 2; tstepB = (size_t)256 * K * 2; }
    __device__ __forceinline__ bool next(int i, pg8::Unit& u) const {
        const long L = (long)i * G + c; if (L >= nwg) return false;
        int wgid = (int)L; { const int q = nwg / 8, r = nwg % 8, xcd = wgid % 8, off = wgid / 8; wgid = (xcd < r ? xcd * (q + 1) : r * (q + 1) + (xcd - r) * q) + off; }
        const int nig = 8 * nN, gid = wgid / nig, fm = gid * 8, gsz = (nM - fm) < 8 ? (nM - fm) : 8;
        u.pm = fm + ((wgid % nig) % gsz); u.pn = (wgid % nig) / gsz; u.aux = 0; u.slot = i;
        u.A = A + (size_t)u.pm * tstepA; u.B = B + (size_t)u.pn * tstepB; return true;
    }
    __device__ __forceinline__ int row(const pg8::Unit&, int r) const { return r; }
};
constexpr int MOE_MAXU = 8;
struct MoeSched {
    LAS const int* tab; int ub; int nunits; const char* A; const char* B; size_t strideA_tile, strideB_e, strideB_pn;
    __device__ __forceinline__ bool next(int i, pg8::Unit& u) const {
        if (i >= nunits) return false;
        const int tile = tab[ub + 4 * i], pn = tab[ub + 1 + 4 * i], e = tab[ub + 2 + 4 * i];
        u.pm = tile; u.pn = pn; u.aux = e | (tab[ub + 3 + 4 * i] << 8); u.slot = i;
        u.A = A + (size_t)tile * strideA_tile; u.B = B + (size_t)e * strideB_e + (size_t)pn * strideB_pn; return true;
    }
    __device__ __forceinline__ int row(const pg8::Unit& u, int r) const { return tab[256 + 256 * u.slot + r]; }
};

using pg8::cvt_pk_bf16;
#define EPI_ARGS const f32x4 (&acc)[2][2][4][2], const pg8::Unit& u, int wr, int wc, int fr, int fq

struct EpiProj {
    static constexpr bool PERM = true;
    bf16* P; float* rsq; float* rskv;
    __device__ __forceinline__ void operator()(EPI_ARGS) const {
        const int row0 = u.pm * 256 + wr * 64 + fr, col0 = u.pn * 256 + wc * 32 + 8 * fq;
#pragma unroll
        for (int ai = 0; ai < 2; ++ai)
#pragma unroll
            for (int m = 0; m < 4; ++m) {
                const int row = row0 + ai * 128 + m * 16; bf16* rowp = P + (size_t)row * DINP + col0;
                float ss0 = 0.f, ss1 = 0.f;
#pragma unroll
                for (int bj = 0; bj < 2; ++bj) { const f32x4 v0 = acc[ai][bj][m][0], v1 = acc[ai][bj][m][1];
                    u32x4 w; w.x = cvt_pk_bf16(v0[0], v0[1]); w.y = cvt_pk_bf16(v0[2], v0[3]); w.z = cvt_pk_bf16(v1[0], v1[1]); w.w = cvt_pk_bf16(v1[2], v1[3]);
                    *(u32x4*)(rowp + bj * 128) = w;
                    const float s = (v0[0] * v0[0] + v0[1] * v0[1]) + (v0[2] * v0[2] + v0[3] * v0[3]) + (v1[0] * v1[0] + v1[1] * v1[1]) + (v1[2] * v1[2] + v1[3] * v1[3]);
                    if (bj == 0) ss0 = s; else ss1 = s; }
                if (u.pn == 8) { float s = ss0 + ss1; s += __shfl_xor(s, 16); s += __shfl_xor(s, 32); if (fq == 0) rsq[row * 4 + wc] = s; }
                if (u.pn == 9) { float s = ss0; s += __shfl_xor(s, 16); s += __shfl_xor(s, 32); if (fq == 0) rskv[row * 4 + wc] = s; }
            }
    }
};
struct EpiUp {
    static constexpr bool PERM = true;
    bf16 *Q, *QI, *Kk, *VT; LAS const float* rst;
    __device__ __forceinline__ void operator()(EPI_ARGS) const {
        const int row0 = u.pm * 256 + wr * 64 + fr, cl = wc * 32 + 8 * fq;
#pragma unroll
        for (int ai = 0; ai < 2; ++ai)
#pragma unroll
            for (int m = 0; m < 4; ++m) {
                const int row = row0 + ai * 128 + m * 16;
                float rs = rst[256 * u.slot + wr * 64 + fr + ai * 128 + m * 16];
                if (u.pn < 2) rs *= 0.125f * LOG2E;
#pragma unroll
                for (int bj = 0; bj < 2; ++bj) { const f32x4 v0 = acc[ai][bj][m][0] * rs, v1 = acc[ai][bj][m][1] * rs; const int c = cl + bj * 128;
                    if (u.pn < 5) {
                        u32x4 w; w.x = cvt_pk_bf16(v0[0], v0[1]); w.y = cvt_pk_bf16(v0[2], v0[3]); w.z = cvt_pk_bf16(v1[0], v1[1]); w.w = cvt_pk_bf16(v1[2], v1[3]);
                        bf16* dst = u.pn < 2 ? Q + (size_t)row * 512 + u.pn * 256 + c : (u.pn == 2 ? QI + (size_t)row * 256 + c : Kk + (size_t)row * 512 + (u.pn - 3) * 256 + c);
                        *(u32x4*)dst = w;
                    } else {
                        const int vc = (u.pn - 5) * 256 + c, h = vc >> 6, d = vc & 63, b = row >> 11, t = row & 2047;
                        bf16* dst = VT + ((size_t)(b * 8 + h) * 64 + d) * SEQ + t;
#pragma unroll
                        for (int j = 0; j < 4; ++j) { dst[(size_t)j * SEQ] = (bf16)f2bf(v0[j]); dst[(size_t)(4 + j) * SEQ] = (bf16)f2bf(v1[j]); }
                    } }
            }
    }
};
struct EpiOut {
    static constexpr bool PERM = false;
    const float* x; float* pre;
    __device__ __forceinline__ void operator()(EPI_ARGS) const {
        const int row0 = u.pm * 256 + wr * 64 + fr, col0 = u.pn * 256 + wc * 32 + 4 * fq;
#pragma unroll
        for (int ai = 0; ai < 2; ++ai)
#pragma unroll
            for (int m = 0; m < 4; ++m) { const size_t off = (size_t)(row0 + ai * 128 + m * 16) * D + col0;
#pragma unroll
                for (int bj = 0; bj < 2; ++bj)
#pragma unroll
                    for (int n = 0; n < 2; ++n) { const f32x4 xv = *(const f32x4*)(x + off + bj * 128 + n * 16); *(f32x4*)(pre + off + bj * 128 + n * 16) = xv * ALPHA + acc[ai][bj][m][n]; } }
    }
};
struct EpiGU {
    static constexpr bool PERM = true;
    bf16* H;
    __device__ __forceinline__ void operator()(EPI_ARGS) const {
        const int row0 = u.pm * 256 + wr * 64 + fr, col0 = u.pn * 128 + wc * 32 + 8 * fq;
#pragma unroll
        for (int ai = 0; ai < 2; ++ai)
#pragma unroll
            for (int m = 0; m < 4; ++m) { const f32x4 g0 = acc[ai][0][m][0], g1 = acc[ai][0][m][1], u0 = acc[ai][1][m][0], u1 = acc[ai][1][m][1];
                float h[8];
#pragma unroll
                for (int j = 0; j < 4; ++j) { h[j] = siluf_(g0[j]) * u0[j]; h[4 + j] = siluf_(g1[j]) * u1[j]; }
                u32x4 w; w.x = cvt_pk_bf16(h[0], h[1]); w.y = cvt_pk_bf16(h[2], h[3]); w.z = cvt_pk_bf16(h[4], h[5]); w.w = cvt_pk_bf16(h[6], h[7]);
                *(u32x4*)(H + (size_t)(row0 + ai * 128 + m * 16) * DE + col0) = w; }
    }
};
struct EpiDown {
    static constexpr bool PERM = true;
    bf16* Y; LAS const float* lwt;
    __device__ __forceinline__ void operator()(EPI_ARGS) const {
        const int lr0 = wr * 64 + fr, col0 = wc * 32 + 8 * fq;
#pragma unroll
        for (int ai = 0; ai < 2; ++ai)
#pragma unroll
            for (int m = 0; m < 4; ++m) { const int lr = lr0 + ai * 128 + m * 16;
                const float wgt = lwt[256 * u.slot + lr];
                bf16* rowp = Y + (size_t)(u.pm * 256 + lr) * 256 + col0;
#pragma unroll
                for (int bj = 0; bj < 2; ++bj) { const f32x4 v0 = acc[ai][bj][m][0] * wgt, v1 = acc[ai][bj][m][1] * wgt;
                    u32x4 w; w.x = cvt_pk_bf16(v0[0], v0[1]); w.y = cvt_pk_bf16(v0[2], v0[3]); w.z = cvt_pk_bf16(v1[0], v1[1]); w.w = cvt_pk_bf16(v1[2], v1[3]);
                    *(u32x4*)(rowp + bj * 128) = w; } }
    }
};

__device__ __forceinline__ void tr_item(const float* src, int ldn, int k0, int n0, int nvalid, bf16* dst, int ldk, const float* kscale, LAS float* scr, int lane) {
    const int n4 = (lane & 7) * 4;
#pragma unroll
    for (int i = 0; i < 8; ++i) { const int kk = (lane >> 3) + 8 * i; f32x4 v = {0.f, 0.f, 0.f, 0.f};
        if (n4 < nvalid) v = *(const f32x4*)(src + (size_t)(k0 + kk) * ldn + n0 + n4);
        if (kscale) v = v * kscale[k0 + kk];
        scr[kk * 33 + n4] = v[0]; scr[kk * 33 + n4 + 1] = v[1]; scr[kk * 33 + n4 + 2] = v[2]; scr[kk * 33 + n4 + 3] = v[3]; }
    LDS_WAIT();
    const int c = lane & 7;
#pragma unroll
    for (int j = 0; j < 4; ++j) { const int n = (lane >> 3) + 8 * j; const LAS float* s = scr + (8 * c) * 33 + n;
        u32x4 o; o.x = pk2(s[0 * 33], s[1 * 33]); o.y = pk2(s[2 * 33], s[3 * 33]); o.z = pk2(s[4 * 33], s[5 * 33]); o.w = pk2(s[6 * 33], s[7 * 33]);
        *(u32x4*)(dst + (size_t)n * ldk + 8 * c) = o; }
    LDS_WAIT();
}

struct Ptrs {
    const float* in[24]; float* out; unsigned char* ws;
};

__device__ __forceinline__ void phase_prep(const Ptrs& p, LAS unsigned char* lds, int vcu, int G) {
    const int tid = threadIdx.x, lane = tid & 63, wave = tid >> 6;
    LAS float* scr = (LAS float*)(lds + wave * 16384);
    const int gw = vcu * NWAVES + wave, NGW = G * NWAVES;
    bf16* WIN = (bf16*)(p.ws + WS_WIN); bf16* WUP = (bf16*)(p.ws + WS_WUP); bf16* WOUT = (bf16*)(p.ws + WS_WOUT); bf16* XB = (bf16*)(p.ws + WS_XB);
    constexpr int I_IN = 16 * 80, I_Q = 4 * 16, I_QI = 4 * 8, I_KV = 2 * 32, I_O = 16 * 32, NIT = I_IN + I_Q + I_QI + I_KV + I_O;
    for (int it = gw; it < NIT; it += NGW) {
        int r = it;
        if (r < I_IN) { const int kb = r / 80, nb = r % 80, n0 = nb * 32; int nv = DIN - n0; nv = nv < 0 ? 0 : (nv > 32 ? 32 : nv);
            tr_item(p.in[1], DIN, kb * 64, n0, nv, WIN + (size_t)n0 * D + kb * 64, D, nullptr, scr, lane); continue; } r -= I_IN;
        if (r < I_Q) { const int kb = r / 16, nb = r % 16; tr_item(p.in[5], 512, kb * 64, nb * 32, 32, WUP + (size_t)(nb * 32) * KUP + kb * 64, KUP, p.in[4], scr, lane); continue; } r -= I_Q;
        if (r < I_QI) { const int kb = r / 8, nb = r % 8; tr_item(p.in[6], 256, kb * 64, nb * 32, 32, WUP + (size_t)(512 + nb * 32) * KUP + kb * 64, KUP, p.in[4], scr, lane); continue; } r -= I_QI;
        if (r < I_KV) { const int kb = r / 32, nb = r % 32; tr_item(p.in[8], 1024, kb * 64, nb * 32, 32, WUP + (size_t)(768 + nb * 32) * KUP + 256 + kb * 64, KUP, p.in[7], scr, lane); continue; } r -= I_KV;
        { const int kb = r / 32, nb = r % 32; tr_item(p.in[11], D, kb * 64, nb * 32, 32, WOUT + (size_t)(nb * 32) * D + kb * 64, D, nullptr, scr, lane); }
    }
    const int gt = vcu * NTHR + tid, NGT = G * NTHR;
    if (gt < 512) ((float*)(p.ws + WS_LB))[gt] = 1.0f / (1.0f + __expf(p.in[2][512 + gt] - p.in[2][gt]));
    for (int ch = gt; ch < NUP * KUP / 8; ch += NGT) { const int r = ch / (KUP / 8), c = (ch % (KUP / 8)) * 8; if (r < 768 ? c >= 256 : c < 256) *(u32x4*)(WUP + (size_t)r * KUP + c) = (u32x4){0u, 0u, 0u, 0u}; }
    const float* x = p.in[0];
    for (int ch = gt; ch < T * D / 8; ch += NGT) { const f32x4 a = *(const f32x4*)(x + (size_t)ch * 8), b = *(const f32x4*)(x + (size_t)ch * 8 + 4);
        u32x4 o; o.x = pk2(a[0], a[1]); o.y = pk2(a[2], a[3]); o.z = pk2(b[0], b[1]); o.w = pk2(b[2], b[3]); *(u32x4*)(XB + (size_t)ch * 8) = o; }
}

__device__ __forceinline__ void phase_convert_experts(const Ptrs& p, LAS unsigned char* lds, int vcu, int G) {
    const int tid = threadIdx.x, lane = tid & 63, wave = tid >> 6;
    LAS float* scr = (LAS float*)(lds + wave * 16384);
    const int gw = vcu * NWAVES + wave, NGW = G * NWAVES;
    bf16* WGU = (bf16*)(p.ws + WS_WGU); bf16* WD = (bf16*)(p.ws + WS_WD);
    for (int it = gw; it < NEX * 384; it += NGW) {
        const int e = it / 384, r = it % 384, which = r / 128, r2 = r % 128;
        if (which < 2) {
            const float* src = e < NE ? p.in[16 + which] + (size_t)e * D * DE : p.in[19 + which];
            const int kb = r2 / 8, nb = r2 % 8, n0 = nb * 32, row0 = (n0 >> 7) * 256 + (n0 & 127) + which * 128;
            tr_item(src, DE, kb * 64, n0, 32, WGU + ((size_t)e * 512 + row0) * D + kb * 64, D, nullptr, scr, lane);
        } else {
            const float* src = e < NE ? p.in[18] + (size_t)e * DE * D : p.in[21];
            const int kb = r2 / 32, nb = r2 % 32;
            tr_item(src, D, kb * 64, nb * 32, 32, WD + ((size_t)e * D + nb * 32) * DE + kb * 64, DE, nullptr, scr, lane);
        }
    }
}

__device__ __forceinline__ void phase_kidx(const Ptrs& p, int vcu, int G) {
    const int tid = threadIdx.x, lane = tid & 63, wave = tid >> 6;
    const bf16* P = (const bf16*)(p.ws + WS_P); bf16* KIDX = (bf16*)(p.ws + WS_KIDX); float* WH = (float*)(p.ws + WS_WH);
    const float g = p.in[9][lane], bb = p.in[10][lane];
    for (int tok = vcu * NWAVES + wave; tok < T; tok += G * NWAVES) {
        const float v = bf2f(P[(size_t)tok * DINP + 2432 + lane]);
        const float mean = wave_sum(v) * (1.0f / 64.0f); const float dv = v - mean;
        const float var = wave_sum(dv * dv) * (1.0f / 64.0f);
        KIDX[(size_t)tok * 64 + lane] = (bf16)f2bf(dv * __builtin_amdgcn_rsqf(var + 1e-5f) * g + bb);
        if (lane < 4) WH[tok * 4 + lane] = bf2f(P[(size_t)tok * DINP + 2496 + lane]) * 0.0625f;
    }
}

constexpr int HG_B = 0, HG_TOT = 32768, HG_VT = 34816, HG_QD = 53248, HG_KI = 70656, HG_KD = 53248, HG_PART = 88064;
constexpr int HG_QP = 136;
__device__ __forceinline__ float fast_sigmoid(float x) { return __builtin_amdgcn_rcpf(1.0f + __builtin_amdgcn_exp2f(-x * LOG2E)); }
__device__ __forceinline__ float fast_exp(float x) { return __builtin_amdgcn_exp2f(x * LOG2E); }
template <int MODE> __device__ __forceinline__ void hgrn_stage(const Ptrs& p, int item, LAS unsigned char* lds) {
    const int tid = threadIdx.x, t = tid >> 3, blk = tid & 7;
    const int c = item & 31, h = (item >> 5) & 3, b = item >> 7;
    const bf16* P = (const bf16*)(p.ws + WS_P); const float* LB = (const float*)(p.ws + WS_LB) + h * 128 + blk * 16;
    LAS float* bc = (LAS float*)(lds + HG_B); LAS float* tot = (LAS float*)(lds + HG_TOT); LAS bf16* VT = (LAS bf16*)(lds + HG_VT);
    const bf16* prow = P + ((size_t)b * SEQ + c * 64 + t) * DINP + h * 128 + blk * 16;
    float kk[16];
    const u32x4 gv0 = *(const u32x4*)(prow + 1024), gv1 = *(const u32x4*)(prow + 1024 + 8);
    u32x4 gq0 = {0u, 0u, 0u, 0u}, gq1 = {0u, 0u, 0u, 0u};
    if (MODE == 3) { gq0 = *(const u32x4*)prow; gq1 = *(const u32x4*)(prow + 8); }
    { const u32x4 a = *(const u32x4*)(prow + 512), a2 = *(const u32x4*)(prow + 512 + 8);
      const unsigned w[8] = {a.x, a.y, a.z, a.w, a2.x, a2.y, a2.z, a2.w};
#pragma unroll
      for (int j = 0; j < 16; ++j) { const float x = (j & 1) ? bfhi(w[j >> 1]) : bflo(w[j >> 1]); const float lb = LB[j], sg = fast_sigmoid(x);
          kk[j] = (1.0f - lb) * (1.0f - sg); bc[t * 128 + blk * 16 + j] = __logf(1.0f - kk[j]); } }
    __syncthreads();
    { const int d = tid & 127, part = tid >> 7; float s = 0.f;
#pragma unroll 4
      for (int i = 0; i < 16; ++i) { const int tt = part * 16 + i; s += bc[tt * 128 + d]; bc[tt * 128 + d] = s; }
      tot[part * 128 + d] = s;
      __syncthreads();
      float off = 0.f;
      for (int q = 0; q < part; ++q) off += tot[q * 128 + d];
      if (part > 0) {
#pragma unroll 4
          for (int i = 0; i < 16; ++i) bc[(part * 16 + i) * 128 + d] += off; } }
    __syncthreads();
    { const unsigned w[8] = {gv0.x, gv0.y, gv0.z, gv0.w, gv1.x, gv1.y, gv1.z, gv1.w};
#pragma unroll
      for (int j = 0; j < 8; ++j) { VT[(blk * 16 + 2 * j) * 72 + t] = (bf16)(w[j] & 0xffffu); VT[(blk * 16 + 2 * j + 1) * 72 + t] = (bf16)(w[j] >> 16); } }
    if (MODE == 1) {
        LAS bf16* KD = (LAS bf16*)(lds + HG_KD);
#pragma unroll
        for (int j = 0; j < 16; ++j) { const int d = blk * 16 + j; KD[d * 72 + t] = (bf16)f2bf(kk[j] * fast_exp(bc[63 * 128 + d] - bc[t * 128 + d])); }
        if (tid < 128) ((float*)(p.ws + WS_DEC))[item * 128 + tid] = fast_exp(bc[63 * 128 + tid]);
    } else {
        LAS bf16* QD = (LAS bf16*)(lds + HG_QD); LAS bf16* KI = (LAS bf16*)(lds + HG_KI);
        const unsigned w[8] = {gq0.x, gq0.y, gq0.z, gq0.w, gq1.x, gq1.y, gq1.z, gq1.w};
        unsigned oq[8], ok[8];
#pragma unroll
        for (int j = 0; j < 8; ++j) { const float b0 = bc[t * 128 + blk * 16 + 2 * j], b1 = bc[t * 128 + blk * 16 + 2 * j + 1]; const float x0 = bflo(w[j]), x1 = bfhi(w[j]);
            oq[j] = pk2(x0 * fast_sigmoid(x0) * fast_exp(b0), x1 * fast_sigmoid(x1) * fast_exp(b1));
            ok[j] = pk2(kk[2 * j] * fast_exp(-b0), kk[2 * j + 1] * fast_exp(-b1)); }
        *(LAS u32x4*)(QD + t * HG_QP + blk * 16) = (u32x4){oq[0], oq[1], oq[2], oq[3]}; *(LAS u32x4*)(QD + t * HG_QP + blk * 16 + 8) = (u32x4){oq[4], oq[5], oq[6], oq[7]};
        *(LAS u32x4*)(KI + t * HG_QP + blk * 16) = (u32x4){ok[0], ok[1], ok[2], ok[3]}; *(LAS u32x4*)(KI + t * HG_QP + blk * 16 + 8) = (u32x4){ok[4], ok[5], ok[6], ok[7]};
    }
    __syncthreads();
}
__device__ __forceinline__ void hgrn1_item(const Ptrs& p, int item, LAS unsigned char* lds) {
    const int tid = threadIdx.x, lane = tid & 63, w = tid >> 6;
    hgrn_stage<1>(p, item, lds);
    LAS bf16* KD = (LAS bf16*)(lds + HG_KD); LAS bf16* VT = (LAS bf16*)(lds + HG_VT);
    bf16* DS = (bf16*)(p.ws + WS_DS) + (size_t)item * 16384;
    { const int cc = lane & 15, g = lane >> 4;
      bf16x8 af[2];
#pragma unroll
      for (int ks = 0; ks < 2; ++ks) af[ks] = *(const LAS bf16x8*)(KD + (16 * w + cc) * 72 + 32 * ks + 8 * g);
#pragma unroll
      for (int vt = 0; vt < 8; ++vt) {
          f32x4 C = {0.f, 0.f, 0.f, 0.f};
#pragma unroll
          for (int ks = 0; ks < 2; ++ks) { const bf16x8 bfm = *(const LAS bf16x8*)(VT + (16 * vt + cc) * 72 + 32 * ks + 8 * g); C = __builtin_amdgcn_mfma_f32_16x16x32_bf16(af[ks], bfm, C, 0, 0, 0); }
          u32x2 o; o.x = pk2(C[0], C[1]); o.y = pk2(C[2], C[3]);
          *(u32x2*)(DS + (size_t)(16 * vt + cc) * 128 + 16 * w + 4 * g) = o; } }
    __syncthreads();
}
__device__ __forceinline__ void phase_scan(const Ptrs& p, int vcu, int G) {
    const bf16* DS = (const bf16*)(p.ws + WS_DS); bf16* SP = (bf16*)(p.ws + WS_SP); const float* DEC = (const float*)(p.ws + WS_DEC);
    for (int gt = vcu * NTHR + threadIdx.x; gt < 32 * 4096; gt += G * NTHR) {
        const int bh = gt >> 12, e4 = gt & 4095, d0 = (e4 & 31) * 4; const size_t eo = (size_t)(e4 >> 5) * 128 + d0;
        float S0 = 0.f, S1 = 0.f, S2 = 0.f, S3 = 0.f;
#pragma unroll 4
        for (int c = 0; c < 32; ++c) { const size_t item = (size_t)bh * 32 + c;
            const u32x2 ds = *(const u32x2*)(DS + item * 16384 + eo); const f32x4 dc = *(const f32x4*)(DEC + item * 128 + d0);
            u32x2 o; o.x = pk2(S0, S1); o.y = pk2(S2, S3); *(u32x2*)(SP + item * 16384 + eo) = o;
            S0 = dc[0] * S0 + bflo(ds.x); S1 = dc[1] * S1 + bfhi(ds.x); S2 = dc[2] * S2 + bflo(ds.y); S3 = dc[3] * S3 + bfhi(ds.y); }
    }
}
__device__ __forceinline__ void hgrn3_item(const Ptrs& p, int item, LAS unsigned char* lds) {
    const int tid = threadIdx.x, lane = tid & 63, w = tid >> 6, cc = lane & 15, g = lane >> 4;
    const int c = item & 31, h = (item >> 5) & 3, b = item >> 7;
    const bf16* P = (const bf16*)(p.ws + WS_P);
    const int tt = w & 3, vh = w >> 2;
    bf16x8 spf[4][4];
    { const bf16* SPi = (const bf16*)(p.ws + WS_SP) + (size_t)item * 16384;
#pragma unroll
      for (int vi = 0; vi < 4; ++vi)
#pragma unroll
          for (int ks = 0; ks < 4; ++ks) spf[vi][ks] = *(const bf16x8*)(SPi + (size_t)(16 * (4 * vh + vi) + cc) * 128 + 32 * ks + 8 * g); }
    hgrn_stage<3>(p, item, lds);
    LAS bf16* VT = (LAS bf16*)(lds + HG_VT); LAS float* part = (LAS float*)(lds + HG_PART); LAS bf16* QD = (LAS bf16*)(lds + HG_QD); LAS bf16* KI = (LAS bf16*)(lds + HG_KI);
    const size_t tok0 = (size_t)b * SEQ + c * 64;
    bf16x8 qd[4];
#pragma unroll
    for (int ks = 0; ks < 4; ++ks) qd[ks] = *(const LAS bf16x8*)(QD + (16 * tt + cc) * HG_QP + 32 * ks + 8 * g);
    u32x2 scb[4];
#pragma unroll
    for (int st = 0; st < 4; ++st) {
        scb[st] = (u32x2){0u, 0u};
        if (st <= tt) {
            f32x4 C = {0.f, 0.f, 0.f, 0.f};
#pragma unroll
            for (int ks = 0; ks < 4; ++ks) C = __builtin_amdgcn_mfma_f32_16x16x32_bf16(*(const LAS bf16x8*)(KI + (16 * st + cc) * HG_QP + 32 * ks + 8 * g), qd[ks], C, 0, 0, 0);
#pragma unroll
            for (int i = 0; i < 4; ++i) if (16 * st + 4 * g + i > 16 * tt + cc) C[i] = 0.f;
            scb[st] = (u32x2){pk2(C[0], C[1]), pk2(C[2], C[3])};
        }
    }
    f32x4 o[4]; float ss = 0.f;
#pragma unroll
    for (int vi = 0; vi < 4; ++vi) { const int vt = 4 * vh + vi; f32x4 C = {0.f, 0.f, 0.f, 0.f};
#pragma unroll
        for (int ks = 0; ks < 4; ++ks) C = __builtin_amdgcn_mfma_f32_16x16x32_bf16(spf[vi][ks], qd[ks], C, 0, 0, 0);
#pragma unroll
        for (int kp = 0; kp < 2; ++kp) if (2 * kp <= tt) {
            const u32x2 v0 = *(const LAS u32x2*)(VT + (16 * vt + cc) * 72 + 32 * kp + 4 * g), v1 = *(const LAS u32x2*)(VT + (16 * vt + cc) * 72 + 32 * kp + 16 + 4 * g);
            C = __builtin_amdgcn_mfma_f32_16x16x32_bf16(__builtin_bit_cast(bf16x8, (u32x4){v0.x, v0.y, v1.x, v1.y}), __builtin_bit_cast(bf16x8, (u32x4){scb[2 * kp].x, scb[2 * kp].y, scb[2 * kp + 1].x, scb[2 * kp + 1].y}), C, 0, 0, 0); }
        o[vi] = C; ss += (C[0] * C[0] + C[1] * C[1]) + (C[2] * C[2] + C[3] * C[3]); }
    ss += __shfl_xor(ss, 16); ss += __shfl_xor(ss, 32);
    if (g == 0) part[vh * 64 + 16 * tt + cc] = ss;
    __syncthreads();
    const float rstd = __builtin_amdgcn_rsqf((part[16 * tt + cc] + part[64 + 16 * tt + cc]) * (1.0f / 128.0f) + 1e-6f);
    bf16* OC = (bf16*)(p.ws + WS_XB);
    { const size_t tok = tok0 + 16 * tt + cc;
#pragma unroll
      for (int vi = 0; vi < 4; ++vi) { const int v0 = 16 * (4 * vh + vi) + 4 * g;
          const u32x2 gt = *(const u32x2*)(P + tok * DINP + 1536 + h * 128 + v0); const f32x4 ng = *(const f32x4*)(p.in[3] + v0);
          u32x2 ov; ov.x = pk2(o[vi][0] * rstd * ng[0] * siluf_(bflo(gt.x)), o[vi][1] * rstd * ng[1] * siluf_(bfhi(gt.x)));
          ov.y = pk2(o[vi][2] * rstd * ng[2] * siluf_(bflo(gt.y)), o[vi][3] * rstd * ng[3] * siluf_(bfhi(gt.y)));
          *(u32x2*)(OC + tok * D + h * 128 + v0) = ov; } }
    __syncthreads();
}

constexpr int IX_P = 2052;
__device__ __forceinline__ void cnt_ge_u32(int& cnt, unsigned a, unsigned b) { unsigned long long t; asm("v_cmp_ge_u32_e64 %1, %2, %3\n\tv_addc_co_u32_e64 %0, %1, 0, %0, %1" : "+v"(cnt), "=&s"(t) : "v"(a), "v"(b)); }
__device__ __forceinline__ void cnt_le_u32(int& cnt, unsigned a, unsigned b) { unsigned long long t; asm("v_cmp_le_u32_e64 %1, %2, %3\n\tv_addc_co_u32_e64 %0, %1, 0, %0, %1" : "+v"(cnt), "=&s"(t) : "v"(a), "v"(b)); }
__device__ __forceinline__ void cnt_gt_u64(int& cnt, unsigned long long a, unsigned long long b) { asm("v_cmp_gt_u64 vcc, %1, %2\n\tv_addc_co_u32 %0, vcc, 0, %0, vcc" : "+v"(cnt) : "v"(a), "v"(b) : "vcc"); }
__device__ __forceinline__ unsigned ord_u32(float f) { unsigned b = __builtin_bit_cast(unsigned, f); if (b == 0x80000000u) b = 0u; return (b & 0x80000000u) ? ~b : (b | 0x80000000u); }
__device__ __forceinline__ int bcnt_ge(unsigned a, unsigned sb) { int r; asm("v_cmp_le_u32 vcc, %2, %1\n\ts_bcnt1_i32_b64 %0, vcc" : "=s"(r) : "v"(a), "s"(sb) : "vcc", "scc"); return r; }
__device__ __forceinline__ int bcnt_le(unsigned a, unsigned sb) { int r; asm("v_cmp_ge_u32 vcc, %2, %1\n\ts_bcnt1_i32_b64 %0, vcc" : "=s"(r) : "v"(a), "s"(sb) : "vcc", "scc"); return r; }
__device__ __forceinline__ int wave_sum_dpp(int v) {
    v += __builtin_amdgcn_update_dpp(0, v, 0x111, 0xF, 0xF, false);
    v += __builtin_amdgcn_update_dpp(0, v, 0x112, 0xF, 0xF, false);
    v += __builtin_amdgcn_update_dpp(0, v, 0x114, 0xF, 0xF, false);
    v += __builtin_amdgcn_update_dpp(0, v, 0x118, 0xF, 0xF, false);
    v += __builtin_amdgcn_update_dpp(0, v, 0x142, 0xA, 0xF, false);
    v += __builtin_amdgcn_update_dpp(0, v, 0x143, 0xC, 0xF, false);
    return __builtin_amdgcn_readlane(v, 63);
}
template <int NR> __device__ __forceinline__ void topk_row(const LAS unsigned* srow, int nreg, int lane, LAS unsigned* mrow  ) {
    unsigned u[NR];
#pragma unroll
    for (int j = 0; j < NR; ++j) u[j] = srow[64 * j + lane];
    unsigned Tt = 0u;
#pragma unroll 1
    for (int bit = 31; bit >= 0; --bit) {
        const unsigned cand = (unsigned)__builtin_amdgcn_readfirstlane((int)(Tt | (1u << bit))); int c4[4] = {0, 0, 0, 0};
#pragma unroll
        for (int j = 0; j < NR; ++j) cnt_ge_u32(c4[j & 3], u[j], cand);
        const int cnt = wave_sum_dpp((c4[0] + c4[1]) + (c4[2] + c4[3]));
        if (cnt >= 256) Tt = cand;
        if (cnt == 256) break;
    }
    int cge = 0;
#pragma unroll
    for (int j = 0; j < NR; ++j) { const unsigned uu = u[j]; cge += (uu >= Tt) ? 1 : 0;
        u[j] = uu > Tt ? 0u : (uu == Tt ? (unsigned)(1 + 64 * j + lane) : 4096u); }
    const int cgt = 0, ceq = wave_sum_dpp(cge);
    unsigned X = 2048u;
    if (cgt + ceq > 256) {
        unsigned Xb = 0u;
#pragma unroll 1
        for (int bit = 11; bit >= 0; --bit) {
            const unsigned cand = (unsigned)__builtin_amdgcn_readfirstlane((int)(Xb | (1u << bit))); int c4[4] = {0, 0, 0, 0};
#pragma unroll
            for (int j = 0; j < NR; ++j) cnt_le_u32(c4[j & 3], u[j], cand);
            const int cnt = wave_sum_dpp((c4[0] + c4[1]) + (c4[2] + c4[3]));
            if (cnt <= 256) Xb = cand;
        }
        X = Xb;
    }
    unsigned myword = 0u;
#pragma unroll
    for (int j = 0; j < NR; ++j) { const unsigned long long bal = __ballot(u[j] <= X); if ((lane >> 1) == j) myword = (lane & 1) ? (unsigned)(bal >> 32) : (unsigned)bal; }
    if (lane < 2 * nreg) mrow[16 * lane] = myword;
}
__device__ __forceinline__ void indexer_item(const Ptrs& p, int item, LAS unsigned char* lds) {
    const int tid = threadIdx.x, lane = tid & 63, w = __builtin_amdgcn_readfirstlane(tid >> 6), q = lane & 15, g = lane >> 4;
    const int b = item >> 7, qg = item & 127, c = qg >> 2, nw = 2 * (c + 1);
    unsigned* MASKT = (unsigned*)(p.ws + WS_MASK) + (size_t)b * 64 * SEQ;
    if (c < 4) { for (int idx = tid; idx < nw * 16; idx += NTHR) MASKT[(size_t)(idx >> 4) * SEQ + qg * 16 + (idx & 15)] = 0xFFFFFFFFu; return; }
    const bf16* QI = (const bf16*)(p.ws + WS_QI); const bf16* KIDX = (const bf16*)(p.ws + WS_KIDX); const float* WH = (const float*)(p.ws + WS_WH);
    LAS unsigned* S = (LAS unsigned*)lds;
    {
        const size_t tokq = (size_t)b * SEQ + qg * 16 + q;
        bf16x8 qf[4][2]; float wq[4];
#pragma unroll
        for (int h = 0; h < 4; ++h) { wq[h] = WH[tokq * 4 + h];
#pragma unroll
            for (int ks = 0; ks < 2; ++ks) qf[h][ks] = *(const bf16x8*)(QI + tokq * 256 + h * 64 + 32 * ks + 8 * g); }
        const int ntile = 4 * (c + 1);
#pragma unroll 4
        for (int j = w; j < ntile; j += 8) {
            const bf16* kp = KIDX + ((size_t)b * SEQ + 16 * j + q) * 64 + 8 * g;
            const bf16x8 k0 = *(const bf16x8*)kp, k1 = *(const bf16x8*)(kp + 32);
            float sc[4] = {0.f, 0.f, 0.f, 0.f};
#pragma unroll
            for (int h = 0; h < 4; ++h) { f32x4 C = {0.f, 0.f, 0.f, 0.f};
                C = __builtin_amdgcn_mfma_f32_16x16x32_bf16(k0, qf[h][0], C, 0, 0, 0); C = __builtin_amdgcn_mfma_f32_16x16x32_bf16(k1, qf[h][1], C, 0, 0, 0);
#pragma unroll
                for (int i = 0; i < 4; ++i) sc[i] += wq[h] * fmaxf(C[i], 0.f); }
            *(LAS u32x4*)(S + q * IX_P + 16 * j + 4 * g) = (u32x4){ord_u32(sc[0]), ord_u32(sc[1]), ord_u32(sc[2]), ord_u32(sc[3])};
        }
    }
    {
        const int nend = ((c + 8) & ~7) * 64, n0 = 64 * (c + 1);
        for (int idx = tid; idx < 16 * ((nend - n0) >> 2); idx += NTHR) { const int per = (nend - n0) >> 2, r = idx / per, k4 = idx % per; *(LAS u32x4*)(S + r * IX_P + n0 + 4 * k4) = (u32x4){0u, 0u, 0u, 0u}; }
    }
    __syncthreads();
    {
        const int nreg = c + 1;
#pragma unroll 1
        for (int rr = 0; rr < 2; ++rr) { const int row = 2 * w + rr; const LAS unsigned* srow = S + row * IX_P; LAS unsigned* mrow = S + 16 * IX_P + row;
            if (nreg <= 8) topk_row<8>(srow, nreg, lane, mrow); else if (nreg <= 16) topk_row<16>(srow, nreg, lane, mrow);
            else if (nreg <= 24) topk_row<24>(srow, nreg, lane, mrow); else topk_row<32>(srow, nreg, lane, mrow); }
    }
    __syncthreads();
    for (int idx = tid; idx < nw * 16; idx += NTHR) MASKT[(size_t)(idx >> 4) * SEQ + qg * 16 + (idx & 15)] = S[16 * IX_P + idx];
    __syncthreads();
}

__device__ __forceinline__ int crow(int r, int hi) { return (r & 3) + 8 * (r >> 2) + 4 * hi; }
constexpr int AT_KP = 144, AT_VP = 136, AT_KB = 64 * AT_KP, AT_VB = 64 * AT_VP, AT_STAGE = AT_KB + AT_VB;
struct AtRegs { u32x4 k, v; unsigned m0, m1; };
__device__ __forceinline__ void attn_unit(const Ptrs& p, int b, int h, int QB, LAS unsigned char* lds) {
    const int tid = threadIdx.x, lane = tid & 63, w = __builtin_amdgcn_readfirstlane(tid >> 6), q = lane & 31, hh = lane >> 5;
    const int tq = 256 * QB + 32 * w + q, NT = 4 * QB + 4, ntw = 4 * QB + (w >> 1) + 1;
    const size_t tok = (size_t)b * SEQ + tq;
    const bf16* Q = (const bf16*)(p.ws + WS_Q); const bf16* Kb = (const bf16*)(p.ws + WS_K) + (size_t)b * SEQ * 512 + h * 64;
    const bf16* VTb = (const bf16*)(p.ws + WS_VT) + (size_t)(b * 8 + h) * 64 * SEQ; const unsigned* MASKT = (const unsigned*)(p.ws + WS_MASK) + (size_t)b * 64 * SEQ + tq;
    const float slope2 = __builtin_amdgcn_exp2f(-(float)(h + 1)) * LOG2E;
    bf16x8 qf[4];
#pragma unroll
    for (int ks = 0; ks < 4; ++ks) qf[ks] = *(const bf16x8*)(Q + tok * 512 + h * 64 + 16 * ks + 8 * hh);
    const int srow = tid >> 3, sch = tid & 7;
    const bf16* kg = Kb + (size_t)srow * 512 + sch * 8; const bf16* vg = VTb + (size_t)srow * SEQ + sch * 8;
    const int kso = srow * AT_KP + sch * 16, vso = AT_KB + srow * AT_VP + sch * 16;
#define AT_LOAD(R, i_) do { if ((i_) < NT) { const int t_ = NT - 1 - (i_); (R).k = *(const u32x4*)(kg + (size_t)t_ * 64 * 512); (R).v = *(const u32x4*)(vg + t_ * 64); \
        if (t_ < ntw) { (R).m0 = MASKT[(size_t)(2 * t_) * SEQ]; (R).m1 = MASKT[(size_t)(2 * t_ + 1) * SEQ]; } } } while (0)
#define AT_WRITE(R, so) do { *(LAS u32x4*)(lds + (so) + kso) = (R).k; *(LAS u32x2*)(lds + (so) + vso) = (u32x2){(R).v.x, (R).v.y}; *(LAS u32x2*)(lds + (so) + vso + 8) = (u32x2){(R).v.z, (R).v.w}; } while (0)
    f32x16 o0 = {}, o1 = {}; float m = -INFINITY, l = 0.f;
#define AT_COMPUTE(kt, so, w0, w1) do { if ((kt) < ntw) { \
        LAS const unsigned char* sb = lds + (so); \
        f32x16 S0, S1; \
        if (64 * (kt) + 63 < 256 * QB + 32 * w) {        \
            const float lb0 = -slope2 * (float)(tq - 64 * (kt) - 4 * hh); \
            _Pragma("unroll") for (int r = 0; r < 16; ++r) { S0[r] = lb0 + slope2 * (float)((r & 3) + 8 * (r >> 2)); S1[r] = S0[r] + 32.0f * slope2; } \
        } else { \
            _Pragma("unroll") for (int r = 0; r < 16; ++r) { const int key = 64 * (kt) + crow(r, hh); const int d0 = tq > key ? tq - key : key - tq; const int key1 = key + 32; const int d1 = tq > key1 ? tq - key1 : key1 - tq; \
                S0[r] = -slope2 * (float)d0; S1[r] = -slope2 * (float)d1; } \
        } \
        _Pragma("unroll") for (int ks = 0; ks < 4; ++ks) { \
            const bf16x8 k0 = *(LAS const bf16x8*)(sb + q * AT_KP + 32 * ks + 16 * hh), k1 = *(LAS const bf16x8*)(sb + (32 + q) * AT_KP + 32 * ks + 16 * hh); \
            S0 = __builtin_amdgcn_mfma_f32_32x32x16_bf16(k0, qf[ks], S0, 0, 0, 0); S1 = __builtin_amdgcn_mfma_f32_32x32x16_bf16(k1, qf[ks], S1, 0, 0, 0); } \
          \
        float rm = fmaxf(S0[0], S1[0]); \
        _Pragma("unroll") for (int r = 1; r < 16; ++r) rm = fmaxf(fmaxf(rm, S0[r]), S1[r]); \
        rm = fmaxf(rm, __shfl_xor(rm, 32)); \
        if (__any(rm > m)) { const float mn = fmaxf(m, rm), alpha = __builtin_amdgcn_exp2f(m - mn); l *= alpha; m = mn; \
            _Pragma("unroll") for (int r = 0; r < 16; ++r) { o0[r] *= alpha; o1[r] *= alpha; } } \
        float ls = 0.f; \
        _Pragma("unroll") for (int r = 0; r < 16; ++r) { const int cr = crow(r, hh); \
            const unsigned e0 = __builtin_bit_cast(unsigned, __builtin_amdgcn_exp2f(S0[r] - m)) & (unsigned)__builtin_amdgcn_sbfe((int)(w0), cr, 1); \
            const unsigned e1 = __builtin_bit_cast(unsigned, __builtin_amdgcn_exp2f(S1[r] - m)) & (unsigned)__builtin_amdgcn_sbfe((int)(w1), cr, 1); \
            S0[r] = __builtin_bit_cast(float, e0); S1[r] = __builtin_bit_cast(float, e1); ls += S0[r] + S1[r]; } \
        l += ls; \
        LAS const unsigned char* vb = sb + AT_KB; \
        _Pragma("unroll") for (int s2 = 0; s2 < 4; ++s2) { \
            const bf16x8 pa = (s2 < 2) \
                ? __builtin_bit_cast(bf16x8, (u32x4){cvt_pk_bf16(S0[8 * (s2 & 1)], S0[8 * (s2 & 1) + 1]), cvt_pk_bf16(S0[8 * (s2 & 1) + 2], S0[8 * (s2 & 1) + 3]), cvt_pk_bf16(S0[8 * (s2 & 1) + 4], S0[8 * (s2 & 1) + 5]), cvt_pk_bf16(S0[8 * (s2 & 1) + 6], S0[8 * (s2 & 1) + 7])}) \
                : __builtin_bit_cast(bf16x8, (u32x4){cvt_pk_bf16(S1[8 * (s2 & 1)], S1[8 * (s2 & 1) + 1]), cvt_pk_bf16(S1[8 * (s2 & 1) + 2], S1[8 * (s2 & 1) + 3]), cvt_pk_bf16(S1[8 * (s2 & 1) + 4], S1[8 * (s2 & 1) + 5]), cvt_pk_bf16(S1[8 * (s2 & 1) + 6], S1[8 * (s2 & 1) + 7])}); \
            const u32x2 a0 = *(LAS const u32x2*)(vb + q * AT_VP + 32 * s2 + 8 * hh), a1 = *(LAS const u32x2*)(vb + q * AT_VP + 32 * s2 + 8 * hh + 16); \
            const u32x2 c0 = *(LAS const u32x2*)(vb + (32 + q) * AT_VP + 32 * s2 + 8 * hh), c1 = *(LAS const u32x2*)(vb + (32 + q) * AT_VP + 32 * s2 + 8 * hh + 16); \
            o0 = __builtin_amdgcn_mfma_f32_32x32x16_bf16(__builtin_bit_cast(bf16x8, (u32x4){a0.x, a0.y, a1.x, a1.y}), pa, o0, 0, 0, 0); \
            o1 = __builtin_amdgcn_mfma_f32_32x32x16_bf16(__builtin_bit_cast(bf16x8, (u32x4){c0.x, c0.y, c1.x, c1.y}), pa, o1, 0, 0, 0); } } } while (0)
    AtRegs R0, R1; R0.m0 = R0.m1 = R1.m0 = R1.m1 = 0u; R0.k = R0.v = R1.k = R1.v = (u32x4){0u, 0u, 0u, 0u};
    AT_LOAD(R0, 0); AT_LOAD(R1, 1);
    unsigned cm0 = R0.m0, cm1 = R0.m1;
    AT_WRITE(R0, 0);
    AT_LOAD(R0, 2);
    __syncthreads();
    int s_cur = 0, s_nxt = AT_STAGE, s_nn = 2 * AT_STAGE;
    for (int kt = 0; kt < NT; kt += 2) {
        AT_COMPUTE(NT - 1 - kt, s_cur, cm0, cm1);
        cm0 = R1.m0; cm1 = R1.m1;
        AT_WRITE(R1, s_nxt);
        AT_LOAD(R1, kt + 3);
        __syncthreads();
        AT_COMPUTE(NT - 2 - kt, s_nxt, cm0, cm1);
        cm0 = R0.m0; cm1 = R0.m1;
        if (kt + 2 < NT) AT_WRITE(R0, s_nn);
        AT_LOAD(R0, kt + 4);
        __syncthreads();
        { const int t0 = s_cur; s_cur = s_nn; s_nn = s_nxt; s_nxt = t0; }
    }
#undef AT_LOAD
#undef AT_WRITE
#undef AT_COMPUTE
    l += __shfl_xor(l, 32);
    const float inv = 1.0f / l;
    bf16* OC = (bf16*)(p.ws + WS_XB) + tok * D + 512 + h * 64;
#pragma unroll
    for (int r4 = 0; r4 < 4; ++r4) {
        u32x2 a; a.x = pk2(o0[4 * r4] * inv, o0[4 * r4 + 1] * inv); a.y = pk2(o0[4 * r4 + 2] * inv, o0[4 * r4 + 3] * inv); *(u32x2*)(OC + 8 * r4 + 4 * hh) = a;
        u32x2 c; c.x = pk2(o1[4 * r4] * inv, o1[4 * r4 + 1] * inv); c.y = pk2(o1[4 * r4 + 2] * inv, o1[4 * r4 + 3] * inv); *(u32x2*)(OC + 32 + 8 * r4 + 4 * hh) = c; }
}

constexpr int R6_HP = 1028;
constexpr int R6_HBUF = 0, R6_PART = 16 * R6_HP * 4, R6_LCNT = R6_PART + 8 * 16 * 64 * 4, R6_GBASE = R6_LCNT + 256, R6_ENT = R6_GBASE + 256;
__device__ __forceinline__ void phase_ln1_router(const Ptrs& p, LAS unsigned char* lds, int vcu, int G) {
    const int tid = threadIdx.x, lane = tid & 63, wave = __builtin_amdgcn_readfirstlane(tid >> 6);
    LAS float* hbuf = (LAS float*)(lds + R6_HBUF); LAS float* part = (LAS float*)(lds + R6_PART);
    LAS int* lcnt = (LAS int*)(lds + R6_LCNT); LAS int* gbase = (LAS int*)(lds + R6_GBASE); LAS int* ent = (LAS int*)(lds + R6_ENT);
    const float* pre = (const float*)(p.ws + WS_HB); bf16* H1B = (bf16*)(p.ws + WS_XB);
    const float* g1 = p.in[12]; const float* b1 = p.in[13]; const float* Wr = p.in[14]; const float rbias = p.in[15][lane];
    unsigned* cnt = (unsigned*)(p.ws + WS_CTL) + CW_CNT; int* LTOK = (int*)(p.ws + WS_LTOK); float* LW = (float*)(p.ws + WS_LW); unsigned* ROUTE = (unsigned*)(p.ws + WS_ROUTE);
    for (int tile = vcu; tile < T / 64; tile += G) {
        if (tid < 64) lcnt[tid] = 0;
        for (int sub = 0; sub < 4; ++sub) {
            const int tok0 = tile * 64 + sub * 16;
#pragma unroll
            for (int j2 = 0; j2 < 2; ++j2) { const int tl = 2 * wave + j2; const size_t tok = tok0 + tl;
                f32x4 v[4]; float s = 0.f;
#pragma unroll
                for (int jj = 0; jj < 4; ++jj) { v[jj] = *(const f32x4*)(pre + tok * D + 4 * lane + 256 * jj); s += (v[jj][0] + v[jj][1]) + (v[jj][2] + v[jj][3]); }
                const float mean = wave_sum(s) * (1.0f / D); float s2 = 0.f;
#pragma unroll
                for (int jj = 0; jj < 4; ++jj) { v[jj] = v[jj] - mean; s2 += (v[jj][0] * v[jj][0] + v[jj][1] * v[jj][1]) + (v[jj][2] * v[jj][2] + v[jj][3] * v[jj][3]); }
                const float rstd = 1.0f / sqrtf(wave_sum(s2) * (1.0f / D) + 1e-5f);
#pragma unroll
                for (int jj = 0; jj < 4; ++jj) { const int c0 = 4 * lane + 256 * jj; const f32x4 gg = *(const f32x4*)(g1 + c0), bb = *(const f32x4*)(b1 + c0);
                    const f32x4 hv = v[jj] * rstd * gg + bb;
                    u32x2 o; o.x = pk2(hv[0], hv[1]); o.y = pk2(hv[2], hv[3]); *(u32x2*)(H1B + tok * D + c0) = o;
                    *(LAS f32x4*)(hbuf + tl * R6_HP + c0) = hv; } }
            __syncthreads();
            { f32x4 acc[4];
#pragma unroll
              for (int nt = 0; nt < 4; ++nt) acc[nt] = (f32x4){0.f, 0.f, 0.f, 0.f};
              const LAS float* ap = hbuf + (lane & 15) * R6_HP + 128 * wave + (lane >> 4); const float* bp = Wr + (size_t)(128 * wave + (lane >> 4)) * 64 + (lane & 15);
#pragma unroll 8
              for (int ks = 0; ks < 32; ++ks) { const float a = ap[4 * ks];
#pragma unroll
                  for (int nt = 0; nt < 4; ++nt) acc[nt] = __builtin_amdgcn_mfma_f32_16x16x4f32(a, bp[(size_t)ks * 256 + 16 * nt], acc[nt], 0, 0, 0); }
#pragma unroll
              for (int nt = 0; nt < 4; ++nt)
#pragma unroll
                  for (int r = 0; r < 4; ++r) part[(wave * 16 + (lane >> 4) * 4 + r) * 64 + 16 * nt + (lane & 15)] = acc[nt][r]; }
            __syncthreads();
#pragma unroll 1
            for (int j2 = 0; j2 < 2; ++j2) { const int tl = 2 * wave + j2; float logit = 0.f;
#pragma unroll
                for (int ww = 0; ww < 8; ++ww) logit += part[(ww * 16 + tl) * 64 + lane];
                const float score = sigmoidf_(logit); const float sel = score + rbias;
                float m1 = sel; m1 = fmaxf(m1, __shfl_xor(m1, 1)); m1 = fmaxf(m1, __shfl_xor(m1, 2)); m1 = fmaxf(m1, __shfl_xor(m1, 4));
                const unsigned long long bm = __ballot(sel == m1) & (0xFFull << (lane & 56));
                const int first = __ffsll((long long)bm) - 1;
                float m2 = (lane == first) ? -INFINITY : sel; m2 = fmaxf(m2, __shfl_xor(m2, 1)); m2 = fmaxf(m2, __shfl_xor(m2, 2)); m2 = fmaxf(m2, __shfl_xor(m2, 4));
                const float gs = m1 + m2; const int grpi = lane >> 3; int grank = 0;
#pragma unroll
                for (int j = 0; j < 8; ++j) { const float gj = __shfl(gs, j * 8); grank += (gj > gs || (gj == gs && j < grpi)) ? 1 : 0; }
                const float selm = grank < 4 ? sel : -INFINITY; int rank = 0;
                const unsigned long long mykey = ((unsigned long long)ord_u32(selm) << 8) | (unsigned)(63 - lane);
#pragma unroll
                for (int j = 0; j < 64; ++j) { const unsigned long long kj = ((unsigned long long)(unsigned)__shfl((int)(mykey >> 8), j) << 8) | (unsigned)(63 - j); cnt_gt_u64(rank, kj, mykey); }
                const bool chosen = rank < TOPK;
                const float wsum = wave_sum(chosen ? score : 0.f); const float wgt = score / wsum * 2.5f;
                const unsigned long long cm = __ballot(chosen); const int k = __popcll(cm & ((1ull << lane) - 1ull));
                if (chosen) { const int lpos = __hip_atomic_fetch_add(lcnt + lane, 1, __ATOMIC_RELAXED, __HIP_MEMORY_SCOPE_WORKGROUP);
                    LAS int* en = ent + ((sub * 16 + tl) * 8 + k) * 3; en[0] = lane; en[1] = lpos; en[2] = __builtin_bit_cast(int, wgt); } }
            __syncthreads();
        }
        if (tid < 64) gbase[tid] = (int)atomicAdd(cnt + 64 * tid, (unsigned)lcnt[tid]);
        __syncthreads();
        { const int tl = tid >> 3, k = tid & 7; const LAS int* en = ent + (tl * 8 + k) * 3; const int e = en[0], pos = gbase[e] + en[1], tok = tile * 64 + tl;
          LTOK[(size_t)e * T + pos] = tok; LW[(size_t)e * T + pos] = __builtin_bit_cast(float, en[2]); ROUTE[(size_t)tok * 8 + k] = ((unsigned)e << 16) | (unsigned)pos; }
        __syncthreads();
    }
}

__device__ __forceinline__ void moe_tables(const Ptrs& p, LAS int* tab, int v, int G) {
    const int tid = threadIdx.x;
    const unsigned* cnt = (const unsigned*)(p.ws + WS_CTL) + CW_CNT; const int* LTOK = (const int*)(p.ws + WS_LTOK);
    if (tid < 64) tab[66 + tid] = ((int)__hip_atomic_load(cnt + 64 * tid, __ATOMIC_RELAXED, __HIP_MEMORY_SCOPE_AGENT) + 255) >> 8;
    __syncthreads();
    if (tid == 0) { int s = 0; for (int e = 0; e < NE; ++e) { const int n = tab[66 + e]; tab[e] = s; s += n; } tab[NE] = s; tab[NE + 1] = s + T / 256; }
    __syncthreads();
    const int ntile = tab[NE + 1];
    int nu2 = 0, nu1 = 0;
    for (int i = 0; i < MOE_MAXU; ++i) { if ((long)i * G + v < 2 * ntile) nu2 = i + 1; if ((long)i * G + v < ntile) nu1 = i + 1; }
    if (tid < 16) { const int which = tid >> 3, i = tid & 7, nN = which ? 1 : 2, nu = which ? nu1 : nu2;
        if (i < nu) { const int L = i * G + v, tile = L / nN, pn = L % nN; int e = 0; while (tab[e + 1] <= tile) ++e;
            LAS int* u = tab + (which ? 192 : 128) + 4 * i; u[0] = tile; u[1] = pn; u[2] = e; u[3] = tile - tab[e]; } }
    if (tid == 0) { tab[126] = nu2; tab[127] = nu1; }
    __syncthreads();
    for (int idx = tid; idx < nu2 * 256; idx += NTHR) { const int i = idx >> 8, r = idx & 255, e = tab[130 + 4 * i], mt = tab[131 + 4 * i], pos = mt * 256 + r;
        tab[256 + idx] = e < NE ? (pos < (int)__hip_atomic_load(cnt + 64 * e, __ATOMIC_RELAXED, __HIP_MEMORY_SCOPE_AGENT) ? LTOK[(size_t)e * T + pos] : 0) : pos; }
    { const float* LW = (const float*)(p.ws + WS_LW);
      for (int idx = tid; idx < nu1 * 256; idx += NTHR) { const int i = idx >> 8, r = idx & 255, e = tab[194 + 4 * i], mt = tab[195 + 4 * i];
          ((LAS float*)tab)[1536 + idx] = e < NE ? LW[(size_t)e * T + mt * 256 + r] : 1.0f; } }
    __syncthreads();
}

__device__ __forceinline__ void phase_combine(const Ptrs& p, LAS int* tab, int j, int vcu, int G) {
    const int tid = threadIdx.x, lane = tid & 63, wave = tid >> 6;
    const bf16* Y = (const bf16*)(p.ws + WS_Y); const bf16* H1B = (const bf16*)(p.ws + WS_XB); const unsigned* ROUTE = (const unsigned*)(p.ws + WS_ROUTE);
    for (int tok = vcu * NWAVES + wave; tok < T; tok += G * NWAVES) {
        const u32x2 hv = *(const u32x2*)(H1B + (size_t)tok * D + 256 * j + 4 * lane);
        f32x4 a = {ALPHA * bflo(hv.x), ALPHA * bfhi(hv.x), ALPHA * bflo(hv.y), ALPHA * bfhi(hv.y)};
        { const u32x2 y = *(const u32x2*)(Y + ((size_t)tab[NE] * 256 + tok) * 256 + 4 * lane); a[0] += bflo(y.x); a[1] += bfhi(y.x); a[2] += bflo(y.y); a[3] += bfhi(y.y); }
#pragma unroll
        for (int k = 0; k < TOPK; ++k) { const unsigned r = ROUTE[(size_t)tok * 8 + k]; const size_t row = (size_t)tab[r >> 16] * 256 + (r & 0xffffu);
            const u32x2 y = *(const u32x2*)(Y + row * 256 + 4 * lane); a[0] += bflo(y.x); a[1] += bfhi(y.x); a[2] += bflo(y.y); a[3] += bfhi(y.y); }
        *(f32x4*)(p.out + (size_t)tok * D + 256 * j + 4 * lane) = a;
    }
}
__device__ __forceinline__ void phase_combine_ln2(const Ptrs& p, LAS int* tab, int vcu, int G) {
    const int tid = threadIdx.x, lane = tid & 63, wave = tid >> 6;
    const bf16* Y = (const bf16*)(p.ws + WS_Y); const bf16* H1B = (const bf16*)(p.ws + WS_XB); const unsigned* ROUTE = (const unsigned*)(p.ws + WS_ROUTE);
    const float* g2 = p.in[22]; const float* b2 = p.in[23];
    for (int tok = vcu * NWAVES + wave; tok < T; tok += G * NWAVES) {
        float* rowp = p.out + (size_t)tok * D;
        f32x4 v[4]; float s = 0.f;
#pragma unroll
        for (int jj = 0; jj < 3; ++jj) v[jj] = *(const f32x4*)(rowp + 4 * lane + 256 * jj);
        { const u32x2 hv = *(const u32x2*)(H1B + (size_t)tok * D + 768 + 4 * lane);
          f32x4 a = {ALPHA * bflo(hv.x), ALPHA * bfhi(hv.x), ALPHA * bflo(hv.y), ALPHA * bfhi(hv.y)};
          { const u32x2 y = *(const u32x2*)(Y + ((size_t)tab[NE] * 256 + tok) * 256 + 4 * lane); a[0] += bflo(y.x); a[1] += bfhi(y.x); a[2] += bflo(y.y); a[3] += bfhi(y.y); }
#pragma unroll
          for (int k = 0; k < TOPK; ++k) { const unsigned r = ROUTE[(size_t)tok * 8 + k]; const size_t row = (size_t)tab[r >> 16] * 256 + (r & 0xffffu);
              const u32x2 y = *(const u32x2*)(Y + row * 256 + 4 * lane); a[0] += bflo(y.x); a[1] += bfhi(y.x); a[2] += bflo(y.y); a[3] += bfhi(y.y); }
          v[3] = a; }
#pragma unroll
        for (int jj = 0; jj < 4; ++jj) s += (v[jj][0] + v[jj][1]) + (v[jj][2] + v[jj][3]);
        const float mean = wave_sum(s) * (1.0f / D); float s2 = 0.f;
#pragma unroll
        for (int jj = 0; jj < 4; ++jj) { v[jj] = v[jj] - mean; s2 += (v[jj][0] * v[jj][0] + v[jj][1] * v[jj][1]) + (v[jj][2] * v[jj][2] + v[jj][3] * v[jj][3]); }
        const float rstd = 1.0f / sqrtf(wave_sum(s2) * (1.0f / D) + 1e-5f);
#pragma unroll
        for (int jj = 0; jj < 4; ++jj) { const int c0 = 4 * lane + 256 * jj; *(f32x4*)(rowp + c0) = v[jj] * rstd * *(const f32x4*)(g2 + c0) + *(const f32x4*)(b2 + c0); }
    }
}
#define XB_TMO      128
#define XB_XCNT(j)  (256  + 64 * (j))
#define XB_XSUB(j)  (1280 + 64 * (j))
#define XB_XGEN(j)  (2304 + 64 * (j))
#define XB_TOP      3328
#define XB_TOPGEN   3392
#define XCD_BAR_WORDS 3456
#define XB_SPIN_CAP (1u << 18)
__device__ __forceinline__ unsigned xb_ld(unsigned* p)              { return __hip_atomic_load(p, __ATOMIC_RELAXED, __HIP_MEMORY_SCOPE_AGENT); }
__device__ __forceinline__ unsigned xb_add(unsigned* p, unsigned v) { return __hip_atomic_fetch_add(p, v, __ATOMIC_RELAXED, __HIP_MEMORY_SCOPE_AGENT); }
__device__ __forceinline__ unsigned xb_xcc_id() { return (unsigned)__builtin_amdgcn_s_getreg((3 << 11) | 20) & 0xFu; }
#define XB_SPIN(cond, bar) do { unsigned _sp = 0; while (cond) { __builtin_amdgcn_s_sleep(1); \
    if ((++_sp & 255u) == 0u) { if (xb_ld(&(bar)[XB_TMO])) break; if (_sp > XB_SPIN_CAP) { atomicAdd(&(bar)[XB_TMO], 1u); break; } } } } while (0)
struct XcdBarrier { unsigned* bar; unsigned x; volatile LAS unsigned* st; };
__device__ __forceinline__ XcdBarrier xcd_barrier_post(unsigned* bar, volatile LAS unsigned* st) {
    XcdBarrier b; b.bar = bar; b.x = xb_xcc_id(); b.st = st;
    if (threadIdx.x == 0) (void)xb_add(&bar[XB_XCNT(b.x)], 1u);
    return b;
}
__device__ __forceinline__ void xcd_barrier_complete(unsigned* bar, unsigned x, unsigned& nloc, unsigned& nx) {
    const unsigned G = gridDim.x * gridDim.y * gridDim.z;
    unsigned sum, cnt, mine, sp = 0u;
    for (;;) {
        sum = 0u; cnt = 0u; mine = 0u;
#pragma unroll
        for (unsigned j = 0; j < 16; ++j) { const unsigned c = xb_ld(&bar[XB_XCNT(j)]); sum += c; cnt += (c > 0u) ? 1u : 0u; mine = (j == x) ? c : mine; }
        if (sum == G) break;
        __builtin_amdgcn_s_sleep(1);
        if ((++sp & 255u) == 0u) { if (xb_ld(&bar[XB_TMO])) break; if (sp > XB_SPIN_CAP) { atomicAdd(&bar[XB_TMO], 1u); break; } }
    }
    nloc = mine > 0u ? mine : 1u; nx = cnt > 0u ? cnt : 1u;
}
__device__ __forceinline__ void xcd_barrier(const XcdBarrier& b) {
    asm volatile("s_waitcnt vmcnt(0)" ::: "memory");
    __syncthreads();
    if (threadIdx.x == 0) {
        unsigned* bar = b.bar;
        __builtin_amdgcn_s_waitcnt(0);
        unsigned nloc = b.st[0], nx = b.st[1];
        if (nloc == 0u) { xcd_barrier_complete(bar, b.x, nloc, nx); b.st[0] = nloc; b.st[1] = nx; }
        const unsigned old = xb_add(&bar[XB_XSUB(b.x)], 1u);
        const unsigned gen = old / nloc;
        if (old + 1u == (gen + 1u) * nloc) {
            __builtin_amdgcn_fence(__ATOMIC_RELEASE, "agent");
            asm volatile("s_waitcnt vmcnt(0)" ::: "memory");
            const unsigned og = xb_add(&bar[XB_TOP], 1u);
            const unsigned tg = og / nx;
            if (og + 1u == (tg + 1u) * nx) xb_add(&bar[XB_TOPGEN], 1u);
            else XB_SPIN(xb_ld(&bar[XB_TOPGEN]) == tg, bar);
            __builtin_amdgcn_fence(__ATOMIC_ACQUIRE, "agent");
            xb_add(&bar[XB_XGEN(b.x)], 1u);
            asm volatile("s_waitcnt vmcnt(0)" ::: "memory");
        } else {
            XB_SPIN(xb_ld(&bar[XB_XGEN(b.x)]) == gen, bar);
            __builtin_amdgcn_fence(__ATOMIC_ACQUIRE, "agent");
            asm volatile("s_waitcnt vmcnt(0)" ::: "memory");
        }
    }
    __syncthreads();
}

__device__ __forceinline__ void probe_between(const XcdBarrier& bar, int k, unsigned* cnt) {
    xcd_barrier(bar);
    if (k == 6) { if (blockIdx.x == 0 && threadIdx.x < 64) cnt[threadIdx.x] = 0u; xcd_barrier(bar); }
}
__device__ __forceinline__ const Ptrs* kargs() { auto k = __builtin_amdgcn_kernarg_segment_ptr(); asm volatile("" : "+s"(k)); return (const Ptrs*)k; }
constexpr int NPH = 16;
struct Args { Ptrs p; int ph_lo, ph_hi; };
__global__ void __launch_bounds__(NTHR, 2) mk_fwd(Args args) {
    extern __shared__ __attribute__((aligned(16))) unsigned char lds_raw[];
    LAS unsigned char* lds = (LAS unsigned char*)lds_raw;
    volatile LAS unsigned* MISC = (volatile LAS unsigned*)(lds + MISC_OFF);
    LAS int* tab = (LAS int*)(lds + TAB_OFF);
    const int tid = threadIdx.x, lane = tid & 63, wave = __builtin_amdgcn_readfirstlane(tid >> 6);
    const int G = gridDim.x, bx = blockIdx.x, vcu = (G % 8 == 0) ? (bx % 8) * (G / 8) + bx / 8 : bx;
    if (tid < 32) MISC[tid] = 0u;
    __syncthreads();
    XcdBarrier bar; bar.bar = (unsigned*)(kargs()->ws + WS_CTL) + CW_BAR; bar.x = 0; bar.st = nullptr;
    if (MK_N_LAUNCHES == 1) bar = xcd_barrier_post((unsigned*)(kargs()->ws + WS_CTL) + CW_BAR, MISC + 8);
    const int lo = args.ph_lo, hi = args.ph_hi;
#ifndef PHMASK
#define PHMASK 0x1FFFF
#endif
#define IN(k) (((PHMASK >> (k)) & 1) && lo <= (k) && (k) < hi)
#define SEAM(k) do { if (IN(k) && IN((k) + 1)) xcd_barrier(bar); } while (0)
#ifndef PROBE_REP
#define PROBE_REP 0
#endif
#define REPEAT(k) for (int rep_ = 0; rep_ <= ((PROBE_REP >> (k)) & 1); ++rep_, ((PROBE_REP >> (k)) & 1) ? probe_between(bar, (k), (unsigned*)(kargs()->ws + WS_CTL) + CW_CNT) : (void)0)

    if (IN(0)) REPEAT(0) { const Ptrs& p = *kargs(); unsigned char* const ws = p.ws; (void)ws; phase_prep(p, lds, vcu, G); } SEAM(0);

    if (IN(1)) REPEAT(1) { const Ptrs& p = *kargs(); unsigned char* const ws = p.ws; (void)ws;
        DenseSched S; S.init(T, DINP, D, D, (const bf16*)(ws + WS_XB), (const bf16*)(ws + WS_WIN), G, bx);
        EpiProj E{(bf16*)(ws + WS_P), (float*)(ws + WS_RSQ), (float*)(ws + WS_RSKV)};
        pg8::gemm_phase<EpiProj, DenseSched, false>(lds, D, D, S, E);
    } SEAM(1);

    if (IN(2)) REPEAT(2) { const Ptrs& p = *kargs(); unsigned char* const ws = p.ws; (void)ws;
        DenseSched S; S.init(T, NUP, KUP, DINP, (const bf16*)(ws + WS_P) + 2048, (const bf16*)(ws + WS_WUP), G, bx);
        { pg8::Unit uu;
          for (int i = 0; S.next(i, uu); ++i) { const bool isq = uu.pn < 3;
              if (tid < 256) { const f32x4 pr = *(const f32x4*)((const float*)(ws + (isq ? WS_RSQ : WS_RSKV)) + (size_t)(uu.pm * 256 + tid) * 4);
                  ((LAS float*)tab)[256 * i + tid] = __builtin_amdgcn_rsqf(((pr[0] + pr[1]) + (pr[2] + pr[3])) * (isq ? (1.0f / 256.0f) : (1.0f / 128.0f)) + 1e-6f); } }
          __syncthreads(); }
        EpiUp E{(bf16*)(ws + WS_Q), (bf16*)(ws + WS_QI), (bf16*)(ws + WS_K), (bf16*)(ws + WS_VT), (LAS const float*)tab};
        pg8::gemm_phase<EpiUp, DenseSched, false>(lds, KUP, DINP, S, E);
        phase_kidx(p, vcu, G);
        for (int item = vcu; item < 1024; item += G) hgrn1_item(p, item, lds);
    } SEAM(2);

    if (IN(3)) REPEAT(3) { const Ptrs& p = *kargs(); unsigned char* const ws = p.ws; (void)ws;
        for (int L = vcu; L < 1024; L += G) { const int i = L >> 8, idx = L & 255, b = idx >> 5, j = idx & 31;
            const int qg = (i == 0) ? j : (i == 1) ? 63 - j : (i == 2) ? 64 + j : 127 - j;
            indexer_item(p, b * 128 + qg, lds); }
        phase_scan(p, vcu, G);
    } SEAM(3);

    if (IN(4)) REPEAT(4) { const Ptrs& p = *kargs(); unsigned char* const ws = p.ws; (void)ws;
        for (int pr = vcu; pr < 256; pr += G) { const int b = pr >> 5, h = (pr >> 2) & 7, j = pr & 3;
            attn_unit(p, b, h, 7 - j, lds); attn_unit(p, b, h, j, lds); }
        for (int item = vcu; item < 1024; item += G) hgrn3_item(p, item, lds);
    } SEAM(4);

    if (IN(5)) REPEAT(5) { const Ptrs& p = *kargs(); unsigned char* const ws = p.ws; (void)ws;
        DenseSched S; S.init(T, D, D, D, (const bf16*)(ws + WS_XB), (const bf16*)(ws + WS_WOUT), G, bx);
        EpiOut E{p.in[0], (float*)(ws + WS_HB)};
        pg8::gemm_phase<EpiOut, DenseSched, false>(lds, D, D, S, E);
        phase_convert_experts(p, lds, vcu, G);
    } SEAM(5);

    if (IN(6)) REPEAT(6) { const Ptrs& p = *kargs(); unsigned char* const ws = p.ws; (void)ws; phase_ln1_router(p, lds, vcu, G); } SEAM(6);

    bool tab_ready = false;
#define MOE_TAB() do { if (!tab_ready) { moe_tables(p, tab, vcu, G); tab_ready = true; } } while (0)
    if (IN(7)) REPEAT(7) { const Ptrs& p = *kargs(); unsigned char* const ws = p.ws; (void)ws;
        MOE_TAB();
        MoeSched S{tab, 128, tab[126], (const char*)(ws + WS_XB), (const char*)(ws + WS_WGU), (size_t)0, (size_t)512 * D * 2, (size_t)256 * D * 2};
        EpiGU E{(bf16*)(ws + WS_HB)};
        pg8::gemm_phase<EpiGU, MoeSched, true>(lds, D, D, S, E);
    } SEAM(7);

#define DOWN_PHASE(ph, j) \
    if (IN(ph)) REPEAT(8) { const Ptrs& p = *kargs(); unsigned char* const ws = p.ws;     \
        MOE_TAB(); \
        MoeSched S{tab, 192, tab[127], (const char*)(ws + WS_HB), (const char*)(ws + WS_WD) + (size_t)(j) * 256 * DE * 2, (size_t)256 * DE * 2, (size_t)D * DE * 2, (size_t)0}; \
        EpiDown E{(bf16*)(ws + WS_Y), (LAS const float*)(tab + 1536)}; \
        pg8::gemm_phase<EpiDown, MoeSched, false>(lds, DE, DE, S, E); \
    } SEAM(ph);
#define COMB_PHASE(ph, j) \
    if (IN(ph)) REPEAT(9) { const Ptrs& p = *kargs(); MOE_TAB(); phase_combine(p, tab, (j), vcu, G); } SEAM(ph);
    DOWN_PHASE(8, 0) COMB_PHASE(9, 0) DOWN_PHASE(10, 1) COMB_PHASE(11, 1) DOWN_PHASE(12, 2) COMB_PHASE(13, 2) DOWN_PHASE(14, 3)
    if (IN(15)) { const Ptrs& p = *kargs(); MOE_TAB(); phase_combine_ln2(p, tab, vcu, G); }
#undef IN
#undef SEAM
}

extern "C" void kernel_launch(void* const* d_in, const int* in_sizes, int n_in, void* d_out, int out_size, void* d_ws, size_t ws_size, hipStream_t stream) {
    static int grid = 0;
    if (grid == 0) {
        if (n_in != 24 || out_size != T * D || ws_size < WS_END) { fprintf(stderr, "kernel_launch: unexpected problem (n_in %d, out %d, ws %zu)\n", n_in, out_size, ws_size); grid = -1; return; }
        int dev = 0, cus = 0, per_cu = 0;
        if (hipGetDevice(&dev) != hipSuccess || hipDeviceGetAttribute(&cus, hipDeviceAttributeMultiprocessorCount, dev) != hipSuccess) { grid = -1; return; }
        if (hipFuncSetAttribute((const void*)mk_fwd, hipFuncAttributeMaxDynamicSharedMemorySize, LDS_BYTES) != hipSuccess) { fprintf(stderr, "kernel_launch: hipFuncSetAttribute failed\n"); grid = -1; return; }
        if (hipOccupancyMaxActiveBlocksPerMultiprocessor(&per_cu, (const void*)mk_fwd, NTHR, LDS_BYTES) != hipSuccess || per_cu < 1) { fprintf(stderr, "kernel_launch: occupancy query says %d blocks per CU\n", per_cu); }
        (void)hipGetLastError();
        grid = cus;
    }
    if (grid < 0) return;
    (void)hipMemsetAsync((char*)d_ws + WS_CTL, 0, CTL_ZERO_BYTES, stream);
    Args a{};
    for (int i = 0; i < 24; ++i) a.p.in[i] = (const float*)d_in[i];
    a.p.out = (float*)d_out; a.p.ws = (unsigned char*)d_ws;
    if (MK_N_LAUNCHES == 1) { a.ph_lo = 0; a.ph_hi = NPH; hipLaunchKernelGGL(mk_fwd, dim3(grid), dim3(NTHR), LDS_BYTES, stream, a); }
    else for (int ph = 0; ph < NPH; ++ph) { a.ph_lo = ph; a.ph_hi = ph + 1; hipLaunchKernelGGL(mk_fwd, dim3(grid), dim3(NTHR), LDS_BYTES, stream, a); }
}
```

```cpp
#include <hip/hip_runtime.h>
#include <cstdint>
#include <cstdio>

#define LAS __attribute__((address_space(3)))
#define GAS __attribute__((address_space(1)))
typedef unsigned short bf16;
typedef short bf16x8 __attribute__((ext_vector_type(8)));
typedef short s16x4 __attribute__((ext_vector_type(4)));
typedef float f32x2 __attribute__((ext_vector_type(2)));
typedef float f32x4 __attribute__((ext_vector_type(4)));
typedef float f32x16 __attribute__((ext_vector_type(16)));
typedef unsigned u32x2 __attribute__((ext_vector_type(2)));
typedef unsigned u32x4 __attribute__((ext_vector_type(4)));
typedef GAS unsigned gu32;
#define RLX_AGENT __ATOMIC_RELAXED, __HIP_MEMORY_SCOPE_AGENT

#ifndef MK_N_LAUNCHES
#define MK_N_LAUNCHES 1
#endif

constexpr int NB = 8, SEQ = 2048, T = NB * SEQ, D = 1024, DIN = 2500, DINP = 2560;
constexpr int NE = 64, NEX = 65  , DE = 256, TOPK = 8;
constexpr int KUP = 384, NUP = 1792;
constexpr float ALPHA = 1.18920711500272f;
constexpr float LOG2E = 1.4426950408889634f;
constexpr int HROWS = 147456 + T;
constexpr int NWAVES = 8, NTHR = 512;

constexpr size_t MiB = 1u << 20;
constexpr size_t WS_CTL = 0, CTL_ZERO_BYTES = 1 * MiB;
constexpr size_t WS_RSQ = 1 * MiB, WS_RSKV = WS_RSQ + 256 * 1024, WS_WH = WS_RSKV + 256 * 1024, WS_DEC = WS_WH + 256 * 1024;
constexpr size_t WS_LB = 2 * MiB + 256 * 1024;
constexpr size_t WS_ROUTE = 2 * MiB + 512 * 1024;
constexpr size_t WS_WUP = 4 * MiB, WS_WOUT = 6 * MiB, WS_MASK = 8 * MiB, WS_KIDX = 12 * MiB, WS_LTOK = 14 * MiB, WS_LW = 18 * MiB;
constexpr size_t WS_XB = 24 * MiB;
constexpr size_t WS_WIN = 56 * MiB, WS_P = 61 * MiB, WS_Q = 141 * MiB, WS_QI = 157 * MiB, WS_K = 165 * MiB, WS_VT = 181 * MiB, WS_DS = 197 * MiB, WS_SP = 229 * MiB;
constexpr size_t WS_WD = 56 * MiB, WS_WGU = 89 * MiB, WS_Y = 89 * MiB, WS_HB = 169 * MiB, WS_YT = 249 * MiB, WS_END = 265 * MiB;
constexpr int YSPLIT = 131072;
constexpr int CW_Q = 16384;
constexpr int CW_TMO = 0, CW_BAR = 4096, CW_CNT = 8192;

constexpr int RING_BYTES = 131072;
constexpr int TAB_OFF = RING_BYTES;
constexpr int MISC_OFF = RING_BYTES + 12288;
constexpr int LDS_BYTES = 147456;

__device__ __forceinline__ unsigned f2bf(float f) { unsigned u = __builtin_bit_cast(unsigned, f); return (u + 0x7fffu + ((u >> 16) & 1u)) >> 16; }
__device__ __forceinline__ unsigned pk2(float lo, float hi) { return f2bf(lo) | (f2bf(hi) << 16); }
__device__ __forceinline__ float bf2f(unsigned h) { return __builtin_bit_cast(float, h << 16); }
__device__ __forceinline__ float bflo(unsigned w) { return __builtin_bit_cast(float, w << 16); }
__device__ __forceinline__ float bfhi(unsigned w) { return __builtin_bit_cast(float, w & 0xffff0000u); }
__device__ __forceinline__ float sigmoidf_(float x) { return 1.0f / (1.0f + __expf(-x)); }
__device__ __forceinline__ float siluf_(float x) { return x / (1.0f + __expf(-x)); }
__device__ __forceinline__ float wave_sum(float v) {
#pragma unroll
    for (int o = 1; o < 64; o <<= 1) v += __shfl_xor(v, o);
    return v;
}
#define LDS_WAIT() asm volatile("s_waitcnt lgkmcnt(0)" ::: "memory")
#define VM_WAIT() asm volatile("s_waitcnt vmcnt(0)" ::: "memory")

namespace pg8 {
constexpr int BM = 256, BK = 64, HALF = 128, HTB = HALF * BK * 2, STAGE_BYTES = 8 * HTB;
__host__ __device__ __forceinline__ int lds_byte(int r, int c) { const int st = (r >> 4) * 2 + (c >> 5), rr = r & 15, cc = c & 31, ob = rr * 64 + cc * 2; return st * 1024 + (ob ^ (((ob >> 9) & 1) << 5)); }
__host__ __device__ __forceinline__ void stage_rc(int b, int& R, int& C) { const int st = b / 1024, sb = b % 1024, swz = sb ^ (((sb >> 9) & 1) << 5); R = (st >> 1) * 16 + swz / 64; C = (st & 1) * 32 + (swz % 64) / 2; }
__host__ __device__ __forceinline__ int perm32(int rho) { const int n = rho >> 4, i = rho & 15; return 8 * (i >> 2) + 4 * n + (i & 3); }

struct Unit { int pm, pn, aux, slot; const char* A; const char* B; };

__device__ __forceinline__ unsigned cvt_pk_bf16(float lo, float hi) { unsigned r; asm volatile("v_cvt_pk_bf16_f32 %0, %1, %2" : "=v"(r) : "v"(lo), "v"(hi)); return r; }

template <class Epi, class Sched, bool GATHER>
__device__ __forceinline__ void gemm_phase(LAS unsigned char* lds, const int K, const int lda, const Sched& S, const Epi& E) {
    const int tid = threadIdx.x, wid = __builtin_amdgcn_readfirstlane(tid >> 6), lane = tid & 63, wr = wid >> 2, wc = wid & 3, fr = lane & 15, fq = lane >> 4;
    const int nt = K / BK;
    int sR[2], sC[2];
    unsigned voffB[2];
#pragma unroll
    for (int i = 0; i < 2; ++i) { stage_rc(tid * 16 + i * 8192, sR[i], sC[i]); const int Rb = Epi::PERM ? ((sR[i] & ~31) + perm32(sR[i] & 31)) : sR[i]; voffB[i] = (unsigned)(Rb * K + sC[i]) * 2u; }
    const size_t kstep = (size_t)(BK * 2);
    const size_t hstepB = (size_t)HALF * K * 2, hstepA = (size_t)HALF * lda * 2;
    unsigned voffA[2];
#pragma unroll
    for (int i = 0; i < 2; ++i) voffA[i] = (unsigned)(sR[i] * lda + sC[i]) * 2u;
    const unsigned ldsw = (unsigned)wid * 1024u;
    const int aoff = lds_byte(wr * 64 + fr, fq * 8), boff = lds_byte(wc * 32 + fr, fq * 8);
#define PG8_SA(b, h) (((b) * 2 + (h)) * HTB)
#define PG8_SB(b, h) ((4 + (b) * 2 + (h)) * HTB)
#define PG8_STAGE(bufoff, gbase, voff) do { _Pragma("unroll") for (int _i = 0; _i < 2; ++_i) \
        __builtin_amdgcn_global_load_lds((const unsigned*)((const char*)(gbase) + (voff)[_i]), (LAS unsigned*)(lds + (bufoff) + ldsw + _i * 8192), 16, 0, 0); } while (0)
#define PG8_LDA(dst, b, h) do { _Pragma("unroll") for (int m = 0; m < 4; ++m) _Pragma("unroll") for (int k = 0; k < 2; ++k) dst[m][k] = *(const LAS bf16x8*)(lds + PG8_SA(b, h) + aoff + m * 2048 + k * 1024); } while (0)
#define PG8_LDB(dst, b, h) do { _Pragma("unroll") for (int n = 0; n < 2; ++n) _Pragma("unroll") for (int k = 0; k < 2; ++k) dst[n][k] = *(const LAS bf16x8*)(lds + PG8_SB(b, h) + boff + n * 2048 + k * 1024); } while (0)
#define PG8_MMA(ai, bj, At, Bt) do { __builtin_amdgcn_s_setprio(1); _Pragma("unroll") for (int m = 0; m < 4; ++m) _Pragma("unroll") for (int n = 0; n < 2; ++n) _Pragma("unroll") for (int k = 0; k < 2; ++k) \
        acc[ai][bj][m][n] = __builtin_amdgcn_mfma_f32_16x16x32_bf16(Bt[n][k], At[m][k], acc[ai][bj][m][n], 0, 0, 0); __builtin_amdgcn_s_setprio(0); } while (0)
#define PG8_WAIT_V(n) asm volatile("s_waitcnt vmcnt(" #n ")" ::: "memory")
#define PG8_WAIT_L(n) asm volatile("s_waitcnt lgkmcnt(" #n ")" ::: "memory")
#define PG8_BAR __builtin_amdgcn_s_barrier()
#define PG8_SCHED __builtin_amdgcn_sched_barrier(0)
#define PG8_AOFF(dst, u) do { if constexpr (GATHER) { _Pragma("unroll") for (int _h = 0; _h < 2; ++_h) _Pragma("unroll") for (int _i = 0; _i < 2; ++_i) { \
        const int _src = S.row((u), _h * HALF + sR[_i]); dst[_h][_i] = (unsigned)(_src * lda + sC[_i]) * 2u; } } } while (0)
#define PG8_STAGE_A(bufoff, gbase, v, h) do { if constexpr (GATHER) { PG8_STAGE(bufoff, gbase, (v)[h]); } else { PG8_STAGE(bufoff, (gbase) + (h) * hstepA, voffA); } } while (0)
    Unit cur, nxt; int ui = 0;
    if (!S.next(0, cur)) return;
    f32x4 acc[2][2][4][2];
#pragma unroll
    for (int a = 0; a < 2; ++a)
#pragma unroll
        for (int b = 0; b < 2; ++b)
#pragma unroll
            for (int m = 0; m < 4; ++m)
#pragma unroll
                for (int n = 0; n < 2; ++n) acc[a][b][m][n] = (f32x4){0.f, 0.f, 0.f, 0.f};
    bf16x8 At[4][2], B0[2][2], B1[2][2];
    unsigned vA[2][2], vN[2][2];
    PG8_AOFF(vA, cur);
#pragma unroll
    for (int h = 0; h < 2; ++h)
#pragma unroll
        for (int i = 0; i < 2; ++i) vN[h][i] = vA[h][i];
    const char* cA = cur.A; const char* cB = cur.B;
    PG8_STAGE(PG8_SB(0, 0), cB, voffB); PG8_STAGE(PG8_SB(0, 1), cB + hstepB, voffB); PG8_STAGE_A(PG8_SA(0, 0), cA, vA, 0); PG8_STAGE_A(PG8_SA(0, 1), cA, vA, 1);
    if (wr == 1) PG8_BAR;
    PG8_WAIT_V(2); PG8_BAR;
    PG8_STAGE(PG8_SB(1, 0), cB + kstep, voffB); PG8_STAGE_A(PG8_SA(1, 0), cA + kstep, vA, 0); PG8_STAGE(PG8_SB(1, 1), cB + hstepB + kstep, voffB);
    PG8_WAIT_V(6); PG8_BAR;
    for (;;) {
        const bool has_next = S.next(ui + 1, nxt);
        const char* nA = has_next ? nxt.A : cA; const char* nB = has_next ? nxt.B : cB;
#pragma unroll 1
        for (int t = 0; t < nt; t += 2) {
            const bool last = (t == nt - 2);
            const char* a1 = cA + (size_t)(t + 1) * kstep;
            const char* a2 = last ? nA : cA + (size_t)(t + 2) * kstep; const char* b2 = last ? nB : cB + (size_t)(t + 2) * kstep;
            const char* a3 = a2 + kstep; const char* b3 = b2 + kstep;
            if (last && has_next) { PG8_AOFF(vN, nxt); }
            unsigned wX[2][2];
            if constexpr (GATHER) {
#pragma unroll
                for (int h = 0; h < 2; ++h)
#pragma unroll
                    for (int i = 0; i < 2; ++i) wX[h][i] = last ? vN[h][i] : vA[h][i]; }
            PG8_LDB(B0, 0, 0); PG8_LDB(B1, 0, 1); PG8_SCHED; PG8_LDA(At, 0, 0); PG8_STAGE_A(PG8_SA(1, 1), a1, vA, 1);
            PG8_WAIT_V(8); PG8_WAIT_L(0); PG8_BAR; PG8_MMA(0, 0, At, B0); PG8_MMA(0, 1, At, B1); PG8_BAR; PG8_SCHED;
            PG8_LDA(At, 0, 1); PG8_STAGE(PG8_SB(0, 0), b2, voffB); PG8_STAGE(PG8_SB(0, 1), b2 + hstepB, voffB); PG8_STAGE_A(PG8_SA(0, 0), a2, wX, 0);
            PG8_WAIT_V(8); PG8_WAIT_L(0); PG8_BAR; PG8_MMA(1, 0, At, B0); PG8_MMA(1, 1, At, B1); PG8_BAR; PG8_SCHED;
            PG8_LDB(B0, 1, 0); PG8_LDB(B1, 1, 1); PG8_SCHED; PG8_LDA(At, 1, 0); PG8_STAGE_A(PG8_SA(0, 1), a2, wX, 1);
            PG8_WAIT_V(8); PG8_WAIT_L(0); PG8_BAR; PG8_MMA(0, 0, At, B0); PG8_MMA(0, 1, At, B1); PG8_BAR; PG8_SCHED;
            PG8_LDA(At, 1, 1); PG8_STAGE(PG8_SB(1, 0), b3, voffB); PG8_STAGE(PG8_SB(1, 1), b3 + hstepB, voffB); PG8_STAGE_A(PG8_SA(1, 0), a3, wX, 0);
            PG8_WAIT_V(8); PG8_WAIT_L(0); PG8_BAR; PG8_MMA(1, 0, At, B0); PG8_MMA(1, 1, At, B1); PG8_BAR; PG8_SCHED;
        }
        if (wr == 0) PG8_BAR;
        E(acc, cur, wr, wc, fr, fq);
        if (!has_next) break;
#pragma unroll
        for (int a = 0; a < 2; ++a)
#pragma unroll
            for (int b = 0; b < 2; ++b)
#pragma unroll
                for (int m = 0; m < 4; ++m)
#pragma unroll
                    for (int n = 0; n < 2; ++n) acc[a][b][m][n] = (f32x4){0.f, 0.f, 0.f, 0.f};
        cur = nxt; cA = nA; cB = nB; ++ui;
#pragma unroll
        for (int h = 0; h < 2; ++h)
#pragma unroll
            for (int i = 0; i < 2; ++i) vA[h][i] = vN[h][i];
        if (wr == 1) PG8_BAR;
    }
    PG8_WAIT_V(0);
    PG8_BAR;
#undef PG8_SA
#undef PG8_SB
#undef PG8_STAGE
#undef PG8_LDA
#undef PG8_LDB
#undef PG8_MMA
#undef PG8_WAIT_V
#undef PG8_WAIT_L
#undef PG8_BAR
#undef PG8_SCHED
#undef PG8_AOFF
#undef PG8_STAGE_A
}
}

struct DenseSched {
    int nM, nN, nwg, G, c; const char* A; const char* B; size_t tstepA, tstepB;
    __device__ __forceinline__ void init(int M, int N, int K, int lda, const bf16* A_, const bf16* B_, int G_, int c_) { nM = M / 256; nN = N / 256; nwg = nM * nN; G = G_; c = c_; A = (const char*)A_; B = (const char*)B_; tstepA = (size_t)256 * lda * 2; tstepB = (size_t)256 * K * 2; }
    __device__ __forceinline__ bool next(int i, pg8::Unit& u) const {
        const long L = (long)i * G + c; if (L >= nwg) return false;
        int wgid = (int)L; { const int q = nwg / 8, r = nwg % 8, xcd = wgid % 8, off = wgid / 8; wgid = (xcd < r ? xcd * (q + 1) : r * (q + 1) + (xcd - r) * q) + off; }
        const int nig = 8 * nN, gid = wgid / nig, fm = gid * 8, gsz = (nM - fm) < 8 ? (nM - fm) : 8;
        u.pm = fm + ((wgid % nig) % gsz); u.pn = (wgid % nig) / gsz; u.aux = 0; u.slot = i;
        u.A = A + (size_t)u.pm * tstepA; u.B = B + (size_t)u.pn * tstepB; return true;
    }
    __device__ __forceinline__ int row(const pg8::Unit&, int r) const { return r; }
};
constexpr int MOE_MAXU = 8;
struct MoeSched {
    LAS const int* tab; int ub; int nunits; const char* A; const char* B; size_t strideA_tile, strideB_e, strideB_pn;
    __device__ __forceinline__ bool next(int i, pg8::Unit& u) const {
        if (i >= nunits) return false;
        const int tile = tab[ub + 4 * i], pn = tab[ub + 1 + 4 * i], e = tab[ub + 2 + 4 * i];
        u.pm = tile; u.pn = pn; u.aux = e | (tab[ub + 3 + 4 * i] << 8); u.slot = i;
        u.A = A + (size_t)tile * strideA_tile; u.B = B + (size_t)e * strideB_e + (size_t)pn * strideB_pn; return true;
    }
    __device__ __forceinline__ int row(const pg8::Unit& u, int r) const { return tab[256 + 256 * u.slot + r]; }
};

using pg8::cvt_pk_bf16;
#define EPI_ARGS const f32x4 (&acc)[2][2][4][2], const pg8::Unit& u, int wr, int wc, int fr, int fq

struct EpiProj {
    static constexpr bool PERM = true;
    bf16* P; float* rsq; float* rskv;
    __device__ __forceinline__ void operator()(EPI_ARGS) const {
        const int row0 = u.pm * 256 + wr * 64 + fr, col0 = u.pn * 256 + wc * 32 + 8 * fq;
#pragma unroll
        for (int ai = 0; ai < 2; ++ai)
#pragma unroll
            for (int m = 0; m < 4; ++m) {
                const int row = row0 + ai * 128 + m * 16; bf16* rowp = P + (size_t)row * DINP + col0;
                float ss0 = 0.f, ss1 = 0.f;
#pragma unroll
                for (int bj = 0; bj < 2; ++bj) { const f32x4 v0 = acc[ai][bj][m][0], v1 = acc[ai][bj][m][1];
                    u32x4 w; w.x = cvt_pk_bf16(v0[0], v0[1]); w.y = cvt_pk_bf16(v0[2], v0[3]); w.z = cvt_pk_bf16(v1[0], v1[1]); w.w = cvt_pk_bf16(v1[2], v1[3]);
                    *(u32x4*)(rowp + bj * 128) = w;
                    const float s = (v0[0] * v0[0] + v0[1] * v0[1]) + (v0[2] * v0[2] + v0[3] * v0[3]) + (v1[0] * v1[0] + v1[1] * v1[1]) + (v1[2] * v1[2] + v1[3] * v1[3]);
                    if (bj == 0) ss0 = s; else ss1 = s; }
                if (u.pn == 8) { float s = ss0 + ss1; s += __shfl_xor(s, 16); s += __shfl_xor(s, 32); if (fq == 0) rsq[row * 4 + wc] = s; }
                if (u.pn == 9) { float s = ss0; s += __shfl_xor(s, 16); s += __shfl_xor(s, 32); if (fq == 0) rskv[row * 4 + wc] = s; }
            }
    }
};
struct EpiUp {
    static constexpr bool PERM = true;
    bf16 *Q, *QI, *Kk, *VT; LAS const float* rst;
    __device__ __forceinline__ void operator()(EPI_ARGS) const {
        const int row0 = u.pm * 256 + wr * 64 + fr, cl = wc * 32 + 8 * fq;
#pragma unroll
        for (int ai = 0; ai < 2; ++ai)
#pragma unroll
            for (int m = 0; m < 4; ++m) {
                const int row = row0 + ai * 128 + m * 16;
                float rs = rst[256 * u.slot + wr * 64 + fr + ai * 128 + m * 16];
                if (u.pn < 2) rs *= 0.125f * LOG2E;
#pragma unroll
                for (int bj = 0; bj < 2; ++bj) { const f32x4 v0 = acc[ai][bj][m][0] * rs, v1 = acc[ai][bj][m][1] * rs; const int c = cl + bj * 128;
                    if (u.pn < 5) {
                        u32x4 w; w.x = cvt_pk_bf16(v0[0], v0[1]); w.y = cvt_pk_bf16(v0[2], v0[3]); w.z = cvt_pk_bf16(v1[0], v1[1]); w.w = cvt_pk_bf16(v1[2], v1[3]);
                        bf16* dst = u.pn < 2 ? Q + (size_t)row * 512 + u.pn * 256 + c : (u.pn == 2 ? QI + (size_t)row * 256 + c : Kk + (size_t)row * 512 + (u.pn - 3) * 256 + c);
                        *(u32x4*)dst = w;
                    } else {
                        const int vc = (u.pn - 5) * 256 + c, h = vc >> 6, d = vc & 63, b = row >> 11, t = row & 2047;
                        bf16* dst = VT + ((size_t)(b * 8 + h) * 64 + d) * SEQ + t;
#pragma unroll
                        for (int j = 0; j < 4; ++j) { dst[(size_t)j * SEQ] = (bf16)f2bf(v0[j]); dst[(size_t)(4 + j) * SEQ] = (bf16)f2bf(v1[j]); }
                    } }
            }
    }
};
struct EpiOut {
    static constexpr bool PERM = false;
    const float* x; float* pre;
    __device__ __forceinline__ void operator()(EPI_ARGS) const {
        const int row0 = u.pm * 256 + wr * 64 + fr, col0 = u.pn * 256 + wc * 32 + 4 * fq;
#pragma unroll
        for (int ai = 0; ai < 2; ++ai)
#pragma unroll
            for (int m = 0; m < 4; ++m) { const size_t off = (size_t)(row0 + ai * 128 + m * 16) * D + col0;
#pragma unroll
                for (int bj = 0; bj < 2; ++bj)
#pragma unroll
                    for (int n = 0; n < 2; ++n) { const f32x4 xv = *(const f32x4*)(x + off + bj * 128 + n * 16); *(f32x4*)(pre + off + bj * 128 + n * 16) = xv * ALPHA + acc[ai][bj][m][n]; } }
    }
};
struct EpiGU {
    static constexpr bool PERM = true;
    bf16* H;
    __device__ __forceinline__ void operator()(EPI_ARGS) const {
        const int row0 = u.pm * 256 + wr * 64 + fr, col0 = u.pn * 128 + wc * 32 + 8 * fq;
#pragma unroll
        for (int ai = 0; ai < 2; ++ai)
#pragma unroll
            for (int m = 0; m < 4; ++m) { const f32x4 g0 = acc[ai][0][m][0], g1 = acc[ai][0][m][1], u0 = acc[ai][1][m][0], u1 = acc[ai][1][m][1];
                float h[8];
#pragma unroll
                for (int j = 0; j < 4; ++j) { h[j] = siluf_(g0[j]) * u0[j]; h[4 + j] = siluf_(g1[j]) * u1[j]; }
                u32x4 w; w.x = cvt_pk_bf16(h[0], h[1]); w.y = cvt_pk_bf16(h[2], h[3]); w.z = cvt_pk_bf16(h[4], h[5]); w.w = cvt_pk_bf16(h[6], h[7]);
                *(u32x4*)(H + (size_t)(row0 + ai * 128 + m * 16) * DE + col0) = w; }
    }
};
struct EpiDown {
    static constexpr bool PERM = true;
    bf16* Alo; bf16* Ahi; bf16* Blo; bf16* Bhi; LAS const float* lwt;
    __device__ __forceinline__ void operator()(EPI_ARGS) const {
        const int lr0 = wr * 64 + fr, col0 = wc * 32 + 8 * fq;
#pragma unroll
        for (int ai = 0; ai < 2; ++ai)
#pragma unroll
            for (int m = 0; m < 4; ++m) { const int lr = lr0 + ai * 128 + m * 16;
                const float wgt = lwt[256 * u.slot + lr];
                bf16* const ylo = (bf16*)((char*)Alo + (ptrdiff_t)u.pn * ((char*)Blo - (char*)Alo)); bf16* const yhi = (bf16*)((char*)Ahi + (ptrdiff_t)u.pn * ((char*)Bhi - (char*)Ahi));
                bf16* rowp = (u.pm < 512 ? ylo + (size_t)(u.pm * 256 + lr) * 256 : yhi + (size_t)((u.pm - 512) * 256 + lr) * 256) + col0;
#pragma unroll
                for (int bj = 0; bj < 2; ++bj) { const f32x4 v0 = acc[ai][bj][m][0] * wgt, v1 = acc[ai][bj][m][1] * wgt;
                    u32x4 w; w.x = cvt_pk_bf16(v0[0], v0[1]); w.y = cvt_pk_bf16(v0[2], v0[3]); w.z = cvt_pk_bf16(v1[0], v1[1]); w.w = cvt_pk_bf16(v1[2], v1[3]);
                    *(u32x4*)(rowp + bj * 128) = w; } }
    }
};

__device__ __forceinline__ void tr_item(const float* src, int ldn, int k0, int n0, int nvalid, bf16* dst, int ldk, const float* kscale, LAS float* scr, int lane) {
    const int n4 = (lane & 7) * 4;
#pragma unroll
    for (int i = 0; i < 8; ++i) { const int kk = (lane >> 3) + 8 * i; f32x4 v = {0.f, 0.f, 0.f, 0.f};
        if (n4 < nvalid) v = *(const f32x4*)(src + (size_t)(k0 + kk) * ldn + n0 + n4);
        if (kscale) v = v * kscale[k0 + kk];
        scr[kk * 33 + n4] = v[0]; scr[kk * 33 + n4 + 1] = v[1]; scr[kk * 33 + n4 + 2] = v[2]; scr[kk * 33 + n4 + 3] = v[3]; }
    LDS_WAIT();
    const int c = lane & 7;
#pragma unroll
    for (int j = 0; j < 4; ++j) { const int n = (lane >> 3) + 8 * j; const LAS float* s = scr + (8 * c) * 33 + n;
        u32x4 o; o.x = pk2(s[0 * 33], s[1 * 33]); o.y = pk2(s[2 * 33], s[3 * 33]); o.z = pk2(s[4 * 33], s[5 * 33]); o.w = pk2(s[6 * 33], s[7 * 33]);
        *(u32x4*)(dst + (size_t)n * ldk + 8 * c) = o; }
    LDS_WAIT();
}

struct Ptrs {
    const float* in[24]; float* out; unsigned char* ws;
};

__device__ __forceinline__ void phase_prep(const Ptrs& p, LAS unsigned char* lds, int vcu, int G) {
    const int tid = threadIdx.x, lane = tid & 63, wave = tid >> 6;
    LAS float* scr = (LAS float*)(lds + wave * 16384);
    const int gw = vcu * NWAVES + wave, NGW = G * NWAVES;
    bf16* WIN = (bf16*)(p.ws + WS_WIN); bf16* WUP = (bf16*)(p.ws + WS_WUP); bf16* WOUT = (bf16*)(p.ws + WS_WOUT); bf16* XB = (bf16*)(p.ws + WS_XB);
    constexpr int I_IN = 16 * 80, I_Q = 4 * 16, I_QI = 4 * 8, I_KV = 2 * 32, I_O = 16 * 32, NIT = I_IN + I_Q + I_QI + I_KV + I_O;
    for (int it = gw; it < NIT; it += NGW) {
        int r = it;
        if (r < I_IN) { const int kb = r / 80, nb = r % 80, n0 = nb * 32; int nv = DIN - n0; nv = nv < 0 ? 0 : (nv > 32 ? 32 : nv);
            tr_item(p.in[1], DIN, kb * 64, n0, nv, WIN + (size_t)n0 * D + kb * 64, D, nullptr, scr, lane); continue; } r -= I_IN;
        if (r < I_Q) { const int kb = r / 16, nb = r % 16; tr_item(p.in[5], 512, kb * 64, nb * 32, 32, WUP + (size_t)(nb * 32) * KUP + kb * 64, KUP, p.in[4], scr, lane); continue; } r -= I_Q;
        if (r < I_QI) { const int kb = r / 8, nb = r % 8; tr_item(p.in[6], 256, kb * 64, nb * 32, 32, WUP + (size_t)(512 + nb * 32) * KUP + kb * 64, KUP, p.in[4], scr, lane); continue; } r -= I_QI;
        if (r < I_KV) { const int kb = r / 32, nb = r % 32; tr_item(p.in[8], 1024, kb * 64, nb * 32, 32, WUP + (size_t)(768 + nb * 32) * KUP + 256 + kb * 64, KUP, p.in[7], scr, lane); continue; } r -= I_KV;
        { const int kb = r / 32, nb = r % 32; tr_item(p.in[11], D, kb * 64, nb * 32, 32, WOUT + (size_t)(nb * 32) * D + kb * 64, D, nullptr, scr, lane); }
    }
    const int gt = vcu * NTHR + tid, NGT = G * NTHR;
    if (gt < 512) ((float*)(p.ws + WS_LB))[gt] = 1.0f / (1.0f + __expf(p.in[2][512 + gt] - p.in[2][gt]));
    for (int ch = gt; ch < NUP * KUP / 8; ch += NGT) { const int r = ch / (KUP / 8), c = (ch % (KUP / 8)) * 8; if (r < 768 ? c >= 256 : c < 256) *(u32x4*)(WUP + (size_t)r * KUP + c) = (u32x4){0u, 0u, 0u, 0u}; }
    const float* x = p.in[0];
    for (int ch = gt; ch < T * D / 8; ch += NGT) { const f32x4 a = *(const f32x4*)(x + (size_t)ch * 8), b = *(const f32x4*)(x + (size_t)ch * 8 + 4);
        u32x4 o; o.x = pk2(a[0], a[1]); o.y = pk2(a[2], a[3]); o.z = pk2(b[0], b[1]); o.w = pk2(b[2], b[3]); *(u32x4*)(XB + (size_t)ch * 8) = o; }
}

__device__ __forceinline__ void phase_convert_experts(const Ptrs& p, LAS unsigned char* lds, int vcu, int G) {
    const int tid = threadIdx.x, lane = tid & 63, wave = tid >> 6;
    LAS float* scr = (LAS float*)(lds + wave * 16384);
    const int gw = vcu * NWAVES + wave, NGW = G * NWAVES;
    bf16* WGU = (bf16*)(p.ws + WS_WGU); bf16* WD = (bf16*)(p.ws + WS_WD);
    for (int it = gw; it < NEX * 384; it += NGW) {
        const int e = it / 384, r = it % 384, which = r / 128, r2 = r % 128;
        if (which < 2) {
            const float* src = e < NE ? p.in[16 + which] + (size_t)e * D * DE : p.in[19 + which];
            const int kb = r2 / 8, nb = r2 % 8, n0 = nb * 32, row0 = (n0 >> 7) * 256 + (n0 & 127) + which * 128;
            tr_item(src, DE, kb * 64, n0, 32, WGU + ((size_t)e * 512 + row0) * D + kb * 64, D, nullptr, scr, lane);
        } else {
            const float* src = e < NE ? p.in[18] + (size_t)e * DE * D : p.in[21];
            const int kb = r2 / 32, nb = r2 % 32;
            tr_item(src, D, kb * 64, nb * 32, 32, WD + ((size_t)e * D + nb * 32) * DE + kb * 64, DE, nullptr, scr, lane);
        }
    }
}

__device__ __forceinline__ void phase_kidx(const Ptrs& p, int vcu, int G) {
    const int tid = threadIdx.x, lane = tid & 63, wave = tid >> 6;
    const bf16* P = (const bf16*)(p.ws + WS_P); bf16* KIDX = (bf16*)(p.ws + WS_KIDX); float* WH = (float*)(p.ws + WS_WH);
    const float g = p.in[9][lane], bb = p.in[10][lane];
    for (int tok = vcu * NWAVES + wave; tok < T; tok += G * NWAVES) {
        const float v = bf2f(P[(size_t)tok * DINP + 2432 + lane]);
        const float mean = wave_sum(v) * (1.0f / 64.0f); const float dv = v - mean;
        const float var = wave_sum(dv * dv) * (1.0f / 64.0f);
        KIDX[(size_t)tok * 64 + lane] = (bf16)f2bf(dv * __builtin_amdgcn_rsqf(var + 1e-5f) * g + bb);
        if (lane < 4) WH[tok * 4 + lane] = bf2f(P[(size_t)tok * DINP + 2496 + lane]) * 0.0625f;
    }
}

constexpr int HG_B = 0, HG_TOT = 32768, HG_VT = 34816, HG_QD = 53248, HG_KI = 70656, HG_KD = 53248, HG_PART = 88064;
constexpr int HG_QP = 136;
__device__ __forceinline__ float fast_sigmoid(float x) { return __builtin_amdgcn_rcpf(1.0f + __builtin_amdgcn_exp2f(-x * LOG2E)); }
__device__ __forceinline__ float fast_exp(float x) { return __builtin_amdgcn_exp2f(x * LOG2E); }
template <int MODE> __device__ __forceinline__ void hgrn_stage(const Ptrs& p, int item, LAS unsigned char* lds) {
    const int tid = threadIdx.x, t = tid >> 3, blk = tid & 7;
    const int c = item & 31, h = (item >> 5) & 3, b = item >> 7;
    const bf16* P = (const bf16*)(p.ws + WS_P); const float* LB = (const float*)(p.ws + WS_LB) + h * 128 + blk * 16;
    LAS float* bc = (LAS float*)(lds + HG_B); LAS float* tot = (LAS float*)(lds + HG_TOT); LAS bf16* VT = (LAS bf16*)(lds + HG_VT);
    const bf16* prow = P + ((size_t)b * SEQ + c * 64 + t) * DINP + h * 128 + blk * 16;
    float kk[16];
    const u32x4 gv0 = *(const u32x4*)(prow + 1024), gv1 = *(const u32x4*)(prow + 1024 + 8);
    u32x4 gq0 = {0u, 0u, 0u, 0u}, gq1 = {0u, 0u, 0u, 0u};
    if (MODE == 3) { gq0 = *(const u32x4*)prow; gq1 = *(const u32x4*)(prow + 8); }
    { const u32x4 a = *(const u32x4*)(prow + 512), a2 = *(const u32x4*)(prow + 512 + 8);
      const unsigned w[8] = {a.x, a.y, a.z, a.w, a2.x, a2.y, a2.z, a2.w};
#pragma unroll
      for (int j = 0; j < 16; ++j) { const float x = (j & 1) ? bfhi(w[j >> 1]) : bflo(w[j >> 1]); const float lb = LB[j], sg = fast_sigmoid(x);
          kk[j] = (1.0f - lb) * (1.0f - sg); bc[t * 128 + blk * 16 + j] = __logf(1.0f - kk[j]); } }
    __syncthreads();
    { const int d = tid & 127, part = tid >> 7; float s = 0.f;
#pragma unroll 4
      for (int i = 0; i < 16; ++i) { const int tt = part * 16 + i; s += bc[tt * 128 + d]; bc[tt * 128 + d] = s; }
      tot[part * 128 + d] = s;
      __syncthreads();
      float off = 0.f;
      for (int q = 0; q < part; ++q) off += tot[q * 128 + d];
      if (part > 0) {
#pragma unroll 4
          for (int i = 0; i < 16; ++i) bc[(part * 16 + i) * 128 + d] += off; } }
    __syncthreads();
    { const unsigned w[8] = {gv0.x, gv0.y, gv0.z, gv0.w, gv1.x, gv1.y, gv1.z, gv1.w};
#pragma unroll
      for (int j = 0; j < 8; ++j) { VT[(blk * 16 + 2 * j) * 72 + t] = (bf16)(w[j] & 0xffffu); VT[(blk * 16 + 2 * j + 1) * 72 + t] = (bf16)(w[j] >> 16); } }
    if (MODE == 1) {
        LAS bf16* KD = (LAS bf16*)(lds + HG_KD);
#pragma unroll
        for (int j = 0; j < 16; ++j) { const int d = blk * 16 + j; KD[d * 72 + t] = (bf16)f2bf(kk[j] * fast_exp(bc[63 * 128 + d] - bc[t * 128 + d])); }
        if (tid < 128) ((float*)(p.ws + WS_DEC))[item * 128 + tid] = fast_exp(bc[63 * 128 + tid]);
    } else {
        LAS bf16* QD = (LAS bf16*)(lds + HG_QD); LAS bf16* KI = (LAS bf16*)(lds + HG_KI);
        const unsigned w[8] = {gq0.x, gq0.y, gq0.z, gq0.w, gq1.x, gq1.y, gq1.z, gq1.w};
        unsigned oq[8], ok[8];
#pragma unroll
        for (int j = 0; j < 8; ++j) { const float b0 = bc[t * 128 + blk * 16 + 2 * j], b1 = bc[t * 128 + blk * 16 + 2 * j + 1]; const float x0 = bflo(w[j]), x1 = bfhi(w[j]);
            oq[j] = pk2(x0 * fast_sigmoid(x0) * fast_exp(b0), x1 * fast_sigmoid(x1) * fast_exp(b1));
            ok[j] = pk2(kk[2 * j] * fast_exp(-b0), kk[2 * j + 1] * fast_exp(-b1)); }
        *(LAS u32x4*)(QD + t * HG_QP + blk * 16) = (u32x4){oq[0], oq[1], oq[2], oq[3]}; *(LAS u32x4*)(QD + t * HG_QP + blk * 16 + 8) = (u32x4){oq[4], oq[5], oq[6], oq[7]};
        *(LAS u32x4*)(KI + t * HG_QP + blk * 16) = (u32x4){ok[0], ok[1], ok[2], ok[3]}; *(LAS u32x4*)(KI + t * HG_QP + blk * 16 + 8) = (u32x4){ok[4], ok[5], ok[6], ok[7]};
    }
    __syncthreads();
}
__device__ __forceinline__ void hgrn1_item(const Ptrs& p, int item, LAS unsigned char* lds) {
    const int tid = threadIdx.x, lane = tid & 63, w = tid >> 6;
    hgrn_stage<1>(p, item, lds);
    LAS bf16* KD = (LAS bf16*)(lds + HG_KD); LAS bf16* VT = (LAS bf16*)(lds + HG_VT);
    bf16* DS = (bf16*)(p.ws + WS_DS) + (size_t)item * 16384;
    { const int cc = lane & 15, g = lane >> 4;
      bf16x8 af[2];
#pragma unroll
      for (int ks = 0; ks < 2; ++ks) af[ks] = *(const LAS bf16x8*)(KD + (16 * w + cc) * 72 + 32 * ks + 8 * g);
#pragma unroll
      for (int vt = 0; vt < 8; ++vt) {
          f32x4 C = {0.f, 0.f, 0.f, 0.f};
#pragma unroll
          for (int ks = 0; ks < 2; ++ks) { const bf16x8 bfm = *(const LAS bf16x8*)(VT + (16 * vt + cc) * 72 + 32 * ks + 8 * g); C = __builtin_amdgcn_mfma_f32_16x16x32_bf16(af[ks], bfm, C, 0, 0, 0); }
          u32x2 o; o.x = pk2(C[0], C[1]); o.y = pk2(C[2], C[3]);
          *(u32x2*)(DS + (size_t)(16 * vt + cc) * 128 + 16 * w + 4 * g) = o; } }
    __syncthreads();
}
__device__ __forceinline__ void phase_scan(const Ptrs& p, int vcu, int G) {
    const bf16* DS = (const bf16*)(p.ws + WS_DS); bf16* SP = (bf16*)(p.ws + WS_SP); const float* DEC = (const float*)(p.ws + WS_DEC);
    for (int gt = vcu * NTHR + threadIdx.x; gt < 32 * 4096; gt += G * NTHR) {
        const int bh = gt >> 12, e4 = gt & 4095, d0 = (e4 & 31) * 4; const size_t eo = (size_t)(e4 >> 5) * 128 + d0;
        float S0 = 0.f, S1 = 0.f, S2 = 0.f, S3 = 0.f;
#pragma unroll 4
        for (int c = 0; c < 32; ++c) { const size_t item = (size_t)bh * 32 + c;
            const u32x2 ds = *(const u32x2*)(DS + item * 16384 + eo); const f32x4 dc = *(const f32x4*)(DEC + item * 128 + d0);
            u32x2 o; o.x = pk2(S0, S1); o.y = pk2(S2, S3); *(u32x2*)(SP + item * 16384 + eo) = o;
            S0 = dc[0] * S0 + bflo(ds.x); S1 = dc[1] * S1 + bfhi(ds.x); S2 = dc[2] * S2 + bflo(ds.y); S3 = dc[3] * S3 + bfhi(ds.y); }
    }
}
__device__ __forceinline__ void hgrn3_item(const Ptrs& p, int item, LAS unsigned char* lds) {
    const int tid = threadIdx.x, lane = tid & 63, w = tid >> 6, cc = lane & 15, g = lane >> 4;
    const int c = item & 31, h = (item >> 5) & 3, b = item >> 7;
    const bf16* P = (const bf16*)(p.ws + WS_P);
    const int tt = w & 3, vh = w >> 2;
    bf16x8 spf[4][4];
    { const bf16* SPi = (const bf16*)(p.ws + WS_SP) + (size_t)item * 16384;
#pragma unroll
      for (int vi = 0; vi < 4; ++vi)
#pragma unroll
          for (int ks = 0; ks < 4; ++ks) spf[vi][ks] = *(const bf16x8*)(SPi + (size_t)(16 * (4 * vh + vi) + cc) * 128 + 32 * ks + 8 * g); }
    hgrn_stage<3>(p, item, lds);
    LAS bf16* VT = (LAS bf16*)(lds + HG_VT); LAS float* part = (LAS float*)(lds + HG_PART); LAS bf16* QD = (LAS bf16*)(lds + HG_QD); LAS bf16* KI = (LAS bf16*)(lds + HG_KI);
    const size_t tok0 = (size_t)b * SEQ + c * 64;
    bf16x8 qd[4];
#pragma unroll
    for (int ks = 0; ks < 4; ++ks) qd[ks] = *(const LAS bf16x8*)(QD + (16 * tt + cc) * HG_QP + 32 * ks + 8 * g);
    u32x2 scb[4];
#pragma unroll
    for (int st = 0; st < 4; ++st) {
        scb[st] = (u32x2){0u, 0u};
        if (st <= tt) {
            f32x4 C = {0.f, 0.f, 0.f, 0.f};
#pragma unroll
            for (int ks = 0; ks < 4; ++ks) C = __builtin_amdgcn_mfma_f32_16x16x32_bf16(*(const LAS bf16x8*)(KI + (16 * st + cc) * HG_QP + 32 * ks + 8 * g), qd[ks], C, 0, 0, 0);
#pragma unroll
            for (int i = 0; i < 4; ++i) if (16 * st + 4 * g + i > 16 * tt + cc) C[i] = 0.f;
            scb[st] = (u32x2){pk2(C[0], C[1]), pk2(C[2], C[3])};
        }
    }
    f32x4 o[4]; float ss = 0.f;
#pragma unroll
    for (int vi = 0; vi < 4; ++vi) { const int vt = 4 * vh + vi; f32x4 C = {0.f, 0.f, 0.f, 0.f};
#pragma unroll
        for (int ks = 0; ks < 4; ++ks) C = __builtin_amdgcn_mfma_f32_16x16x32_bf16(spf[vi][ks], qd[ks], C, 0, 0, 0);
#pragma unroll
        for (int kp = 0; kp < 2; ++kp) if (2 * kp <= tt) {
            const u32x2 v0 = *(const LAS u32x2*)(VT + (16 * vt + cc) * 72 + 32 * kp + 4 * g), v1 = *(const LAS u32x2*)(VT + (16 * vt + cc) * 72 + 32 * kp + 16 + 4 * g);
            C = __builtin_amdgcn_mfma_f32_16x16x32_bf16(__builtin_bit_cast(bf16x8, (u32x4){v0.x, v0.y, v1.x, v1.y}), __builtin_bit_cast(bf16x8, (u32x4){scb[2 * kp].x, scb[2 * kp].y, scb[2 * kp + 1].x, scb[2 * kp + 1].y}), C, 0, 0, 0); }
        o[vi] = C; ss += (C[0] * C[0] + C[1] * C[1]) + (C[2] * C[2] + C[3] * C[3]); }
    ss += __shfl_xor(ss, 16); ss += __shfl_xor(ss, 32);
    if (g == 0) part[vh * 64 + 16 * tt + cc] = ss;
    __syncthreads();
    const float rstd = __builtin_amdgcn_rsqf((part[16 * tt + cc] + part[64 + 16 * tt + cc]) * (1.0f / 128.0f) + 1e-6f);
    bf16* OC = (bf16*)(p.ws + WS_XB);
    { const size_t tok = tok0 + 16 * tt + cc;
#pragma unroll
      for (int vi = 0; vi < 4; ++vi) { const int v0 = 16 * (4 * vh + vi) + 4 * g;
          const u32x2 gt = *(const u32x2*)(P + tok * DINP + 1536 + h * 128 + v0); const f32x4 ng = *(const f32x4*)(p.in[3] + v0);
          u32x2 ov; ov.x = pk2(o[vi][0] * rstd * ng[0] * siluf_(bflo(gt.x)), o[vi][1] * rstd * ng[1] * siluf_(bfhi(gt.x)));
          ov.y = pk2(o[vi][2] * rstd * ng[2] * siluf_(bflo(gt.y)), o[vi][3] * rstd * ng[3] * siluf_(bfhi(gt.y)));
          *(u32x2*)(OC + tok * D + h * 128 + v0) = ov; } }
    __syncthreads();
}

constexpr int IX_P = 2052;
__device__ __forceinline__ void cnt_ge_u32(int& cnt, unsigned a, unsigned b) { unsigned long long t; asm("v_cmp_ge_u32_e64 %1, %2, %3\n\tv_addc_co_u32_e64 %0, %1, 0, %0, %1" : "+v"(cnt), "=&s"(t) : "v"(a), "v"(b)); }
__device__ __forceinline__ void cnt_le_u32(int& cnt, unsigned a, unsigned b) { unsigned long long t; asm("v_cmp_le_u32_e64 %1, %2, %3\n\tv_addc_co_u32_e64 %0, %1, 0, %0, %1" : "+v"(cnt), "=&s"(t) : "v"(a), "v"(b)); }
__device__ __forceinline__ void cnt_gt_u64(int& cnt, unsigned long long a, unsigned long long b) { asm("v_cmp_gt_u64 vcc, %1, %2\n\tv_addc_co_u32 %0, vcc, 0, %0, vcc" : "+v"(cnt) : "v"(a), "v"(b) : "vcc"); }
__device__ __forceinline__ unsigned ord_u32(float f) { unsigned b = __builtin_bit_cast(unsigned, f); if (b == 0x80000000u) b = 0u; return (b & 0x80000000u) ? ~b : (b | 0x80000000u); }
__device__ __forceinline__ int bcnt_ge(unsigned a, unsigned sb) { int r; asm("v_cmp_le_u32 vcc, %2, %1\n\ts_bcnt1_i32_b64 %0, vcc" : "=s"(r) : "v"(a), "s"(sb) : "vcc", "scc"); return r; }
__device__ __forceinline__ int bcnt_le(unsigned a, unsigned sb) { int r; asm("v_cmp_ge_u32 vcc, %2, %1\n\ts_bcnt1_i32_b64 %0, vcc" : "=s"(r) : "v"(a), "s"(sb) : "vcc", "scc"); return r; }
__device__ __forceinline__ int wave_sum_dpp(int v) {
    v += __builtin_amdgcn_update_dpp(0, v, 0x111, 0xF, 0xF, false);
    v += __builtin_amdgcn_update_dpp(0, v, 0x112, 0xF, 0xF, false);
    v += __builtin_amdgcn_update_dpp(0, v, 0x114, 0xF, 0xF, false);
    v += __builtin_amdgcn_update_dpp(0, v, 0x118, 0xF, 0xF, false);
    v += __builtin_amdgcn_update_dpp(0, v, 0x142, 0xA, 0xF, false);
    v += __builtin_amdgcn_update_dpp(0, v, 0x143, 0xC, 0xF, false);
    return __builtin_amdgcn_readlane(v, 63);
}
template <int NR> __device__ __forceinline__ void topk_row(const LAS unsigned* srow, int nreg, int lane, LAS unsigned* mrow  ) {
    unsigned u[NR];
#pragma unroll
    for (int j = 0; j < NR; ++j) u[j] = srow[64 * j + lane];
    unsigned Tt = 0u;
#pragma unroll 1
    for (int bit = 31; bit >= 0; --bit) {
        const unsigned cand = (unsigned)__builtin_amdgcn_readfirstlane((int)(Tt | (1u << bit))); int c4[4] = {0, 0, 0, 0};
#pragma unroll
        for (int j = 0; j < NR; ++j) cnt_ge_u32(c4[j & 3], u[j], cand);
        const int cnt = wave_sum_dpp((c4[0] + c4[1]) + (c4[2] + c4[3]));
        if (cnt >= 256) Tt = cand;
        if (cnt == 256) break;
    }
    int cge = 0;
#pragma unroll
    for (int j = 0; j < NR; ++j) { const unsigned uu = u[j]; cge += (uu >= Tt) ? 1 : 0;
        u[j] = uu > Tt ? 0u : (uu == Tt ? (unsigned)(1 + 64 * j + lane) : 4096u); }
    const int cgt = 0, ceq = wave_sum_dpp(cge);
    unsigned X = 2048u;
    if (cgt + ceq > 256) {
        unsigned Xb = 0u;
#pragma unroll 1
        for (int bit = 11; bit >= 0; --bit) {
            const unsigned cand = (unsigned)__builtin_amdgcn_readfirstlane((int)(Xb | (1u << bit))); int c4[4] = {0, 0, 0, 0};
#pragma unroll
            for (int j = 0; j < NR; ++j) cnt_le_u32(c4[j & 3], u[j], cand);
            const int cnt = wave_sum_dpp((c4[0] + c4[1]) + (c4[2] + c4[3]));
            if (cnt <= 256) Xb = cand;
        }
        X = Xb;
    }
    unsigned myword = 0u;
#pragma unroll
    for (int j = 0; j < NR; ++j) { const unsigned long long bal = __ballot(u[j] <= X); if ((lane >> 1) == j) myword = (lane & 1) ? (unsigned)(bal >> 32) : (unsigned)bal; }
    if (lane < 2 * nreg) mrow[16 * lane] = myword;
}
__device__ __forceinline__ void indexer_item(const Ptrs& p, int item, LAS unsigned char* lds) {
    const int tid = threadIdx.x, lane = tid & 63, w = __builtin_amdgcn_readfirstlane(tid >> 6), q = lane & 15, g = lane >> 4;
    const int b = item >> 7, qg = item & 127, c = qg >> 2, nw = 2 * (c + 1);
    unsigned* MASKT = (unsigned*)(p.ws + WS_MASK) + (size_t)b * 64 * SEQ;
    if (c < 4) { for (int idx = tid; idx < nw * 16; idx += NTHR) MASKT[(size_t)(idx >> 4) * SEQ + qg * 16 + (idx & 15)] = 0xFFFFFFFFu; return; }
    const bf16* QI = (const bf16*)(p.ws + WS_QI); const bf16* KIDX = (const bf16*)(p.ws + WS_KIDX); const float* WH = (const float*)(p.ws + WS_WH);
    LAS unsigned* S = (LAS unsigned*)lds;
    {
        const size_t tokq = (size_t)b * SEQ + qg * 16 + q;
        bf16x8 qf[4][2]; float wq[4];
#pragma unroll
        for (int h = 0; h < 4; ++h) { wq[h] = WH[tokq * 4 + h];
#pragma unroll
            for (int ks = 0; ks < 2; ++ks) qf[h][ks] = *(const bf16x8*)(QI + tokq * 256 + h * 64 + 32 * ks + 8 * g); }
        const int ntile = 4 * (c + 1);
#pragma unroll 4
        for (int j = w; j < ntile; j += 8) {
            const bf16* kp = KIDX + ((size_t)b * SEQ + 16 * j + q) * 64 + 8 * g;
            const bf16x8 k0 = *(const bf16x8*)kp, k1 = *(const bf16x8*)(kp + 32);
            float sc[4] = {0.f, 0.f, 0.f, 0.f};
#pragma unroll
            for (int h = 0; h < 4; ++h) { f32x4 C = {0.f, 0.f, 0.f, 0.f};
                C = __builtin_amdgcn_mfma_f32_16x16x32_bf16(k0, qf[h][0], C, 0, 0, 0); C = __builtin_amdgcn_mfma_f32_16x16x32_bf16(k1, qf[h][1], C, 0, 0, 0);
#pragma unroll
                for (int i = 0; i < 4; ++i) sc[i] += wq[h] * fmaxf(C[i], 0.f); }
            *(LAS u32x4*)(S + q * IX_P + 16 * j + 4 * g) = (u32x4){ord_u32(sc[0]), ord_u32(sc[1]), ord_u32(sc[2]), ord_u32(sc[3])};
        }
    }
    {
        const int nend = ((c + 8) & ~7) * 64, n0 = 64 * (c + 1);
        for (int idx = tid; idx < 16 * ((nend - n0) >> 2); idx += NTHR) { const int per = (nend - n0) >> 2, r = idx / per, k4 = idx % per; *(LAS u32x4*)(S + r * IX_P + n0 + 4 * k4) = (u32x4){0u, 0u, 0u, 0u}; }
    }
    __syncthreads();
    {
        const int nreg = c + 1;
#pragma unroll 1
        for (int rr = 0; rr < 2; ++rr) { const int row = 2 * w + rr; const LAS unsigned* srow = S + row * IX_P; LAS unsigned* mrow = S + 16 * IX_P + row;
            if (nreg <= 8) topk_row<8>(srow, nreg, lane, mrow); else if (nreg <= 16) topk_row<16>(srow, nreg, lane, mrow);
            else if (nreg <= 24) topk_row<24>(srow, nreg, lane, mrow); else topk_row<32>(srow, nreg, lane, mrow); }
    }
    __syncthreads();
    for (int idx = tid; idx < nw * 16; idx += NTHR) MASKT[(size_t)(idx >> 4) * SEQ + qg * 16 + (idx & 15)] = S[16 * IX_P + idx];
    __syncthreads();
}

__device__ __forceinline__ int crow(int r, int hi) { return (r & 3) + 8 * (r >> 2) + 4 * hi; }
constexpr int AT_KP = 144, AT_VP = 136, AT_KB = 64 * AT_KP, AT_VB = 64 * AT_VP, AT_STAGE = AT_KB + AT_VB;
struct AtRegs { u32x4 k, v; unsigned m0, m1; };
__device__ __forceinline__ void attn_unit(const Ptrs& p, int b, int h, int QB, LAS unsigned char* lds) {
    const int tid = threadIdx.x, lane = tid & 63, w = __builtin_amdgcn_readfirstlane(tid >> 6), q = lane & 31, hh = lane >> 5;
    const int tq = 256 * QB + 32 * w + q, NT = 4 * QB + 4, ntw = 4 * QB + (w >> 1) + 1;
    const size_t tok = (size_t)b * SEQ + tq;
    const bf16* Q = (const bf16*)(p.ws + WS_Q); const bf16* Kb = (const bf16*)(p.ws + WS_K) + (size_t)b * SEQ * 512 + h * 64;
    const bf16* VTb = (const bf16*)(p.ws + WS_VT) + (size_t)(b * 8 + h) * 64 * SEQ; const unsigned* MASKT = (const unsigned*)(p.ws + WS_MASK) + (size_t)b * 64 * SEQ + tq;
    const float slope2 = __builtin_amdgcn_exp2f(-(float)(h + 1)) * LOG2E;
    bf16x8 qf[4];
#pragma unroll
    for (int ks = 0; ks < 4; ++ks) qf[ks] = *(const bf16x8*)(Q + tok * 512 + h * 64 + 16 * ks + 8 * hh);
    const int srow = tid >> 3, sch = tid & 7;
    const bf16* kg = Kb + (size_t)srow * 512 + sch * 8; const bf16* vg = VTb + (size_t)srow * SEQ + sch * 8;
    const int kso = srow * AT_KP + sch * 16, vso = AT_KB + srow * AT_VP + sch * 16;
#define AT_LOAD(R, i_) do { if ((i_) < NT) { const int t_ = NT - 1 - (i_); (R).k = *(const u32x4*)(kg + (size_t)t_ * 64 * 512); (R).v = *(const u32x4*)(vg + t_ * 64); \
        if (t_ < ntw) { (R).m0 = MASKT[(size_t)(2 * t_) * SEQ]; (R).m1 = MASKT[(size_t)(2 * t_ + 1) * SEQ]; } } } while (0)
#define AT_WRITE(R, so) do { *(LAS u32x4*)(lds + (so) + kso) = (R).k; *(LAS u32x2*)(lds + (so) + vso) = (u32x2){(R).v.x, (R).v.y}; *(LAS u32x2*)(lds + (so) + vso + 8) = (u32x2){(R).v.z, (R).v.w}; } while (0)
    f32x16 o0 = {}, o1 = {}; float m = -INFINITY, l = 0.f;
#define AT_COMPUTE(kt, so, w0, w1) do { if ((kt) < ntw) { \
        LAS const unsigned char* sb = lds + (so); \
        f32x16 S0, S1; \
        if (64 * (kt) + 63 < 256 * QB + 32 * w) {        \
            const float lb0 = -slope2 * (float)(tq - 64 * (kt) - 4 * hh); \
            _Pragma("unroll") for (int r = 0; r < 16; ++r) { S0[r] = lb0 + slope2 * (float)((r & 3) + 8 * (r >> 2)); S1[r] = S0[r] + 32.0f * slope2; } \
        } else { \
            _Pragma("unroll") for (int r = 0; r < 16; ++r) { const int key = 64 * (kt) + crow(r, hh); const int d0 = tq > key ? tq - key : key - tq; const int key1 = key + 32; const int d1 = tq > key1 ? tq - key1 : key1 - tq; \
                S0[r] = -slope2 * (float)d0; S1[r] = -slope2 * (float)d1; } \
        } \
        _Pragma("unroll") for (int ks = 0; ks < 4; ++ks) { \
            const bf16x8 k0 = *(LAS const bf16x8*)(sb + q * AT_KP + 32 * ks + 16 * hh), k1 = *(LAS const bf16x8*)(sb + (32 + q) * AT_KP + 32 * ks + 16 * hh); \
            S0 = __builtin_amdgcn_mfma_f32_32x32x16_bf16(k0, qf[ks], S0, 0, 0, 0); S1 = __builtin_amdgcn_mfma_f32_32x32x16_bf16(k1, qf[ks], S1, 0, 0, 0); } \
          \
        float rm = fmaxf(S0[0], S1[0]); \
        _Pragma("unroll") for (int r = 1; r < 16; ++r) rm = fmaxf(fmaxf(rm, S0[r]), S1[r]); \
        rm = fmaxf(rm, __shfl_xor(rm, 32)); \
        if (__any(rm > m)) { const float mn = fmaxf(m, rm), alpha = __builtin_amdgcn_exp2f(m - mn); l *= alpha; m = mn; \
            _Pragma("unroll") for (int r = 0; r < 16; ++r) { o0[r] *= alpha; o1[r] *= alpha; } } \
        float ls = 0.f; \
        _Pragma("unroll") for (int r = 0; r < 16; ++r) { const int cr = crow(r, hh); \
            const unsigned e0 = __builtin_bit_cast(unsigned, __builtin_amdgcn_exp2f(S0[r] - m)) & (unsigned)__builtin_amdgcn_sbfe((int)(w0), cr, 1); \
            const unsigned e1 = __builtin_bit_cast(unsigned, __builtin_amdgcn_exp2f(S1[r] - m)) & (unsigned)__builtin_amdgcn_sbfe((int)(w1), cr, 1); \
            S0[r] = __builtin_bit_cast(float, e0); S1[r] = __builtin_bit_cast(float, e1); ls += S0[r] + S1[r]; } \
        l += ls; \
        LAS const unsigned char* vb = sb + AT_KB; \
        _Pragma("unroll") for (int s2 = 0; s2 < 4; ++s2) { \
            const bf16x8 pa = (s2 < 2) \
                ? __builtin_bit_cast(bf16x8, (u32x4){cvt_pk_bf16(S0[8 * (s2 & 1)], S0[8 * (s2 & 1) + 1]), cvt_pk_bf16(S0[8 * (s2 & 1) + 2], S0[8 * (s2 & 1) + 3]), cvt_pk_bf16(S0[8 * (s2 & 1) + 4], S0[8 * (s2 & 1) + 5]), cvt_pk_bf16(S0[8 * (s2 & 1) + 6], S0[8 * (s2 & 1) + 7])}) \
                : __builtin_bit_cast(bf16x8, (u32x4){cvt_pk_bf16(S1[8 * (s2 & 1)], S1[8 * (s2 & 1) + 1]), cvt_pk_bf16(S1[8 * (s2 & 1) + 2], S1[8 * (s2 & 1) + 3]), cvt_pk_bf16(S1[8 * (s2 & 1) + 4], S1[8 * (s2 & 1) + 5]), cvt_pk_bf16(S1[8 * (s2 & 1) + 6], S1[8 * (s2 & 1) + 7])}); \
            const u32x2 a0 = *(LAS const u32x2*)(vb + q * AT_VP + 32 * s2 + 8 * hh), a1 = *(LAS const u32x2*)(vb + q * AT_VP + 32 * s2 + 8 * hh + 16); \
            const u32x2 c0 = *(LAS const u32x2*)(vb + (32 + q) * AT_VP + 32 * s2 + 8 * hh), c1 = *(LAS const u32x2*)(vb + (32 + q) * AT_VP + 32 * s2 + 8 * hh + 16); \
            o0 = __builtin_amdgcn_mfma_f32_32x32x16_bf16(__builtin_bit_cast(bf16x8, (u32x4){a0.x, a0.y, a1.x, a1.y}), pa, o0, 0, 0, 0); \
            o1 = __builtin_amdgcn_mfma_f32_32x32x16_bf16(__builtin_bit_cast(bf16x8, (u32x4){c0.x, c0.y, c1.x, c1.y}), pa, o1, 0, 0, 0); } } } while (0)
    AtRegs R0, R1; R0.m0 = R0.m1 = R1.m0 = R1.m1 = 0u; R0.k = R0.v = R1.k = R1.v = (u32x4){0u, 0u, 0u, 0u};
    AT_LOAD(R0, 0); AT_LOAD(R1, 1);
    unsigned cm0 = R0.m0, cm1 = R0.m1;
    AT_WRITE(R0, 0);
    AT_LOAD(R0, 2);
    __syncthreads();
    int s_cur = 0, s_nxt = AT_STAGE, s_nn = 2 * AT_STAGE;
    for (int kt = 0; kt < NT; kt += 2) {
        AT_COMPUTE(NT - 1 - kt, s_cur, cm0, cm1);
        cm0 = R1.m0; cm1 = R1.m1;
        AT_WRITE(R1, s_nxt);
        AT_LOAD(R1, kt + 3);
        __syncthreads();
        AT_COMPUTE(NT - 2 - kt, s_nxt, cm0, cm1);
        cm0 = R0.m0; cm1 = R0.m1;
        if (kt + 2 < NT) AT_WRITE(R0, s_nn);
        AT_LOAD(R0, kt + 4);
        __syncthreads();
        { const int t0 = s_cur; s_cur = s_nn; s_nn = s_nxt; s_nxt = t0; }
    }
#undef AT_LOAD
#undef AT_WRITE
#undef AT_COMPUTE
    l += __shfl_xor(l, 32);
    const float inv = l > 0.f ? 1.0f / l : 0.f;
    bf16* OC = (bf16*)(p.ws + WS_XB) + tok * D + 512 + h * 64;
#pragma unroll
    for (int r4 = 0; r4 < 4; ++r4) {
        u32x2 a; a.x = pk2(o0[4 * r4] * inv, o0[4 * r4 + 1] * inv); a.y = pk2(o0[4 * r4 + 2] * inv, o0[4 * r4 + 3] * inv); *(u32x2*)(OC + 8 * r4 + 4 * hh) = a;
        u32x2 c; c.x = pk2(o1[4 * r4] * inv, o1[4 * r4 + 1] * inv); c.y = pk2(o1[4 * r4 + 2] * inv, o1[4 * r4 + 3] * inv); *(u32x2*)(OC + 32 + 8 * r4 + 4 * hh) = c; }
}

constexpr int R6_HP = 1028;
constexpr int R6_HBUF = 0, R6_PART = 16 * R6_HP * 4, R6_LCNT = R6_PART + 8 * 16 * 64 * 4, R6_GBASE = R6_LCNT + 256, R6_ENT = R6_GBASE + 256;
__device__ __forceinline__ void phase_ln1_router(const Ptrs& p, LAS unsigned char* lds, int vcu, int G) {
    const int tid = threadIdx.x, lane = tid & 63, wave = __builtin_amdgcn_readfirstlane(tid >> 6);
    LAS float* hbuf = (LAS float*)(lds + R6_HBUF); LAS float* part = (LAS float*)(lds + R6_PART);
    LAS int* lcnt = (LAS int*)(lds + R6_LCNT); LAS int* gbase = (LAS int*)(lds + R6_GBASE); LAS int* ent = (LAS int*)(lds + R6_ENT);
    const float* pre = (const float*)(p.ws + WS_HB); bf16* H1B = (bf16*)(p.ws + WS_XB);
    const float* g1 = p.in[12]; const float* b1 = p.in[13]; const float* Wr = p.in[14]; const float rbias = p.in[15][lane];
    unsigned* cnt = (unsigned*)(p.ws + WS_CTL) + CW_CNT; int* LTOK = (int*)(p.ws + WS_LTOK); float* LW = (float*)(p.ws + WS_LW); unsigned* ROUTE = (unsigned*)(p.ws + WS_ROUTE);
    for (int tile = vcu; tile < T / 64; tile += G) {
        if (tid < 64) lcnt[tid] = 0;
        for (int sub = 0; sub < 4; ++sub) {
            const int tok0 = tile * 64 + sub * 16;
#pragma unroll
            for (int j2 = 0; j2 < 2; ++j2) { const int tl = 2 * wave + j2; const size_t tok = tok0 + tl;
                f32x4 v[4]; float s = 0.f;
#pragma unroll
                for (int jj = 0; jj < 4; ++jj) { v[jj] = *(const f32x4*)(pre + tok * D + 4 * lane + 256 * jj); s += (v[jj][0] + v[jj][1]) + (v[jj][2] + v[jj][3]); }
                const float mean = wave_sum(s) * (1.0f / D); float s2 = 0.f;
#pragma unroll
                for (int jj = 0; jj < 4; ++jj) { v[jj] = v[jj] - mean; s2 += (v[jj][0] * v[jj][0] + v[jj][1] * v[jj][1]) + (v[jj][2] * v[jj][2] + v[jj][3] * v[jj][3]); }
                const float rstd = 1.0f / sqrtf(wave_sum(s2) * (1.0f / D) + 1e-5f);
#pragma unroll
                for (int jj = 0; jj < 4; ++jj) { const int c0 = 4 * lane + 256 * jj; const f32x4 gg = *(const f32x4*)(g1 + c0), bb = *(const f32x4*)(b1 + c0);
                    const f32x4 hv = v[jj] * rstd * gg + bb;
                    u32x2 o; o.x = pk2(hv[0], hv[1]); o.y = pk2(hv[2], hv[3]); *(u32x2*)(H1B + tok * D + c0) = o;
                    *(LAS f32x4*)(hbuf + tl * R6_HP + c0) = hv; } }
            __syncthreads();
            { f32x4 acc[4];
#pragma unroll
              for (int nt = 0; nt < 4; ++nt) acc[nt] = (f32x4){0.f, 0.f, 0.f, 0.f};
              const LAS float* ap = hbuf + (lane & 15) * R6_HP + 128 * wave + (lane >> 4); const float* bp = Wr + (size_t)(128 * wave + (lane >> 4)) * 64 + (lane & 15);
#pragma unroll 8
              for (int ks = 0; ks < 32; ++ks) { const float a = ap[4 * ks];
#pragma unroll
                  for (int nt = 0; nt < 4; ++nt) acc[nt] = __builtin_amdgcn_mfma_f32_16x16x4f32(a, bp[(size_t)ks * 256 + 16 * nt], acc[nt], 0, 0, 0); }
#pragma unroll
              for (int nt = 0; nt < 4; ++nt)
#pragma unroll
                  for (int r = 0; r < 4; ++r) part[(wave * 16 + (lane >> 4) * 4 + r) * 64 + 16 * nt + (lane & 15)] = acc[nt][r]; }
            __syncthreads();
#pragma unroll 1
            for (int j2 = 0; j2 < 2; ++j2) { const int tl = 2 * wave + j2; float logit = 0.f;
#pragma unroll
                for (int ww = 0; ww < 8; ++ww) logit += part[(ww * 16 + tl) * 64 + lane];
                const float score = sigmoidf_(logit); const float sel = score + rbias;
                float m1 = sel; m1 = fmaxf(m1, __shfl_xor(m1, 1)); m1 = fmaxf(m1, __shfl_xor(m1, 2)); m1 = fmaxf(m1, __shfl_xor(m1, 4));
                const unsigned long long bm = __ballot(sel == m1) & (0xFFull << (lane & 56));
                const int first = __ffsll((long long)bm) - 1;
                float m2 = (lane == first) ? -INFINITY : sel; m2 = fmaxf(m2, __shfl_xor(m2, 1)); m2 = fmaxf(m2, __shfl_xor(m2, 2)); m2 = fmaxf(m2, __shfl_xor(m2, 4));
                const float gs = m1 + m2; const int grpi = lane >> 3; int grank = 0;
#pragma unroll
                for (int j = 0; j < 8; ++j) { const float gj = __shfl(gs, j * 8); grank += (gj > gs || (gj == gs && j < grpi)) ? 1 : 0; }
                const float selm = grank < 4 ? sel : -INFINITY; int rank = 0;
                const unsigned long long mykey = ((unsigned long long)ord_u32(selm) << 8) | (unsigned)(63 - lane);
#pragma unroll
                for (int j = 0; j < 64; ++j) { const unsigned long long kj = ((unsigned long long)(unsigned)__shfl((int)(mykey >> 8), j) << 8) | (unsigned)(63 - j); cnt_gt_u64(rank, kj, mykey); }
                const bool chosen = rank < TOPK;
                const float wsum = wave_sum(chosen ? score : 0.f); const float wgt = score / wsum * 2.5f;
                const unsigned long long cm = __ballot(chosen); const int k = __popcll(cm & ((1ull << lane) - 1ull));
                if (chosen) { const int lpos = __hip_atomic_fetch_add(lcnt + lane, 1, __ATOMIC_RELAXED, __HIP_MEMORY_SCOPE_WORKGROUP);
                    LAS int* en = ent + ((sub * 16 + tl) * 8 + k) * 3; en[0] = lane; en[1] = lpos; en[2] = __builtin_bit_cast(int, wgt); } }
            __syncthreads();
        }
        if (tid < 64) gbase[tid] = (int)atomicAdd(cnt + 64 * tid, (unsigned)lcnt[tid]);
        __syncthreads();
        { const int tl = tid >> 3, k = tid & 7; const LAS int* en = ent + (tl * 8 + k) * 3; const int e = en[0], pos = gbase[e] + en[1], tok = tile * 64 + tl;
          LTOK[(size_t)e * T + pos] = tok; LW[(size_t)e * T + pos] = __builtin_bit_cast(float, en[2]); ROUTE[(size_t)tok * 8 + k] = ((unsigned)e << 16) | (unsigned)pos; }
        __syncthreads();
    }
}

__device__ __forceinline__ void moe_tables(const Ptrs& p, LAS int* tab, int v, int G) {
    const int tid = threadIdx.x;
    const unsigned* cnt = (const unsigned*)(p.ws + WS_CTL) + CW_CNT; const int* LTOK = (const int*)(p.ws + WS_LTOK);
    if (tid < 64) tab[66 + tid] = ((int)__hip_atomic_load(cnt + 64 * tid, __ATOMIC_RELAXED, __HIP_MEMORY_SCOPE_AGENT) + 255) >> 8;
    __syncthreads();
    if (tid == 0) { int s = 0; for (int e = 0; e < NE; ++e) { const int n = tab[66 + e]; tab[e] = s; s += n; } tab[NE] = s; tab[NE + 1] = s + T / 256; }
    __syncthreads();
    const int ntile = tab[NE + 1];
    int nu2 = 0, nu1 = 0;
    for (int i = 0; i < MOE_MAXU; ++i) { if ((long)i * G + v < 2 * ntile) nu2 = i + 1; if ((long)i * G + v < ntile) nu1 = i + 1; }
    if (tid < 16) { const int which = tid >> 3, i = tid & 7, nN = which ? 1 : 2, nu = which ? nu1 : nu2;
        if (i < nu) { const int L = i * G + v, tile = L / nN, pn = L % nN; int e = 0; while (tab[e + 1] <= tile) ++e;
            LAS int* u = tab + (which ? 192 : 128) + 4 * i; u[0] = tile; u[1] = pn; u[2] = e; u[3] = tile - tab[e]; } }
    if (tid == 0) { tab[126] = nu2; tab[127] = nu1; }
    __syncthreads();
    for (int idx = tid; idx < nu2 * 256; idx += NTHR) { const int i = idx >> 8, r = idx & 255, e = tab[130 + 4 * i], mt = tab[131 + 4 * i], pos = mt * 256 + r;
        tab[256 + idx] = e < NE ? (pos < (int)__hip_atomic_load(cnt + 64 * e, __ATOMIC_RELAXED, __HIP_MEMORY_SCOPE_AGENT) ? LTOK[(size_t)e * T + pos] : 0) : pos; }
    { const float* LW = (const float*)(p.ws + WS_LW);
      for (int idx = tid; idx < nu2 * 256; idx += NTHR) { const int i = idx >> 8, r = idx & 255, e = tab[130 + 4 * i], mt = tab[131 + 4 * i];
          ((LAS float*)tab)[1536 + idx] = e < NE ? LW[(size_t)e * T + mt * 256 + r] : 1.0f; } }
    __syncthreads();
}

__device__ __forceinline__ const bf16* yrow(const bf16* ylo, const bf16* yhi, size_t row) { return row < (size_t)YSPLIT ? ylo + row * 256 : yhi + (row - YSPLIT) * 256; }
__device__ __forceinline__ f32x4 combine_token(const Ptrs& p, LAS int* tab, int j, const bf16* ylo, const bf16* yhi, int tok, int lane) {
    const bf16* H1B = (const bf16*)(p.ws + WS_XB); const unsigned* ROUTE = (const unsigned*)(p.ws + WS_ROUTE);
    const u32x2 hv = *(const u32x2*)(H1B + (size_t)tok * D + 256 * j + 4 * lane);
    f32x4 a = {ALPHA * bflo(hv.x), ALPHA * bfhi(hv.x), ALPHA * bflo(hv.y), ALPHA * bfhi(hv.y)};
    { const u32x2 y = *(const u32x2*)(yrow(ylo, yhi, (size_t)tab[NE] * 256 + tok) + 4 * lane); a[0] += bflo(y.x); a[1] += bfhi(y.x); a[2] += bflo(y.y); a[3] += bfhi(y.y); }
#pragma unroll
    for (int k = 0; k < TOPK; ++k) { const unsigned r = ROUTE[(size_t)tok * 8 + k]; const size_t row = (size_t)tab[r >> 16] * 256 + (r & 0xffffu);
        const u32x2 y = *(const u32x2*)(yrow(ylo, yhi, row) + 4 * lane); a[0] += bflo(y.x); a[1] += bfhi(y.x); a[2] += bflo(y.y); a[3] += bfhi(y.y); }
    return a;
}
__device__ __forceinline__ void phase_combine2(const Ptrs& p, LAS int* tab, int j, const bf16* alo, const bf16* ahi, const bf16* blo, const bf16* bhi, int vcu, int G) {
    const int tid = threadIdx.x, lane = tid & 63, wave = tid >> 6;
    bf16* H1B = (bf16*)(p.ws + WS_XB);
    for (int tok = vcu * NWAVES + wave; tok < T; tok += G * NWAVES) {
        const f32x4 a = combine_token(p, tab, j, alo, ahi, tok, lane), c = combine_token(p, tab, j + 1, blo, bhi, tok, lane);
        u32x2 o; o.x = cvt_pk_bf16(a[0], a[1]); o.y = cvt_pk_bf16(a[2], a[3]); *(u32x2*)(H1B + (size_t)tok * D + 256 * j + 4 * lane) = o;
        u32x2 q; q.x = cvt_pk_bf16(c[0], c[1]); q.y = cvt_pk_bf16(c[2], c[3]); *(u32x2*)(H1B + (size_t)tok * D + 256 * (j + 1) + 4 * lane) = q;
    }
}
__device__ __forceinline__ void phase_ln2(const Ptrs& p, int vcu, int G) {
    const int tid = threadIdx.x, lane = tid & 63, wave = tid >> 6;
    const bf16* H1B = (const bf16*)(p.ws + WS_XB);
    const float* g2 = p.in[22]; const float* b2 = p.in[23];
    for (int tok = vcu * NWAVES + wave; tok < T; tok += G * NWAVES) {
        float* rowp = p.out + (size_t)tok * D;
        f32x4 v[4]; float s = 0.f;
#pragma unroll
        for (int jj = 0; jj < 4; ++jj) { const u32x2 pv = *(const u32x2*)(H1B + (size_t)tok * D + 256 * jj + 4 * lane); v[jj] = (f32x4){bflo(pv.x), bfhi(pv.x), bflo(pv.y), bfhi(pv.y)}; s += (v[jj][0] + v[jj][1]) + (v[jj][2] + v[jj][3]); }
        const float mean = wave_sum(s) * (1.0f / D); float s2 = 0.f;
#pragma unroll
        for (int jj = 0; jj < 4; ++jj) { v[jj] = v[jj] - mean; s2 += (v[jj][0] * v[jj][0] + v[jj][1] * v[jj][1]) + (v[jj][2] * v[jj][2] + v[jj][3] * v[jj][3]); }
        const float rstd = 1.0f / sqrtf(wave_sum(s2) * (1.0f / D) + 1e-5f);
#pragma unroll
        for (int jj = 0; jj < 4; ++jj) { const int c0 = 4 * lane + 256 * jj; *(f32x4*)(rowp + c0) = v[jj] * rstd * *(const f32x4*)(g2 + c0) + *(const f32x4*)(b2 + c0); }
    }
}
#define XB_TMO      128
#define XB_XCNT(j)  (256  + 64 * (j))
#define XB_XSUB(j)  (1280 + 64 * (j))
#define XB_XGEN(j)  (2304 + 64 * (j))
#define XB_TOP      3328
#define XB_TOPGEN   3392
#define XCD_BAR_WORDS 3456
#define XB_SPIN_CAP (1u << 18)
__device__ __forceinline__ unsigned xb_ld(unsigned* p)              { return __hip_atomic_load(p, __ATOMIC_RELAXED, __HIP_MEMORY_SCOPE_AGENT); }
__device__ __forceinline__ unsigned xb_add(unsigned* p, unsigned v) { return __hip_atomic_fetch_add(p, v, __ATOMIC_RELAXED, __HIP_MEMORY_SCOPE_AGENT); }
__device__ __forceinline__ unsigned xb_xcc_id() { return (unsigned)__builtin_amdgcn_s_getreg((3 << 11) | 20) & 0xFu; }
#define XB_SPIN(cond, bar) do { unsigned _sp = 0; while (cond) { __builtin_amdgcn_s_sleep(1); \
    if ((++_sp & 255u) == 0u) { if (xb_ld(&(bar)[XB_TMO])) break; if (_sp > XB_SPIN_CAP) { atomicAdd(&(bar)[XB_TMO], 1u); break; } } } } while (0)
struct XcdBarrier { unsigned* bar; unsigned x; volatile LAS unsigned* st; };
__device__ __forceinline__ XcdBarrier xcd_barrier_post(unsigned* bar, volatile LAS unsigned* st) {
    XcdBarrier b; b.bar = bar; b.x = xb_xcc_id(); b.st = st;
    if (threadIdx.x == 0) (void)xb_add(&bar[XB_XCNT(b.x)], 1u);
    return b;
}
__device__ __forceinline__ void xcd_barrier_complete(unsigned* bar, unsigned x, unsigned& nloc, unsigned& nx) {
    const unsigned G = gridDim.x * gridDim.y * gridDim.z;
    unsigned sum, cnt, mine, sp = 0u;
    for (;;) {
        sum = 0u; cnt = 0u; mine = 0u;
#pragma unroll
        for (unsigned j = 0; j < 16; ++j) { const unsigned c = xb_ld(&bar[XB_XCNT(j)]); sum += c; cnt += (c > 0u) ? 1u : 0u; mine = (j == x) ? c : mine; }
        if (sum == G) break;
        __builtin_amdgcn_s_sleep(1);
        if ((++sp & 255u) == 0u) { if (xb_ld(&bar[XB_TMO])) break; if (sp > XB_SPIN_CAP) { atomicAdd(&bar[XB_TMO], 1u); break; } }
    }
    nloc = mine > 0u ? mine : 1u; nx = cnt > 0u ? cnt : 1u;
}
__device__ __forceinline__ void xcd_barrier(const XcdBarrier& b) {
    asm volatile("s_waitcnt vmcnt(0)" ::: "memory");
    __syncthreads();
    if (threadIdx.x == 0) {
        unsigned* bar = b.bar;
        __builtin_amdgcn_s_waitcnt(0);
        unsigned nloc = b.st[0], nx = b.st[1];
        if (nloc == 0u) { xcd_barrier_complete(bar, b.x, nloc, nx); b.st[0] = nloc; b.st[1] = nx; }
        const unsigned old = xb_add(&bar[XB_XSUB(b.x)], 1u);
        const unsigned gen = old / nloc;
        if (old + 1u == (gen + 1u) * nloc) {
            __builtin_amdgcn_fence(__ATOMIC_RELEASE, "agent");
            asm volatile("s_waitcnt vmcnt(0)" ::: "memory");
            const unsigned og = xb_add(&bar[XB_TOP], 1u);
            const unsigned tg = og / nx;
            if (og + 1u == (tg + 1u) * nx) xb_add(&bar[XB_TOPGEN], 1u);
            else XB_SPIN(xb_ld(&bar[XB_TOPGEN]) == tg, bar);
            __builtin_amdgcn_fence(__ATOMIC_ACQUIRE, "agent");
            xb_add(&bar[XB_XGEN(b.x)], 1u);
            asm volatile("s_waitcnt vmcnt(0)" ::: "memory");
        } else {
            XB_SPIN(xb_ld(&bar[XB_XGEN(b.x)]) == gen, bar);
            __builtin_amdgcn_fence(__ATOMIC_ACQUIRE, "agent");
            asm volatile("s_waitcnt vmcnt(0)" ::: "memory");
        }
    }
    __syncthreads();
}

__device__ __forceinline__ void probe_between(const XcdBarrier& bar, int k, unsigned* cnt) {
    xcd_barrier(bar);
    if (k == 6) { if (blockIdx.x == 0 && threadIdx.x < 64) cnt[threadIdx.x] = 0u; xcd_barrier(bar); }
}
__device__ __forceinline__ const Ptrs* kargs() { auto k = __builtin_amdgcn_kernarg_segment_ptr(); asm volatile("" : "+s"(k)); return (const Ptrs*)k; }
constexpr int NPH = 13;
struct Args { Ptrs p; int ph_lo, ph_hi; };
__global__ void __launch_bounds__(NTHR, 2) mk_fwd(Args args) {
    extern __shared__ __attribute__((aligned(16))) unsigned char lds_raw[];
    LAS unsigned char* lds = (LAS unsigned char*)lds_raw;
    volatile LAS unsigned* MISC = (volatile LAS unsigned*)(lds + MISC_OFF);
    LAS int* tab = (LAS int*)(lds + TAB_OFF);
    const int tid = threadIdx.x, lane = tid & 63, wave = __builtin_amdgcn_readfirstlane(tid >> 6);
    const int G = gridDim.x, bx = blockIdx.x, vcu = (G % 8 == 0) ? (bx % 8) * (G / 8) + bx / 8 : bx;
    if (tid < 32) MISC[tid] = 0u;
    __syncthreads();
    XcdBarrier bar; bar.bar = (unsigned*)(kargs()->ws + WS_CTL) + CW_BAR; bar.x = 0; bar.st = nullptr;
    if (MK_N_LAUNCHES == 1) bar = xcd_barrier_post((unsigned*)(kargs()->ws + WS_CTL) + CW_BAR, MISC + 8);
    const int lo = args.ph_lo, hi = args.ph_hi;
#ifndef PHMASK
#define PHMASK 0x1FFFF
#endif
#define IN(k) (((PHMASK >> (k)) & 1) && lo <= (k) && (k) < hi)
#define SEAM(k) do { if (IN(k) && IN((k) + 1)) xcd_barrier(bar); } while (0)
#ifndef PROBE_REP
#define PROBE_REP 0
#endif
#define REPEAT(k) for (int rep_ = 0; rep_ <= ((PROBE_REP >> (k)) & 1); ++rep_, ((PROBE_REP >> (k)) & 1) ? probe_between(bar, (k), (unsigned*)(kargs()->ws + WS_CTL) + CW_CNT) : (void)0)

    if (IN(0)) REPEAT(0) { const Ptrs& p = *kargs(); unsigned char* const ws = p.ws; (void)ws; phase_prep(p, lds, vcu, G); } SEAM(0);

    if (IN(1)) REPEAT(1) { const Ptrs& p = *kargs(); unsigned char* const ws = p.ws; (void)ws;
        DenseSched S; S.init(T, DINP, D, D, (const bf16*)(ws + WS_XB), (const bf16*)(ws + WS_WIN), G, bx);
        EpiProj E{(bf16*)(ws + WS_P), (float*)(ws + WS_RSQ), (float*)(ws + WS_RSKV)};
        pg8::gemm_phase<EpiProj, DenseSched, false>(lds, D, D, S, E);
    } SEAM(1);

    if (IN(2)) REPEAT(2) { const Ptrs& p = *kargs(); unsigned char* const ws = p.ws; (void)ws;
        DenseSched S; S.init(T, NUP, KUP, DINP, (const bf16*)(ws + WS_P) + 2048, (const bf16*)(ws + WS_WUP), G, bx);
        { pg8::Unit uu;
          for (int i = 0; S.next(i, uu); ++i) { const bool isq = uu.pn < 3;
              if (tid < 256) { const f32x4 pr = *(const f32x4*)((const float*)(ws + (isq ? WS_RSQ : WS_RSKV)) + (size_t)(uu.pm * 256 + tid) * 4);
                  ((LAS float*)tab)[256 * i + tid] = __builtin_amdgcn_rsqf(((pr[0] + pr[1]) + (pr[2] + pr[3])) * (isq ? (1.0f / 256.0f) : (1.0f / 128.0f)) + 1e-6f); } }
          __syncthreads(); }
        EpiUp E{(bf16*)(ws + WS_Q), (bf16*)(ws + WS_QI), (bf16*)(ws + WS_K), (bf16*)(ws + WS_VT), (LAS const float*)tab};
        pg8::gemm_phase<EpiUp, DenseSched, false>(lds, KUP, DINP, S, E);
        phase_kidx(p, vcu, G);
        for (int item = vcu; item < 1024; item += G) hgrn1_item(p, item, lds);
    } SEAM(2);

    if (IN(3)) REPEAT(3) { const Ptrs& p = *kargs(); unsigned char* const ws = p.ws; (void)ws;
        for (int L = vcu; L < 1024; L += G) { const int i = L >> 8, idx = L & 255, b = idx >> 5, j = idx & 31;
            const int qg = (i == 0) ? j : (i == 1) ? 63 - j : (i == 2) ? 64 + j : 127 - j;
            indexer_item(p, b * 128 + qg, lds); }
        phase_scan(p, vcu, G);
    } SEAM(3);

    if (IN(4)) REPEAT(4) { const Ptrs& p = *kargs(); unsigned char* const ws = p.ws; (void)ws;
        for (int pr = vcu; pr < 256; pr += G) { const int b = pr >> 5, h = (pr >> 2) & 7, j = pr & 3;
            attn_unit(p, b, h, 7 - j, lds); attn_unit(p, b, h, j, lds); }
        for (int item = vcu; item < 1024; item += G) hgrn3_item(p, item, lds);
    } SEAM(4);

    if (IN(5)) REPEAT(5) { const Ptrs& p = *kargs(); unsigned char* const ws = p.ws; (void)ws;
        DenseSched S; S.init(T, D, D, D, (const bf16*)(ws + WS_XB), (const bf16*)(ws + WS_WOUT), G, bx);
        EpiOut E{p.in[0], (float*)(ws + WS_HB)};
        pg8::gemm_phase<EpiOut, DenseSched, false>(lds, D, D, S, E);
        phase_convert_experts(p, lds, vcu, G);
    } SEAM(5);

    if (IN(6)) REPEAT(6) { const Ptrs& p = *kargs(); unsigned char* const ws = p.ws; (void)ws; phase_ln1_router(p, lds, vcu, G); } SEAM(6);

    bool tab_ready = false;
#define MOE_TAB() do { if (!tab_ready) { moe_tables(p, tab, vcu, G); tab_ready = true; } } while (0)
    if (IN(7)) REPEAT(7) { const Ptrs& p = *kargs(); unsigned char* const ws = p.ws; (void)ws;
        MOE_TAB();
        MoeSched S{tab, 128, tab[126], (const char*)(ws + WS_XB), (const char*)(ws + WS_WGU), (size_t)0, (size_t)512 * D * 2, (size_t)256 * D * 2};
        EpiGU E{(bf16*)(ws + WS_HB)};
        pg8::gemm_phase<EpiGU, MoeSched, true>(lds, D, D, S, E);
    } SEAM(7);

#define YA_LO ((bf16*)p.out)
#define YA_HI ((bf16*)(ws + WS_YT))
#define YB_LO ((bf16*)(ws + WS_Y))
#define YB_HI ((bf16*)(ws + WS_Y) + (size_t)YSPLIT * 256)
#define DOWN_GEMM2(jj) do { \
        MoeSched S{tab, 128, tab[126], (const char*)(ws + WS_HB), (const char*)(ws + WS_WD) + (size_t)(2 * (jj)) * 256 * DE * 2, (size_t)256 * DE * 2, (size_t)D * DE * 2, (size_t)256 * DE * 2}; \
        EpiDown E{YA_LO, YA_HI, YB_LO, YB_HI, (LAS const float*)(tab + 1536)}; \
        pg8::gemm_phase<EpiDown, MoeSched, false>(lds, DE, DE, S, E); } while (0)
    if (IN(8)) { const Ptrs& p = *kargs(); unsigned char* const ws = p.ws; MOE_TAB(); DOWN_GEMM2(0); } SEAM(8);
    if (IN(9)) { const Ptrs& p = *kargs(); unsigned char* const ws = p.ws; MOE_TAB(); phase_combine2(p, tab, 0, YA_LO, YA_HI, YB_LO, YB_HI, vcu, G); } SEAM(9);
    if (IN(10)) { const Ptrs& p = *kargs(); unsigned char* const ws = p.ws; MOE_TAB(); DOWN_GEMM2(1); } SEAM(10);
    if (IN(11)) { const Ptrs& p = *kargs(); unsigned char* const ws = p.ws; MOE_TAB(); phase_combine2(p, tab, 2, YA_LO, YA_HI, YB_LO, YB_HI, vcu, G); } SEAM(11);
    if (IN(12)) { const Ptrs& p = *kargs(); phase_ln2(p, vcu, G); }
#undef IN
#undef SEAM
}

extern "C" void kernel_launch(void* const* d_in, const int* in_sizes, int n_in, void* d_out, int out_size, void* d_ws, size_t ws_size, hipStream_t stream) {
    static int grid = 0;
    if (grid == 0) {
        if (n_in != 24 || out_size != T * D || ws_size < WS_END) { fprintf(stderr, "kernel_launch: unexpected problem (n_in %d, out %d, ws %zu)\n", n_in, out_size, ws_size); grid = -1; return; }
        int dev = 0, cus = 0, per_cu = 0;
        if (hipGetDevice(&dev) != hipSuccess || hipDeviceGetAttribute(&cus, hipDeviceAttributeMultiprocessorCount, dev) != hipSuccess) { grid = -1; return; }
        if (hipFuncSetAttribute((const void*)mk_fwd, hipFuncAttributeMaxDynamicSharedMemorySize, LDS_BYTES) != hipSuccess) { fprintf(stderr, "kernel_launch: hipFuncSetAttribute failed\n"); grid = -1; return; }
        if (hipOccupancyMaxActiveBlocksPerMultiprocessor(&per_cu, (const void*)mk_fwd, NTHR, LDS_BYTES) != hipSuccess || per_cu < 1) { fprintf(stderr, "kernel_launch: occupancy query says %d blocks per CU\n", per_cu); }
        (void)hipGetLastError();
        grid = cus;
    }
    if (grid < 0) return;
    (void)hipMemsetAsync((char*)d_ws + WS_CTL, 0, CTL_ZERO_BYTES, stream);
    Args a{};
    for (int i = 0; i < 24; ++i) a.p.in[i] = (const float*)d_in[i];
    a.p.out = (float*)d_out; a.p.ws = (unsigned char*)d_ws;
    if (MK_N_LAUNCHES == 1) { a.ph_lo = 0; a.ph_hi = NPH; hipLaunchKernelGGL(mk_fwd, dim3(grid), dim3(NTHR), LDS_BYTES, stream, a); }
    else for (int ph = 0; ph < NPH; ++ph) { a.ph_lo = ph; a.ph_hi = ph + 1; hipLaunchKernelGGL(mk_fwd, dim3(grid), dim3(NTHR), LDS_BYTES, stream, a); }
}
```

```cpp
#include <hip/hip_runtime.h>
#include <cstdint>
#include <cstdio>

#define LAS __attribute__((address_space(3)))
#define GAS __attribute__((address_space(1)))
typedef unsigned short bf16;
typedef short bf16x8 __attribute__((ext_vector_type(8)));
typedef short s16x4 __attribute__((ext_vector_type(4)));
typedef float f32x2 __attribute__((ext_vector_type(2)));
typedef float f32x4 __attribute__((ext_vector_type(4)));
typedef float f32x16 __attribute__((ext_vector_type(16)));
typedef unsigned u32x2 __attribute__((ext_vector_type(2)));
typedef unsigned u32x4 __attribute__((ext_vector_type(4)));
typedef GAS unsigned gu32;
#define RLX_AGENT __ATOMIC_RELAXED, __HIP_MEMORY_SCOPE_AGENT

#ifndef PROBE_SEC
#define SEC_B(id)
#define SEC_E(id)
#else
__device__ unsigned long long g_sec_acc;
#define SEC_B(id) do { if ((id) == PROBE_SEC && blockIdx.x == 0 && threadIdx.x == 0) g_sec_acc -= __builtin_amdgcn_s_memrealtime(); } while (0)
#define SEC_E(id) do { if ((id) == PROBE_SEC && blockIdx.x == 0 && threadIdx.x == 0) g_sec_acc += __builtin_amdgcn_s_memrealtime(); } while (0)
#endif
#ifndef MK_N_LAUNCHES
#define MK_N_LAUNCHES 1
#endif

constexpr int NB = 8, SEQ = 2048, T = NB * SEQ, D = 1024, DIN = 2500, DINP = 2560;
constexpr int NE = 64, NEX = 65  , DE = 256, TOPK = 8;
constexpr int KUP = 256, NUP = 1792;
constexpr float ALPHA = 1.18920711500272f;
constexpr float LOG2E = 1.4426950408889634f;
constexpr int HROWS = 147456 + T;
constexpr int NWAVES = 8, NTHR = 512;

constexpr size_t MiB = 1u << 20;
constexpr size_t WS_CTL = 0, CTL_ZERO_BYTES = 1 * MiB;
constexpr size_t WS_RSQ = 1 * MiB, WS_RSKV = WS_RSQ + 256 * 1024, WS_WH = WS_RSKV + 256 * 1024, WS_DEC = WS_WH + 256 * 1024;
constexpr size_t WS_LB = 2 * MiB + 256 * 1024;
constexpr size_t WS_ROUTE = 2 * MiB + 512 * 1024;
constexpr size_t WS_WUP = 4 * MiB, WS_WOUT = 6 * MiB, WS_MASK = 8 * MiB, WS_KIDX = 12 * MiB, WS_LTOK = 14 * MiB, WS_LW = 18 * MiB;
constexpr size_t WS_XB = 24 * MiB;
constexpr size_t WS_WIN = 56 * MiB, WS_P = 61 * MiB, WS_Q = 141 * MiB, WS_QI = 157 * MiB, WS_K = 165 * MiB, WS_VT = 181 * MiB, WS_DS = 197 * MiB, WS_SP = WS_DS;
constexpr size_t WS_WD = 232 * MiB, WS_WGU = 56 * MiB, WS_Y = 56 * MiB, WS_YT = 136 * MiB, WS_HB = 152 * MiB, WS_END = 265 * MiB;
constexpr int YSPLIT = 131072;
constexpr int CW_Q = 16384;
constexpr int CW_TMO = 0, CW_BAR = 4096, CW_CNT = 8192;

constexpr int RING_BYTES = 131072;
constexpr int TAB_OFF = RING_BYTES;
constexpr int MISC_OFF = RING_BYTES + 12288;
constexpr int LDS_BYTES = 147456;

__device__ __forceinline__ unsigned f2bf(float f) { unsigned u = __builtin_bit_cast(unsigned, f); return (u + 0x7fffu + ((u >> 16) & 1u)) >> 16; }
__device__ __forceinline__ unsigned pk2(float lo, float hi) { return f2bf(lo) | (f2bf(hi) << 16); }
__device__ __forceinline__ float bf2f(unsigned h) { return __builtin_bit_cast(float, h << 16); }
__device__ __forceinline__ float bflo(unsigned w) { return __builtin_bit_cast(float, w << 16); }
__device__ __forceinline__ float bfhi(unsigned w) { return __builtin_bit_cast(float, w & 0xffff0000u); }
__device__ __forceinline__ float sigmoidf_(float x) { return 1.0f / (1.0f + __expf(-x)); }
__device__ __forceinline__ float siluf_(float x) { return x / (1.0f + __expf(-x)); }
__device__ __forceinline__ float wave_sum(float v) {
#define WS_STEP(ctrl, rmask) v += __builtin_bit_cast(float, __builtin_amdgcn_update_dpp(0, __builtin_bit_cast(int, v), ctrl, rmask, 0xF, false))
    WS_STEP(0x111, 0xF); WS_STEP(0x112, 0xF); WS_STEP(0x114, 0xF); WS_STEP(0x118, 0xF); WS_STEP(0x142, 0xA); WS_STEP(0x143, 0xC);
#undef WS_STEP
    return __builtin_bit_cast(float, __builtin_amdgcn_readlane(__builtin_bit_cast(int, v), 63));
}
#define LDS_WAIT() asm volatile("s_waitcnt lgkmcnt(0)" ::: "memory")
#define VM_WAIT() asm volatile("s_waitcnt vmcnt(0)" ::: "memory")

namespace pg8 {
constexpr int BM = 256, BK = 64, HALF = 128, HTB = HALF * BK * 2, STAGE_BYTES = 8 * HTB;
__host__ __device__ __forceinline__ int lds_byte(int r, int c) { const int st = (r >> 4) * 2 + (c >> 5), rr = r & 15, cc = c & 31, ob = rr * 64 + cc * 2; return st * 1024 + (ob ^ (((ob >> 9) & 1) << 5)); }
__host__ __device__ __forceinline__ void stage_rc(int b, int& R, int& C) { const int st = b / 1024, sb = b % 1024, swz = sb ^ (((sb >> 9) & 1) << 5); R = (st >> 1) * 16 + swz / 64; C = (st & 1) * 32 + (swz % 64) / 2; }
__host__ __device__ __forceinline__ int perm32(int rho) { const int n = rho >> 4, i = rho & 15; return 8 * (i >> 2) + 4 * n + (i & 3); }

struct Unit { int pm, pn, aux, slot; const char* A; const char* B; };

__device__ __forceinline__ unsigned cvt_pk_bf16(float lo, float hi) { unsigned r; asm volatile("v_cvt_pk_bf16_f32 %0, %1, %2" : "=v"(r) : "v"(lo), "v"(hi)); return r; }

template <class Epi, class Sched, bool GATHER>
__device__ __forceinline__ void gemm_phase(LAS unsigned char* lds, const int K, const int lda, const Sched& S, const Epi& E) {
    const int tid = threadIdx.x, wid = __builtin_amdgcn_readfirstlane(tid >> 6), lane = tid & 63, wr = wid >> 2, wc = wid & 3, fr = lane & 15, fq = lane >> 4;
    const int nt = K / BK;
    int sR[2], sC[2];
    unsigned voffB[2];
#pragma unroll
    for (int i = 0; i < 2; ++i) { stage_rc(tid * 16 + i * 8192, sR[i], sC[i]); const int Rb = Epi::PERM ? ((sR[i] & ~31) + perm32(sR[i] & 31)) : sR[i]; voffB[i] = (unsigned)(Rb * K + sC[i]) * 2u; }
    const size_t kstep = (size_t)(BK * 2);
    const size_t hstepB = (size_t)HALF * K * 2, hstepA = (size_t)HALF * lda * 2;
    unsigned voffA[2];
#pragma unroll
    for (int i = 0; i < 2; ++i) voffA[i] = (unsigned)(sR[i] * lda + sC[i]) * 2u;
    const unsigned ldsw = (unsigned)wid * 1024u;
    const int aoff = lds_byte(wr * 64 + fr, fq * 8), boff = lds_byte(wc * 32 + fr, fq * 8);
#define PG8_SA(b, h) (((b) * 2 + (h)) * HTB)
#define PG8_SB(b, h) ((4 + (b) * 2 + (h)) * HTB)
#define PG8_STAGE(bufoff, gbase, voff) do { _Pragma("unroll") for (int _i = 0; _i < 2; ++_i) \
        __builtin_amdgcn_global_load_lds((const unsigned*)((const char*)(gbase) + (voff)[_i]), (LAS unsigned*)(lds + (bufoff) + ldsw + _i * 8192), 16, 0, 0); } while (0)
#define PG8_LDA(dst, b, h) do { _Pragma("unroll") for (int m = 0; m < 4; ++m) _Pragma("unroll") for (int k = 0; k < 2; ++k) dst[m][k] = *(const LAS bf16x8*)(lds + PG8_SA(b, h) + aoff + m * 2048 + k * 1024); } while (0)
#define PG8_LDB(dst, b, h) do { _Pragma("unroll") for (int n = 0; n < 2; ++n) _Pragma("unroll") for (int k = 0; k < 2; ++k) dst[n][k] = *(const LAS bf16x8*)(lds + PG8_SB(b, h) + boff + n * 2048 + k * 1024); } while (0)
#define PG8_MMA(ai, bj, At, Bt) do { __builtin_amdgcn_s_setprio(1); _Pragma("unroll") for (int m = 0; m < 4; ++m) _Pragma("unroll") for (int n = 0; n < 2; ++n) _Pragma("unroll") for (int k = 0; k < 2; ++k) \
        acc[ai][bj][m][n] = __builtin_amdgcn_mfma_f32_16x16x32_bf16(Bt[n][k], At[m][k], acc[ai][bj][m][n], 0, 0, 0); __builtin_amdgcn_s_setprio(0); } while (0)
#define PG8_WAIT_V(n) asm volatile("s_waitcnt vmcnt(" #n ")" ::: "memory")
#define PG8_WAIT_L(n) asm volatile("s_waitcnt lgkmcnt(" #n ")" ::: "memory")
#define PG8_BAR __builtin_amdgcn_s_barrier()
#define PG8_SCHED __builtin_amdgcn_sched_barrier(0)
#define PG8_AOFF(dst, u) do { if constexpr (GATHER) { _Pragma("unroll") for (int _h = 0; _h < 2; ++_h) _Pragma("unroll") for (int _i = 0; _i < 2; ++_i) { \
        const int _src = S.row((u), _h * HALF + sR[_i]); dst[_h][_i] = (unsigned)(_src * lda + sC[_i]) * 2u; } } } while (0)
#define PG8_STAGE_A(bufoff, gbase, v, h) do { if constexpr (GATHER) { PG8_STAGE(bufoff, gbase, (v)[h]); } else { PG8_STAGE(bufoff, (gbase) + (h) * hstepA, voffA); } } while (0)
    Unit cur, nxt; int ui = 0;
    if (!S.next(0, cur)) return;
    f32x4 acc[2][2][4][2];
#pragma unroll
    for (int a = 0; a < 2; ++a)
#pragma unroll
        for (int b = 0; b < 2; ++b)
#pragma unroll
            for (int m = 0; m < 4; ++m)
#pragma unroll
                for (int n = 0; n < 2; ++n) acc[a][b][m][n] = (f32x4){0.f, 0.f, 0.f, 0.f};
    bf16x8 At[4][2], B0[2][2], B1[2][2];
    unsigned vA[2][2], vN[2][2];
    PG8_AOFF(vA, cur);
#pragma unroll
    for (int h = 0; h < 2; ++h)
#pragma unroll
        for (int i = 0; i < 2; ++i) vN[h][i] = vA[h][i];
    const char* cA = cur.A; const char* cB = cur.B;
    PG8_STAGE(PG8_SB(0, 0), cB, voffB); PG8_STAGE(PG8_SB(0, 1), cB + hstepB, voffB); PG8_STAGE_A(PG8_SA(0, 0), cA, vA, 0); PG8_STAGE_A(PG8_SA(0, 1), cA, vA, 1);
    if (wr == 1) PG8_BAR;
    PG8_WAIT_V(2); PG8_BAR;
    PG8_STAGE(PG8_SB(1, 0), cB + kstep, voffB); PG8_STAGE_A(PG8_SA(1, 0), cA + kstep, vA, 0); PG8_STAGE(PG8_SB(1, 1), cB + hstepB + kstep, voffB);
    PG8_WAIT_V(6); PG8_BAR;
    for (;;) {
        const bool has_next = S.next(ui + 1, nxt);
        const char* nA = has_next ? nxt.A : cA; const char* nB = has_next ? nxt.B : cB;
#pragma unroll 1
        for (int t = 0; t < nt; t += 2) {
            const bool last = (t == nt - 2);
            const char* a1 = cA + (size_t)(t + 1) * kstep;
            const char* a2 = last ? nA : cA + (size_t)(t + 2) * kstep; const char* b2 = last ? nB : cB + (size_t)(t + 2) * kstep;
            const char* a3 = a2 + kstep; const char* b3 = b2 + kstep;
            if (last && has_next) { PG8_AOFF(vN, nxt); }
            unsigned wX[2][2];
            if constexpr (GATHER) {
#pragma unroll
                for (int h = 0; h < 2; ++h)
#pragma unroll
                    for (int i = 0; i < 2; ++i) wX[h][i] = last ? vN[h][i] : vA[h][i]; }
            PG8_LDB(B0, 0, 0); PG8_LDB(B1, 0, 1); PG8_SCHED; PG8_LDA(At, 0, 0); PG8_STAGE_A(PG8_SA(1, 1), a1, vA, 1);
            PG8_WAIT_V(8); PG8_WAIT_L(0); PG8_BAR; PG8_MMA(0, 0, At, B0); PG8_MMA(0, 1, At, B1); PG8_BAR; PG8_SCHED;
            PG8_LDA(At, 0, 1); PG8_STAGE(PG8_SB(0, 0), b2, voffB); PG8_STAGE(PG8_SB(0, 1), b2 + hstepB, voffB); PG8_STAGE_A(PG8_SA(0, 0), a2, wX, 0);
            PG8_WAIT_V(8); PG8_WAIT_L(0); PG8_BAR; PG8_MMA(1, 0, At, B0); PG8_MMA(1, 1, At, B1); PG8_BAR; PG8_SCHED;
            PG8_LDB(B0, 1, 0); PG8_LDB(B1, 1, 1); PG8_SCHED; PG8_LDA(At, 1, 0); PG8_STAGE_A(PG8_SA(0, 1), a2, wX, 1);
            PG8_WAIT_V(8); PG8_WAIT_L(0); PG8_BAR; PG8_MMA(0, 0, At, B0); PG8_MMA(0, 1, At, B1); PG8_BAR; PG8_SCHED;
            PG8_LDA(At, 1, 1); PG8_STAGE(PG8_SB(1, 0), b3, voffB); PG8_STAGE(PG8_SB(1, 1), b3 + hstepB, voffB); PG8_STAGE_A(PG8_SA(1, 0), a3, wX, 0);
            PG8_WAIT_V(8); PG8_WAIT_L(0); PG8_BAR; PG8_MMA(1, 0, At, B0); PG8_MMA(1, 1, At, B1); PG8_BAR; PG8_SCHED;
        }
        if (wr == 0) PG8_BAR;
        E(acc, cur, wr, wc, fr, fq);
        if (!has_next) break;
#pragma unroll
        for (int a = 0; a < 2; ++a)
#pragma unroll
            for (int b = 0; b < 2; ++b)
#pragma unroll
                for (int m = 0; m < 4; ++m)
#pragma unroll
                    for (int n = 0; n < 2; ++n) acc[a][b][m][n] = (f32x4){0.f, 0.f, 0.f, 0.f};
        cur = nxt; cA = nA; cB = nB; ++ui;
#pragma unroll
        for (int h = 0; h < 2; ++h)
#pragma unroll
            for (int i = 0; i < 2; ++i) vA[h][i] = vN[h][i];
        if (wr == 1) PG8_BAR;
    }
    PG8_WAIT_V(0);
    PG8_BAR;
#undef PG8_SA
#undef PG8_SB
#undef PG8_STAGE
#undef PG8_LDA
#undef PG8_LDB
#undef PG8_MMA
#undef PG8_WAIT_V
#undef PG8_WAIT_L
#undef PG8_BAR
#undef PG8_SCHED
#undef PG8_AOFF
#undef PG8_STAGE_A
}
}

struct DenseSched {
    int nM, nN, nwg, G, c; const char* A; const char* B; size_t tstepA, tstepB; int asplit = 1 << 30; size_t ashift = 0;
    __device__ __forceinline__ void init(int M, int N, int K, int lda, const bf16* A_, const bf16* B_, int G_, int c_) { nM = M / 256; nN = N / 256; nwg = nM * nN; G = G_; c = c_; A = (const char*)A_; B = (const char*)B_; tstepA = (size_t)256 * lda * 2; tstepB = (size_t)256 * K * 2; }
    __device__ __forceinline__ bool next(int i, pg8::Unit& u) const {
        const long L = (long)i * G + c; if (L >= nwg) return false;
        int wgid = (int)L; { const int q = nwg / 8, r = nwg % 8, xcd = wgid % 8, off = wgid / 8; wgid = (xcd < r ? xcd * (q + 1) : r * (q + 1) + (xcd - r) * q) + off; }
        const int nig = 8 * nN, gid = wgid / nig, fm = gid * 8, gsz = (nM - fm) < 8 ? (nM - fm) : 8;
        u.pm = fm + ((wgid % nig) % gsz); u.pn = (wgid % nig) / gsz; u.aux = 0; u.slot = i;
        u.A = A + (size_t)u.pm * tstepA + (u.pn >= asplit ? ashift : (size_t)0); u.B = B + (size_t)u.pn * tstepB; return true;
    }
    __device__ __forceinline__ int row(const pg8::Unit&, int r) const { return r; }
};
constexpr int MOE_MAXU = 8;
struct MoeSched {
    LAS const int* tab; int ub; int nunits; const char* A; const char* B; size_t strideA_tile, strideB_e, strideB_pn;
    __device__ __forceinline__ bool next(int i, pg8::Unit& u) const {
        if (i >= nunits) return false;
        const int tile = tab[ub + 4 * i], pn = tab[ub + 1 + 4 * i], e = tab[ub + 2 + 4 * i];
        u.pm = tile; u.pn = pn; u.aux = e | (tab[ub + 3 + 4 * i] << 8); u.slot = i;
        u.A = A + (size_t)tile * strideA_tile; u.B = B + (size_t)e * strideB_e + (size_t)pn * strideB_pn; return true;
    }
    __device__ __forceinline__ int row(const pg8::Unit& u, int r) const { return tab[256 + 256 * u.slot + r]; }
};

using pg8::cvt_pk_bf16;
#define EPI_ARGS const f32x4 (&acc)[2][2][4][2], const pg8::Unit& u, int wr, int wc, int fr, int fq

struct EpiProj {
    static constexpr bool PERM = true;
    bf16* P; float* rsq; float* rskv;
    __device__ __forceinline__ void operator()(EPI_ARGS) const {
        const int row0 = u.pm * 256 + wr * 64 + fr, col0 = u.pn * 256 + wc * 32 + 8 * fq;
#pragma unroll
        for (int ai = 0; ai < 2; ++ai)
#pragma unroll
            for (int m = 0; m < 4; ++m) {
                const int row = row0 + ai * 128 + m * 16; bf16* rowp = P + (size_t)row * DINP + col0;
                float ss0 = 0.f, ss1 = 0.f;
#pragma unroll
                for (int bj = 0; bj < 2; ++bj) { const f32x4 v0 = acc[ai][bj][m][0], v1 = acc[ai][bj][m][1];
                    u32x4 w; w.x = cvt_pk_bf16(v0[0], v0[1]); w.y = cvt_pk_bf16(v0[2], v0[3]); w.z = cvt_pk_bf16(v1[0], v1[1]); w.w = cvt_pk_bf16(v1[2], v1[3]);
                    *(u32x4*)(rowp + bj * 128) = w;
                    const float s = (v0[0] * v0[0] + v0[1] * v0[1]) + (v0[2] * v0[2] + v0[3] * v0[3]) + (v1[0] * v1[0] + v1[1] * v1[1]) + (v1[2] * v1[2] + v1[3] * v1[3]);
                    if (bj == 0) ss0 = s; else ss1 = s; }
                if (u.pn == 8) { float s = ss0 + ss1; s += __shfl_xor(s, 16); s += __shfl_xor(s, 32); if (fq == 0) rsq[row * 4 + wc] = s; }
                if (u.pn == 9) { float s = ss0; s += __shfl_xor(s, 16); s += __shfl_xor(s, 32); if (fq == 0) rskv[row * 4 + wc] = s; }
            }
    }
};
struct EpiUp {
    static constexpr bool PERM = true;
    bf16 *Q, *QI, *Kk, *VT; LAS const float* rst;
    __device__ __forceinline__ void operator()(EPI_ARGS) const {
        const int row0 = u.pm * 256 + wr * 64 + fr, cl = wc * 32 + 8 * fq;
#pragma unroll
        for (int ai = 0; ai < 2; ++ai)
#pragma unroll
            for (int m = 0; m < 4; ++m) {
                const int row = row0 + ai * 128 + m * 16;
                float rs = rst[256 * u.slot + wr * 64 + fr + ai * 128 + m * 16];
                if (u.pn < 2) rs *= 0.125f * LOG2E;
#pragma unroll
                for (int bj = 0; bj < 2; ++bj) { const f32x4 v0 = acc[ai][bj][m][0] * rs, v1 = acc[ai][bj][m][1] * rs; const int c = cl + bj * 128;
                    if (u.pn < 5) {
                        u32x4 w; w.x = cvt_pk_bf16(v0[0], v0[1]); w.y = cvt_pk_bf16(v0[2], v0[3]); w.z = cvt_pk_bf16(v1[0], v1[1]); w.w = cvt_pk_bf16(v1[2], v1[3]);
                        bf16* dst = u.pn < 2 ? Q + (size_t)row * 512 + u.pn * 256 + c : (u.pn == 2 ? QI + (size_t)row * 256 + c : Kk + (size_t)row * 512 + (u.pn - 3) * 256 + c);
                        *(u32x4*)dst = w;
                    } else {
                        const int vc = (u.pn - 5) * 256 + c, h = vc >> 6, d = vc & 63, b = row >> 11, t = row & 2047;
                        bf16* dst = VT + ((size_t)(b * 8 + h) * 64 + d) * SEQ + t;
#pragma unroll
                        for (int j = 0; j < 4; ++j) { dst[(size_t)j * SEQ] = (bf16)f2bf(v0[j]); dst[(size_t)(4 + j) * SEQ] = (bf16)f2bf(v1[j]); }
                    } }
            }
    }
};
struct EpiOut {
    static constexpr bool PERM = false;
    const float* x; float* pre;
    __device__ __forceinline__ void operator()(EPI_ARGS) const {
        const int row0 = u.pm * 256 + wr * 64 + fr, col0 = u.pn * 256 + wc * 32 + 4 * fq;
#pragma unroll
        for (int ai = 0; ai < 2; ++ai)
#pragma unroll
            for (int m = 0; m < 4; ++m) { const size_t off = (size_t)(row0 + ai * 128 + m * 16) * D + col0;
#pragma unroll
                for (int bj = 0; bj < 2; ++bj)
#pragma unroll
                    for (int n = 0; n < 2; ++n) { const f32x4 xv = *(const f32x4*)(x + off + bj * 128 + n * 16); *(f32x4*)(pre + off + bj * 128 + n * 16) = xv * ALPHA + acc[ai][bj][m][n]; } }
    }
};
struct EpiGU {
    static constexpr bool PERM = true;
    bf16* H;
    __device__ __forceinline__ void operator()(EPI_ARGS) const {
        const int row0 = u.pm * 256 + wr * 64 + fr, col0 = u.pn * 128 + wc * 32 + 8 * fq;
#pragma unroll
        for (int ai = 0; ai < 2; ++ai)
#pragma unroll
            for (int m = 0; m < 4; ++m) { const f32x4 g0 = acc[ai][0][m][0], g1 = acc[ai][0][m][1], u0 = acc[ai][1][m][0], u1 = acc[ai][1][m][1];
                float h[8];
#pragma unroll
                for (int j = 0; j < 4; ++j) { h[j] = siluf_(g0[j]) * u0[j]; h[4 + j] = siluf_(g1[j]) * u1[j]; }
                u32x4 w; w.x = cvt_pk_bf16(h[0], h[1]); w.y = cvt_pk_bf16(h[2], h[3]); w.z = cvt_pk_bf16(h[4], h[5]); w.w = cvt_pk_bf16(h[6], h[7]);
                *(u32x4*)(H + (size_t)(row0 + ai * 128 + m * 16) * DE + col0) = w; }
    }
};
struct EpiDown {
    static constexpr bool PERM = true;
    bf16* Alo; bf16* Ahi; bf16* Blo; bf16* Bhi; LAS const float* lwt;
    __device__ __forceinline__ void operator()(EPI_ARGS) const {
        const int lr0 = wr * 64 + fr, col0 = wc * 32 + 8 * fq;
#pragma unroll
        for (int ai = 0; ai < 2; ++ai)
#pragma unroll
            for (int m = 0; m < 4; ++m) { const int lr = lr0 + ai * 128 + m * 16;
                const float wgt = lwt[256 * u.slot + lr];
                bf16* const ylo = (bf16*)((char*)Alo + (ptrdiff_t)u.pn * ((char*)Blo - (char*)Alo)); bf16* const yhi = (bf16*)((char*)Ahi + (ptrdiff_t)u.pn * ((char*)Bhi - (char*)Ahi));
                bf16* rowp = (u.pm < 512 ? ylo + (size_t)(u.pm * 256 + lr) * 256 : yhi + (size_t)((u.pm - 512) * 256 + lr) * 256) + col0;
#pragma unroll
                for (int bj = 0; bj < 2; ++bj) { const f32x4 v0 = acc[ai][bj][m][0] * wgt, v1 = acc[ai][bj][m][1] * wgt;
                    u32x4 w; w.x = cvt_pk_bf16(v0[0], v0[1]); w.y = cvt_pk_bf16(v0[2], v0[3]); w.z = cvt_pk_bf16(v1[0], v1[1]); w.w = cvt_pk_bf16(v1[2], v1[3]);
                    *(u32x4*)(rowp + bj * 128) = w; } }
    }
};

__device__ __forceinline__ void tr_item(const float* src, int ldn, int k0, int n0, int nvalid, bf16* dst, int ldk, const float* kscale, LAS float* scr, int lane) {
    const int n4 = (lane & 7) * 4;
#pragma unroll
    for (int i = 0; i < 8; ++i) { const int kk = (lane >> 3) + 8 * i; f32x4 v = {0.f, 0.f, 0.f, 0.f};
        if (n4 < nvalid) v = *(const f32x4*)(src + (size_t)(k0 + kk) * ldn + n0 + n4);
        if (kscale) v = v * kscale[k0 + kk];
        scr[kk * 33 + n4] = v[0]; scr[kk * 33 + n4 + 1] = v[1]; scr[kk * 33 + n4 + 2] = v[2]; scr[kk * 33 + n4 + 3] = v[3]; }
    LDS_WAIT();
    const int c = lane & 7;
#pragma unroll
    for (int j = 0; j < 4; ++j) { const int n = (lane >> 3) + 8 * j; const LAS float* s = scr + (8 * c) * 33 + n;
        u32x4 o; o.x = pk2(s[0 * 33], s[1 * 33]); o.y = pk2(s[2 * 33], s[3 * 33]); o.z = pk2(s[4 * 33], s[5 * 33]); o.w = pk2(s[6 * 33], s[7 * 33]);
        *(u32x4*)(dst + (size_t)n * ldk + 8 * c) = o; }
    LDS_WAIT();
}

struct Ptrs {
    const float* in[24]; float* out; unsigned char* ws;
};

__device__ __forceinline__ void phase_prep(const Ptrs& p, LAS unsigned char* lds, int vcu, int G) {
    const int tid = threadIdx.x, lane = tid & 63, wave = tid >> 6;
    LAS float* scr = (LAS float*)(lds + wave * 16384);
    const int gw = vcu * NWAVES + wave, NGW = G * NWAVES;
    bf16* WIN = (bf16*)(p.ws + WS_WIN); bf16* WUP = (bf16*)(p.ws + WS_WUP); bf16* WOUT = (bf16*)(p.ws + WS_WOUT); bf16* XB = (bf16*)(p.ws + WS_XB);
    constexpr int I_IN = 16 * 80, I_Q = 4 * 16, I_QI = 4 * 8, I_KV = 2 * 32, I_O = 16 * 32, NIT = I_IN + I_Q + I_QI + I_KV + I_O;
    for (int it = gw; it < NIT; it += NGW) {
        int r = it;
        if (r < I_IN) { const int kb = r / 80, nb = r % 80, n0 = nb * 32; int nv = DIN - n0; nv = nv < 0 ? 0 : (nv > 32 ? 32 : nv);
            tr_item(p.in[1], DIN, kb * 64, n0, nv, WIN + (size_t)n0 * D + kb * 64, D, nullptr, scr, lane); continue; } r -= I_IN;
        if (r < I_Q) { const int kb = r / 16, nb = r % 16; tr_item(p.in[5], 512, kb * 64, nb * 32, 32, WUP + (size_t)(nb * 32) * KUP + kb * 64, KUP, p.in[4], scr, lane); continue; } r -= I_Q;
        if (r < I_QI) { const int kb = r / 8, nb = r % 8; tr_item(p.in[6], 256, kb * 64, nb * 32, 32, WUP + (size_t)(512 + nb * 32) * KUP + kb * 64, KUP, p.in[4], scr, lane); continue; } r -= I_QI;
        if (r < I_KV) { const int kb = r / 32, nb = r % 32; tr_item(p.in[8], 1024, kb * 64, nb * 32, 32, WUP + (size_t)(768 + nb * 32) * KUP + kb * 64, KUP, p.in[7], scr, lane); continue; } r -= I_KV;
        { const int kb = r / 32, nb = r % 32; tr_item(p.in[11], D, kb * 64, nb * 32, 32, WOUT + (size_t)(nb * 32) * D + kb * 64, D, nullptr, scr, lane); }
    }
    const int gt = vcu * NTHR + tid, NGT = G * NTHR;
    if (gt < 512) ((float*)(p.ws + WS_LB))[gt] = 1.0f / (1.0f + __expf(p.in[2][512 + gt] - p.in[2][gt]));
    for (int ch = gt; ch < NUP * KUP / 8; ch += NGT) { const int r = ch / (KUP / 8), c = (ch % (KUP / 8)) * 8; if (r >= 768 && c >= 128) *(u32x4*)(WUP + (size_t)r * KUP + c) = (u32x4){0u, 0u, 0u, 0u}; }
    const float* x = p.in[0];
    for (int ch = gt; ch < T * D / 8; ch += NGT) { const f32x4 a = *(const f32x4*)(x + (size_t)ch * 8), b = *(const f32x4*)(x + (size_t)ch * 8 + 4);
        u32x4 o; o.x = pk2(a[0], a[1]); o.y = pk2(a[2], a[3]); o.z = pk2(b[0], b[1]); o.w = pk2(b[2], b[3]); *(u32x4*)(XB + (size_t)ch * 8) = o; }
}

__device__ __forceinline__ void phase_convert_gu(const Ptrs& p, LAS unsigned char* lds, int vcu, int G) {
    const int tid = threadIdx.x, lane = tid & 63, wave = tid >> 6;
    LAS float* scr = (LAS float*)(lds + wave * 16384);
    const int gw = vcu * NWAVES + wave, NGW = G * NWAVES;
    bf16* WGU = (bf16*)(p.ws + WS_WGU);
    for (int it = gw; it < NEX * 256; it += NGW) {
        const int e = it >> 8, r = it & 255, which = r >> 7, r2 = r & 127;
        const float* src = e < NE ? p.in[16 + which] + (size_t)e * D * DE : p.in[19 + which];
        const int kb = r2 / 8, nb = r2 % 8, n0 = nb * 32, row0 = (n0 >> 7) * 256 + (n0 & 127) + which * 128;
        tr_item(src, DE, kb * 64, n0, 32, WGU + ((size_t)e * 512 + row0) * D + kb * 64, D, nullptr, scr, lane);
    }
}
__device__ __forceinline__ void phase_convert_down(const Ptrs& p, LAS unsigned char* lds, int bi, int nb) {
    const int tid = threadIdx.x, lane = tid & 63, wave = tid >> 6;
    LAS float* scr = (LAS float*)(lds + wave * 16384);
    bf16* WD = (bf16*)(p.ws + WS_WD);
    for (int it = bi * NWAVES + wave; it < NEX * 128; it += nb * NWAVES) {
        const int e = it >> 7, r2 = it & 127;
        const float* src = e < NE ? p.in[18] + (size_t)e * DE * D : p.in[21];
        const int kb = r2 / 32, nbk = r2 % 32;
        tr_item(src, D, kb * 64, nbk * 32, 32, WD + ((size_t)e * D + nbk * 32) * DE + kb * 64, DE, nullptr, scr, lane);
    }
}

__device__ __forceinline__ void phase_kidx(const Ptrs& p, int vcu, int G) {
    const int tid = threadIdx.x, lane = tid & 63, wave = tid >> 6;
    const bf16* P = (const bf16*)(p.ws + WS_P); bf16* KIDX = (bf16*)(p.ws + WS_KIDX); float* WH = (float*)(p.ws + WS_WH);
    const float g = p.in[9][lane], bb = p.in[10][lane];
    for (int t0 = (vcu * NWAVES + wave) * 8; t0 < T; t0 += G * NWAVES * 8) {
        float v[8], wv[8];
#pragma unroll
        for (int i = 0; i < 8; ++i) { v[i] = bf2f(P[(size_t)(t0 + i) * DINP + 2432 + lane]); wv[i] = bf2f(P[(size_t)(t0 + i) * DINP + 2496 + (lane & 3)]); }
#pragma unroll
        for (int i = 0; i < 8; ++i) {
            const float mean = wave_sum(v[i]) * (1.0f / 64.0f); const float dv = v[i] - mean;
            const float var = wave_sum(dv * dv) * (1.0f / 64.0f);
            KIDX[(size_t)(t0 + i) * 64 + lane] = (bf16)f2bf(dv * __builtin_amdgcn_rsqf(var + 1e-5f) * g + bb);
            if (lane < 4) WH[(t0 + i) * 4 + lane] = wv[i] * 0.0625f; }
    }
}

constexpr int HG_B = 0, HG_TOT = 32768, HG_VT = 34816, HG_QD = 53248, HG_KI = 70656, HG_KD = 53248, HG_PART = 88064, HG_LB = 88576;
constexpr int HG_QP = 136;
__device__ __forceinline__ float fast_sigmoid(float x) { return __builtin_amdgcn_rcpf(1.0f + __builtin_amdgcn_exp2f(-x * LOG2E)); }
__device__ __forceinline__ float fast_exp(float x) { return __builtin_amdgcn_exp2f(x * LOG2E); }
__device__ __forceinline__ void hgrn_lb_to_lds(const Ptrs& p, LAS unsigned char* lds) { ((LAS float*)(lds + HG_LB))[threadIdx.x] = ((const float*)(p.ws + WS_LB))[threadIdx.x]; __syncthreads(); }
struct HgIn { u32x4 f0, f1, v0, v1, q0, q1; };
template <int MODE> __device__ __forceinline__ HgIn hg_load(const Ptrs& p, int item) {
    const int tid = threadIdx.x, t = tid >> 3, blk = tid & 7, c = item & 31, h = (item >> 5) & 3, b = item >> 7;
    const bf16* prow = (const bf16*)(p.ws + WS_P) + ((size_t)b * SEQ + c * 64 + t) * DINP + h * 128 + blk * 16;
    HgIn r; r.f0 = *(const u32x4*)(prow + 512); r.f1 = *(const u32x4*)(prow + 512 + 8); r.v0 = *(const u32x4*)(prow + 1024); r.v1 = *(const u32x4*)(prow + 1024 + 8);
    r.q0 = (u32x4){0u, 0u, 0u, 0u}; r.q1 = r.q0; if (MODE == 3) { r.q0 = *(const u32x4*)prow; r.q1 = *(const u32x4*)(prow + 8); }
    return r;
}
template <int MODE> __device__ __forceinline__ void hgrn_stage(const Ptrs& p, int item, LAS unsigned char* lds, const HgIn& in) {
    const int tid = threadIdx.x, t = tid >> 3, blk = tid & 7;
    const int c = item & 31, h = (item >> 5) & 3, b = item >> 7;
    const bf16* P = (const bf16*)(p.ws + WS_P); const LAS float* LB = (const LAS float*)(lds + HG_LB) + h * 128 + blk * 16;
    LAS float* bc = (LAS float*)(lds + HG_B); LAS float* tot = (LAS float*)(lds + HG_TOT); LAS bf16* VT = (LAS bf16*)(lds + HG_VT);
    const bf16* prow = P + ((size_t)b * SEQ + c * 64 + t) * DINP + h * 128 + blk * 16;
    SEC_B(44);
    float kk[16];
    const u32x4 gv0 = in.v0, gv1 = in.v1, gq0 = in.q0, gq1 = in.q1;
    { const u32x4 a = in.f0, a2 = in.f1;
      const unsigned w[8] = {a.x, a.y, a.z, a.w, a2.x, a2.y, a2.z, a2.w};
#pragma unroll
      for (int j = 0; j < 16; ++j) { const float x = (j & 1) ? bfhi(w[j >> 1]) : bflo(w[j >> 1]); const float lb = LB[j], sg = fast_sigmoid(x);
          kk[j] = (1.0f - lb) * (1.0f - sg); bc[t * 128 + blk * 16 + j] = __logf(1.0f - kk[j]); } }
    __syncthreads();
    SEC_E(44);
    { const int d = tid & 127, part = tid >> 7; float s = 0.f;
#pragma unroll 4
      for (int i = 0; i < 16; ++i) { const int tt = part * 16 + i; s += bc[tt * 128 + d]; bc[tt * 128 + d] = s; }
      tot[part * 128 + d] = s;
      __syncthreads();
      float off = 0.f;
      for (int q = 0; q < part; ++q) off += tot[q * 128 + d];
      if (part > 0) {
#pragma unroll 4
          for (int i = 0; i < 16; ++i) bc[(part * 16 + i) * 128 + d] += off; } }
    __syncthreads();
    { const unsigned w[8] = {gv0.x, gv0.y, gv0.z, gv0.w, gv1.x, gv1.y, gv1.z, gv1.w};
#pragma unroll
      for (int j = 0; j < 8; ++j) { VT[(blk * 16 + 2 * j) * 72 + t] = (bf16)(w[j] & 0xffffu); VT[(blk * 16 + 2 * j + 1) * 72 + t] = (bf16)(w[j] >> 16); } }
    if (MODE == 1) {
        LAS bf16* KD = (LAS bf16*)(lds + HG_KD);
#pragma unroll
        for (int j = 0; j < 16; ++j) { const int d = blk * 16 + j; KD[d * 72 + t] = (bf16)f2bf(kk[j] * fast_exp(bc[63 * 128 + d] - bc[t * 128 + d])); }
        if (tid < 128) ((float*)(p.ws + WS_DEC))[item * 128 + tid] = fast_exp(bc[63 * 128 + tid]);
    } else {
        LAS bf16* QD = (LAS bf16*)(lds + HG_QD); LAS bf16* KI = (LAS bf16*)(lds + HG_KI);
        const unsigned w[8] = {gq0.x, gq0.y, gq0.z, gq0.w, gq1.x, gq1.y, gq1.z, gq1.w};
        unsigned oq[8], ok[8];
#pragma unroll
        for (int j = 0; j < 8; ++j) { const float b0 = bc[t * 128 + blk * 16 + 2 * j], b1 = bc[t * 128 + blk * 16 + 2 * j + 1]; const float x0 = bflo(w[j]), x1 = bfhi(w[j]);
            oq[j] = pk2(x0 * fast_sigmoid(x0) * fast_exp(b0), x1 * fast_sigmoid(x1) * fast_exp(b1));
            ok[j] = pk2(kk[2 * j] * fast_exp(-b0), kk[2 * j + 1] * fast_exp(-b1)); }
        *(LAS u32x4*)(QD + t * HG_QP + blk * 16) = (u32x4){oq[0], oq[1], oq[2], oq[3]}; *(LAS u32x4*)(QD + t * HG_QP + blk * 16 + 8) = (u32x4){oq[4], oq[5], oq[6], oq[7]};
        *(LAS u32x4*)(KI + t * HG_QP + blk * 16) = (u32x4){ok[0], ok[1], ok[2], ok[3]}; *(LAS u32x4*)(KI + t * HG_QP + blk * 16 + 8) = (u32x4){ok[4], ok[5], ok[6], ok[7]};
    }
    __syncthreads();
}
__device__ __forceinline__ void hgrn1_item(const Ptrs& p, int item, LAS unsigned char* lds, const HgIn& in) {
    const int tid = threadIdx.x, lane = tid & 63, w = tid >> 6;
    hgrn_stage<1>(p, item, lds, in);
    LAS bf16* KD = (LAS bf16*)(lds + HG_KD); LAS bf16* VT = (LAS bf16*)(lds + HG_VT);
    bf16* DS = (bf16*)(p.ws + WS_DS) + (size_t)item * 16384;
    { const int cc = lane & 15, g = lane >> 4;
      bf16x8 af[2];
#pragma unroll
      for (int ks = 0; ks < 2; ++ks) af[ks] = *(const LAS bf16x8*)(KD + (16 * w + cc) * 72 + 32 * ks + 8 * g);
#pragma unroll
      for (int vt = 0; vt < 8; ++vt) {
          f32x4 C = {0.f, 0.f, 0.f, 0.f};
#pragma unroll
          for (int ks = 0; ks < 2; ++ks) { const bf16x8 bfm = *(const LAS bf16x8*)(VT + (16 * vt + cc) * 72 + 32 * ks + 8 * g); C = __builtin_amdgcn_mfma_f32_16x16x32_bf16(af[ks], bfm, C, 0, 0, 0); }
          u32x2 o; o.x = pk2(C[0], C[1]); o.y = pk2(C[2], C[3]);
          *(u32x2*)(DS + (size_t)(16 * vt + cc) * 128 + 16 * w + 4 * g) = o; } }
    __syncthreads();
}
__device__ __forceinline__ void phase_scan(const Ptrs& p, int vcu, int G) {
    const bf16* DS = (const bf16*)(p.ws + WS_DS); bf16* SP = (bf16*)(p.ws + WS_SP); const float* DEC = (const float*)(p.ws + WS_DEC);
    for (int gt = vcu * NTHR + threadIdx.x; gt < 32 * 4096; gt += G * NTHR) {
        const int bh = gt >> 12, e4 = gt & 4095, d0 = (e4 & 31) * 4; const size_t eo = (size_t)(e4 >> 5) * 128 + d0;
        float S0 = 0.f, S1 = 0.f, S2 = 0.f, S3 = 0.f;
#pragma unroll 4
        for (int c = 0; c < 32; ++c) { const size_t item = (size_t)bh * 32 + c;
            const u32x2 ds = *(const u32x2*)(DS + item * 16384 + eo); const f32x4 dc = *(const f32x4*)(DEC + item * 128 + d0);
            u32x2 o; o.x = pk2(S0, S1); o.y = pk2(S2, S3); *(u32x2*)(SP + item * 16384 + eo) = o;
            S0 = dc[0] * S0 + bflo(ds.x); S1 = dc[1] * S1 + bfhi(ds.x); S2 = dc[2] * S2 + bflo(ds.y); S3 = dc[3] * S3 + bfhi(ds.y); }
    }
}
__device__ __forceinline__ void hgrn3_item(const Ptrs& p, int item, LAS unsigned char* lds, const HgIn& in) {
    const int tid = threadIdx.x, lane = tid & 63, w = tid >> 6, cc = lane & 15, g = lane >> 4;
    const int c = item & 31, h = (item >> 5) & 3, b = item >> 7;
    const bf16* P = (const bf16*)(p.ws + WS_P);
    const int tt = w & 3, vh = w >> 2;
    bf16x8 spf[4][4];
    { const bf16* SPi = (const bf16*)(p.ws + WS_SP) + (size_t)item * 16384;
#pragma unroll
      for (int vi = 0; vi < 4; ++vi)
#pragma unroll
          for (int ks = 0; ks < 4; ++ks) spf[vi][ks] = *(const bf16x8*)(SPi + (size_t)(16 * (4 * vh + vi) + cc) * 128 + 32 * ks + 8 * g); }
    u32x2 gtp[4]; f32x4 ngp[4];
    { const size_t tokq = (size_t)b * SEQ + c * 64 + 16 * tt + cc;
#pragma unroll
      for (int vi = 0; vi < 4; ++vi) { const int v0 = 16 * (4 * vh + vi) + 4 * g; gtp[vi] = *(const u32x2*)(P + tokq * DINP + 1536 + h * 128 + v0); ngp[vi] = *(const f32x4*)(p.in[3] + v0); } }
    hgrn_stage<3>(p, item, lds, in);
    LAS bf16* VT = (LAS bf16*)(lds + HG_VT); LAS float* part = (LAS float*)(lds + HG_PART); LAS bf16* QD = (LAS bf16*)(lds + HG_QD); LAS bf16* KI = (LAS bf16*)(lds + HG_KI);
    const size_t tok0 = (size_t)b * SEQ + c * 64;
    bf16x8 qd[4];
#pragma unroll
    for (int ks = 0; ks < 4; ++ks) qd[ks] = *(const LAS bf16x8*)(QD + (16 * tt + cc) * HG_QP + 32 * ks + 8 * g);
    u32x2 scb[4];
#pragma unroll
    for (int st = 0; st < 4; ++st) {
        scb[st] = (u32x2){0u, 0u};
        if (st <= tt) {
            f32x4 C = {0.f, 0.f, 0.f, 0.f};
#pragma unroll
            for (int ks = 0; ks < 4; ++ks) C = __builtin_amdgcn_mfma_f32_16x16x32_bf16(*(const LAS bf16x8*)(KI + (16 * st + cc) * HG_QP + 32 * ks + 8 * g), qd[ks], C, 0, 0, 0);
#pragma unroll
            for (int i = 0; i < 4; ++i) if (16 * st + 4 * g + i > 16 * tt + cc) C[i] = 0.f;
            scb[st] = (u32x2){pk2(C[0], C[1]), pk2(C[2], C[3])};
        }
    }
    f32x4 o[4]; float ss = 0.f;
#pragma unroll
    for (int vi = 0; vi < 4; ++vi) { const int vt = 4 * vh + vi; f32x4 C = {0.f, 0.f, 0.f, 0.f};
#pragma unroll
        for (int ks = 0; ks < 4; ++ks) C = __builtin_amdgcn_mfma_f32_16x16x32_bf16(spf[vi][ks], qd[ks], C, 0, 0, 0);
#pragma unroll
        for (int kp = 0; kp < 2; ++kp) if (2 * kp <= tt) {
            const u32x2 v0 = *(const LAS u32x2*)(VT + (16 * vt + cc) * 72 + 32 * kp + 4 * g), v1 = *(const LAS u32x2*)(VT + (16 * vt + cc) * 72 + 32 * kp + 16 + 4 * g);
            C = __builtin_amdgcn_mfma_f32_16x16x32_bf16(__builtin_bit_cast(bf16x8, (u32x4){v0.x, v0.y, v1.x, v1.y}), __builtin_bit_cast(bf16x8, (u32x4){scb[2 * kp].x, scb[2 * kp].y, scb[2 * kp + 1].x, scb[2 * kp + 1].y}), C, 0, 0, 0); }
        o[vi] = C; ss += (C[0] * C[0] + C[1] * C[1]) + (C[2] * C[2] + C[3] * C[3]); }
    ss += __shfl_xor(ss, 16); ss += __shfl_xor(ss, 32);
    if (g == 0) part[vh * 64 + 16 * tt + cc] = ss;
    __syncthreads();
    const float rstd = __builtin_amdgcn_rsqf((part[16 * tt + cc] + part[64 + 16 * tt + cc]) * (1.0f / 128.0f) + 1e-6f);
    bf16* OC = (bf16*)(p.ws + WS_XB);
    { const size_t tok = tok0 + 16 * tt + cc;
#pragma unroll
      for (int vi = 0; vi < 4; ++vi) { const int v0 = 16 * (4 * vh + vi) + 4 * g;
          const u32x2 gt = gtp[vi]; const f32x4 ng = ngp[vi];
          u32x2 ov; ov.x = pk2(o[vi][0] * rstd * ng[0] * siluf_(bflo(gt.x)), o[vi][1] * rstd * ng[1] * siluf_(bfhi(gt.x)));
          ov.y = pk2(o[vi][2] * rstd * ng[2] * siluf_(bflo(gt.y)), o[vi][3] * rstd * ng[3] * siluf_(bfhi(gt.y)));
          *(u32x2*)(OC + tok * D + h * 128 + v0) = ov; } }
    __syncthreads();
}

constexpr int IX_P = 2052;
__device__ __forceinline__ void cnt_ge_u32(int& cnt, unsigned a, unsigned b) { unsigned long long t; asm("v_cmp_ge_u32_e64 %1, %2, %3\n\tv_addc_co_u32_e64 %0, %1, 0, %0, %1" : "+v"(cnt), "=&s"(t) : "v"(a), "v"(b)); }
__device__ __forceinline__ void cnt_le_u32(int& cnt, unsigned a, unsigned b) { unsigned long long t; asm("v_cmp_le_u32_e64 %1, %2, %3\n\tv_addc_co_u32_e64 %0, %1, 0, %0, %1" : "+v"(cnt), "=&s"(t) : "v"(a), "v"(b)); }
__device__ __forceinline__ void cnt_lt_u32s(int& cnt, unsigned a, unsigned sb) { asm("v_cmp_gt_u32 vcc, %2, %1\n\tv_addc_co_u32 %0, vcc, 0, %0, vcc" : "+v"(cnt) : "v"(a), "s"(sb) : "vcc"); }
__device__ __forceinline__ void cnt_gt_u64(int& cnt, unsigned long long a, unsigned long long b) { asm("v_cmp_gt_u64 vcc, %1, %2\n\tv_addc_co_u32 %0, vcc, 0, %0, vcc" : "+v"(cnt) : "v"(a), "v"(b) : "vcc"); }
__device__ __forceinline__ unsigned ord_u32(float f) { unsigned b = __builtin_bit_cast(unsigned, f); if (b == 0x80000000u) b = 0u; return (b & 0x80000000u) ? ~b : (b | 0x80000000u); }
__device__ __forceinline__ int bcnt_ge(unsigned a, unsigned sb) { int r; asm("v_cmp_le_u32 vcc, %2, %1\n\ts_bcnt1_i32_b64 %0, vcc" : "=s"(r) : "v"(a), "s"(sb) : "vcc", "scc"); return r; }
__device__ __forceinline__ int bcnt_le(unsigned a, unsigned sb) { int r; asm("v_cmp_ge_u32 vcc, %2, %1\n\ts_bcnt1_i32_b64 %0, vcc" : "=s"(r) : "v"(a), "s"(sb) : "vcc", "scc"); return r; }
__device__ __forceinline__ int wave_sum_dpp(int v) {
    v += __builtin_amdgcn_update_dpp(0, v, 0x111, 0xF, 0xF, false);
    v += __builtin_amdgcn_update_dpp(0, v, 0x112, 0xF, 0xF, false);
    v += __builtin_amdgcn_update_dpp(0, v, 0x114, 0xF, 0xF, false);
    v += __builtin_amdgcn_update_dpp(0, v, 0x118, 0xF, 0xF, false);
    v += __builtin_amdgcn_update_dpp(0, v, 0x142, 0xA, 0xF, false);
    v += __builtin_amdgcn_update_dpp(0, v, 0x143, 0xC, 0xF, false);
    return __builtin_amdgcn_readlane(v, 63);
}
template <int NR> __device__ __forceinline__ void topk_row(const LAS unsigned* srow, int nreg, int lane, LAS unsigned* mrow  ) {
    unsigned u[NR];
#pragma unroll
    for (int j = 0; j < NR; ++j) u[j] = srow[64 * j + lane];
    unsigned Tt = 0u;
#pragma unroll 1
    for (int bit = 31; bit >= 0; --bit) {
        const unsigned cand = (unsigned)__builtin_amdgcn_readfirstlane((int)(Tt | (1u << bit))); int c4[4] = {0, 0, 0, 0};
#pragma unroll
        for (int j = 0; j < NR; ++j) cnt_ge_u32(c4[j & 3], u[j], cand);
        const int cnt = wave_sum_dpp((c4[0] + c4[1]) + (c4[2] + c4[3]));
        if (cnt >= 256) Tt = cand;
        if (cnt == 256) break;
    }
    int cge = 0;
#pragma unroll
    for (int j = 0; j < NR; ++j) { const unsigned uu = u[j]; cge += (uu >= Tt) ? 1 : 0;
        u[j] = uu > Tt ? 0u : (uu == Tt ? (unsigned)(1 + 64 * j + lane) : 4096u); }
    const int cgt = 0, ceq = wave_sum_dpp(cge);
    unsigned X = 2048u;
    if (cgt + ceq > 256) {
        unsigned Xb = 0u;
#pragma unroll 1
        for (int bit = 11; bit >= 0; --bit) {
            const unsigned cand = (unsigned)__builtin_amdgcn_readfirstlane((int)(Xb | (1u << bit))); int c4[4] = {0, 0, 0, 0};
#pragma unroll
            for (int j = 0; j < NR; ++j) cnt_le_u32(c4[j & 3], u[j], cand);
            const int cnt = wave_sum_dpp((c4[0] + c4[1]) + (c4[2] + c4[3]));
            if (cnt <= 256) Xb = cand;
        }
        X = Xb;
    }
    unsigned myword = 0u;
#pragma unroll
    for (int j = 0; j < NR; ++j) { const unsigned long long bal = __ballot(u[j] <= X); if ((lane >> 1) == j) myword = (lane & 1) ? (unsigned)(bal >> 32) : (unsigned)bal; }
    if (lane < 2 * nreg) mrow[16 * lane] = myword;
}
__device__ __forceinline__ void indexer_item(const Ptrs& p, int item, LAS unsigned char* lds) {
    const int tid = threadIdx.x, lane = tid & 63, w = __builtin_amdgcn_readfirstlane(tid >> 6), q = lane & 15, g = lane >> 4;
    const int b = item >> 7, qg = item & 127, c = qg >> 2, nw = 2 * (c + 1);
    unsigned* MASKT = (unsigned*)(p.ws + WS_MASK) + (size_t)b * 64 * SEQ;
    if (c < 4) { for (int idx = tid; idx < nw * 16; idx += NTHR) MASKT[(size_t)(idx >> 4) * SEQ + qg * 16 + (idx & 15)] = 0xFFFFFFFFu; return; }
    const bf16* QI = (const bf16*)(p.ws + WS_QI); const bf16* KIDX = (const bf16*)(p.ws + WS_KIDX); const float* WH = (const float*)(p.ws + WS_WH);
    LAS unsigned* S = (LAS unsigned*)lds;
    {
        const size_t tokq = (size_t)b * SEQ + qg * 16 + q;
        bf16x8 qf[4][2]; float wq[4];
#pragma unroll
        for (int h = 0; h < 4; ++h) { wq[h] = WH[tokq * 4 + h];
#pragma unroll
            for (int ks = 0; ks < 2; ++ks) qf[h][ks] = *(const bf16x8*)(QI + tokq * 256 + h * 64 + 32 * ks + 8 * g); }
        const int ntile = 4 * (c + 1);
#pragma unroll 4
        for (int j = w; j < ntile; j += 8) {
            const bf16* kp = KIDX + ((size_t)b * SEQ + 16 * j + q) * 64 + 8 * g;
            const bf16x8 k0 = *(const bf16x8*)kp, k1 = *(const bf16x8*)(kp + 32);
            float sc[4] = {0.f, 0.f, 0.f, 0.f};
#pragma unroll
            for (int h = 0; h < 4; ++h) { f32x4 C = {0.f, 0.f, 0.f, 0.f};
                C = __builtin_amdgcn_mfma_f32_16x16x32_bf16(k0, qf[h][0], C, 0, 0, 0); C = __builtin_amdgcn_mfma_f32_16x16x32_bf16(k1, qf[h][1], C, 0, 0, 0);
#pragma unroll
                for (int i = 0; i < 4; ++i) sc[i] += wq[h] * fmaxf(C[i], 0.f); }
            *(LAS u32x4*)(S + q * IX_P + 16 * j + 4 * g) = (u32x4){ord_u32(sc[0]), ord_u32(sc[1]), ord_u32(sc[2]), ord_u32(sc[3])};
        }
    }
    {
        const int nend = ((c + 8) & ~7) * 64, n0 = 64 * (c + 1);
        for (int idx = tid; idx < 16 * ((nend - n0) >> 2); idx += NTHR) { const int per = (nend - n0) >> 2, r = idx / per, k4 = idx % per; *(LAS u32x4*)(S + r * IX_P + n0 + 4 * k4) = (u32x4){0u, 0u, 0u, 0u}; }
    }
    __syncthreads();
    {
        const int nreg = c + 1;
#pragma unroll 1
        for (int rr = 0; rr < 2; ++rr) { const int row = 2 * w + rr; const LAS unsigned* srow = S + row * IX_P; LAS unsigned* mrow = S + 16 * IX_P + row;
            if (nreg <= 8) topk_row<8>(srow, nreg, lane, mrow); else if (nreg <= 16) topk_row<16>(srow, nreg, lane, mrow);
            else if (nreg <= 24) topk_row<24>(srow, nreg, lane, mrow); else topk_row<32>(srow, nreg, lane, mrow); }
    }
    __syncthreads();
    for (int idx = tid; idx < nw * 16; idx += NTHR) MASKT[(size_t)(idx >> 4) * SEQ + qg * 16 + (idx & 15)] = S[16 * IX_P + idx];
    __syncthreads();
}

__device__ __forceinline__ int crow(int r, int hi) { return (r & 3) + 8 * (r >> 2) + 4 * hi; }
constexpr int AT_KP = 144, AT_VP = 136, AT_KB = 64 * AT_KP, AT_VB = 64 * AT_VP, AT_STAGE = AT_KB + AT_VB;
struct AtRegs { u32x4 k, v; unsigned m0, m1; };
__device__ __forceinline__ void attn_unit(const Ptrs& p, int b, int h, int QB, LAS unsigned char* lds) {
    const int tid = threadIdx.x, lane = tid & 63, w = __builtin_amdgcn_readfirstlane(tid >> 6), q = lane & 31, hh = lane >> 5;
    const int tq = 256 * QB + 32 * w + q, NT = 4 * QB + 4, ntw = 4 * QB + (w >> 1) + 1;
    const size_t tok = (size_t)b * SEQ + tq;
    const bf16* Q = (const bf16*)(p.ws + WS_Q); const bf16* Kb = (const bf16*)(p.ws + WS_K) + (size_t)b * SEQ * 512 + h * 64;
    const bf16* VTb = (const bf16*)(p.ws + WS_VT) + (size_t)(b * 8 + h) * 64 * SEQ; const unsigned* MASKT = (const unsigned*)(p.ws + WS_MASK) + (size_t)b * 64 * SEQ + tq;
    const float slope2 = __builtin_amdgcn_exp2f(-(float)(h + 1)) * LOG2E;
    bf16x8 qf[4];
#pragma unroll
    for (int ks = 0; ks < 4; ++ks) qf[ks] = *(const bf16x8*)(Q + tok * 512 + h * 64 + 16 * ks + 8 * hh);
    const int srow = tid >> 3, sch = tid & 7;
    const bf16* kg = Kb + (size_t)srow * 512 + sch * 8; const bf16* vg = VTb + (size_t)srow * SEQ + sch * 8;
    const int kso = srow * AT_KP + sch * 16, vso = AT_KB + srow * AT_VP + sch * 16;
#define AT_LOAD(R, i_) do { if ((i_) < NT) { const int t_ = NT - 1 - (i_); (R).k = *(const u32x4*)(kg + (size_t)t_ * 64 * 512); (R).v = *(const u32x4*)(vg + t_ * 64); \
        if (t_ < ntw) { (R).m0 = MASKT[(size_t)(2 * t_) * SEQ]; (R).m1 = MASKT[(size_t)(2 * t_ + 1) * SEQ]; } } } while (0)
#define AT_WRITE(R, so) do { *(LAS u32x4*)(lds + (so) + kso) = (R).k; *(LAS u32x2*)(lds + (so) + vso) = (u32x2){(R).v.x, (R).v.y}; *(LAS u32x2*)(lds + (so) + vso + 8) = (u32x2){(R).v.z, (R).v.w}; } while (0)
    f32x16 o0 = {}, o1 = {}; float m = 0.f, l = 0.f;
#define AT_COMPUTE(kt, so, w0, w1) do { if ((kt) < ntw) { \
        LAS const unsigned char* sb = lds + (so); \
        f32x16 S0, S1; \
          \
        if (64 * (kt) + 63 < 256 * QB + 32 * w) {        \
            const float lb0 = -slope2 * (float)(tq - 64 * (kt) - 4 * hh) - m; \
            _Pragma("unroll") for (int r = 0; r < 16; ++r) { S0[r] = lb0 + slope2 * (float)((r & 3) + 8 * (r >> 2)); S1[r] = S0[r] + 32.0f * slope2; } \
        } else { \
            _Pragma("unroll") for (int r = 0; r < 16; ++r) { const int key = 64 * (kt) + crow(r, hh); const int d0 = tq > key ? tq - key : key - tq; const int key1 = key + 32; const int d1 = tq > key1 ? tq - key1 : key1 - tq; \
                S0[r] = -slope2 * (float)d0 - m; S1[r] = -slope2 * (float)d1 - m; } \
        } \
        _Pragma("unroll") for (int ks = 0; ks < 4; ++ks) { \
            const bf16x8 k0 = *(LAS const bf16x8*)(sb + q * AT_KP + 32 * ks + 16 * hh), k1 = *(LAS const bf16x8*)(sb + (32 + q) * AT_KP + 32 * ks + 16 * hh); \
            S0 = __builtin_amdgcn_mfma_f32_32x32x16_bf16(k0, qf[ks], S0, 0, 0, 0); S1 = __builtin_amdgcn_mfma_f32_32x32x16_bf16(k1, qf[ks], S1, 0, 0, 0); } \
          \
        float rm = fmaxf(S0[0], S1[0]); \
        _Pragma("unroll") for (int r = 1; r < 16; ++r) rm = fmaxf(fmaxf(rm, S0[r]), S1[r]); \
        rm = fmaxf(rm, __shfl_xor(rm, 32)); \
        if (__any(rm > 0.f)) { const float dl = fmaxf(rm, 0.f), alpha = __builtin_amdgcn_exp2f(-dl); l *= alpha; m += dl; \
            _Pragma("unroll") for (int r = 0; r < 16; ++r) { o0[r] *= alpha; o1[r] *= alpha; S0[r] -= dl; S1[r] -= dl; } } \
        float ls = 0.f; \
        _Pragma("unroll") for (int r = 0; r < 16; ++r) { const int cr = crow(r, hh); \
            const unsigned e0 = __builtin_bit_cast(unsigned, __builtin_amdgcn_exp2f(S0[r])) & (unsigned)__builtin_amdgcn_sbfe((int)(w0), cr, 1); \
            const unsigned e1 = __builtin_bit_cast(unsigned, __builtin_amdgcn_exp2f(S1[r])) & (unsigned)__builtin_amdgcn_sbfe((int)(w1), cr, 1); \
            S0[r] = __builtin_bit_cast(float, e0); S1[r] = __builtin_bit_cast(float, e1); ls += S0[r] + S1[r]; } \
        l += ls; \
        LAS const unsigned char* vb = sb + AT_KB; \
        _Pragma("unroll") for (int s2 = 0; s2 < 4; ++s2) { \
            const bf16x8 pa = (s2 < 2) \
                ? __builtin_bit_cast(bf16x8, (u32x4){cvt_pk_bf16(S0[8 * (s2 & 1)], S0[8 * (s2 & 1) + 1]), cvt_pk_bf16(S0[8 * (s2 & 1) + 2], S0[8 * (s2 & 1) + 3]), cvt_pk_bf16(S0[8 * (s2 & 1) + 4], S0[8 * (s2 & 1) + 5]), cvt_pk_bf16(S0[8 * (s2 & 1) + 6], S0[8 * (s2 & 1) + 7])}) \
                : __builtin_bit_cast(bf16x8, (u32x4){cvt_pk_bf16(S1[8 * (s2 & 1)], S1[8 * (s2 & 1) + 1]), cvt_pk_bf16(S1[8 * (s2 & 1) + 2], S1[8 * (s2 & 1) + 3]), cvt_pk_bf16(S1[8 * (s2 & 1) + 4], S1[8 * (s2 & 1) + 5]), cvt_pk_bf16(S1[8 * (s2 & 1) + 6], S1[8 * (s2 & 1) + 7])}); \
            const u32x2 a0 = *(LAS const u32x2*)(vb + q * AT_VP + 32 * s2 + 8 * hh), a1 = *(LAS const u32x2*)(vb + q * AT_VP + 32 * s2 + 8 * hh + 16); \
            const u32x2 c0 = *(LAS const u32x2*)(vb + (32 + q) * AT_VP + 32 * s2 + 8 * hh), c1 = *(LAS const u32x2*)(vb + (32 + q) * AT_VP + 32 * s2 + 8 * hh + 16); \
            o0 = __builtin_amdgcn_mfma_f32_32x32x16_bf16(__builtin_bit_cast(bf16x8, (u32x4){a0.x, a0.y, a1.x, a1.y}), pa, o0, 0, 0, 0); \
            o1 = __builtin_amdgcn_mfma_f32_32x32x16_bf16(__builtin_bit_cast(bf16x8, (u32x4){c0.x, c0.y, c1.x, c1.y}), pa, o1, 0, 0, 0); } } } while (0)
    AtRegs R0, R1; R0.m0 = R0.m1 = R1.m0 = R1.m1 = 0u; R0.k = R0.v = R1.k = R1.v = (u32x4){0u, 0u, 0u, 0u};
    AT_LOAD(R0, 0); AT_LOAD(R1, 1);
    unsigned cm0 = R0.m0, cm1 = R0.m1;
    AT_WRITE(R0, 0);
    AT_LOAD(R0, 2);
    __syncthreads();
    int s_cur = 0, s_nxt = AT_STAGE, s_nn = 2 * AT_STAGE;
    for (int kt = 0; kt < NT; kt += 2) {
        AT_COMPUTE(NT - 1 - kt, s_cur, cm0, cm1);
        cm0 = R1.m0; cm1 = R1.m1;
        AT_WRITE(R1, s_nxt);
        AT_LOAD(R1, kt + 3);
        __syncthreads();
        AT_COMPUTE(NT - 2 - kt, s_nxt, cm0, cm1);
        cm0 = R0.m0; cm1 = R0.m1;
        if (kt + 2 < NT) AT_WRITE(R0, s_nn);
        AT_LOAD(R0, kt + 4);
        __syncthreads();
        { const int t0 = s_cur; s_cur = s_nn; s_nn = s_nxt; s_nxt = t0; }
    }
#undef AT_LOAD
#undef AT_WRITE
#undef AT_COMPUTE
    l += __shfl_xor(l, 32);
    const float inv = l > 0.f ? 1.0f / l : 0.f;
    bf16* OC = (bf16*)(p.ws + WS_XB) + tok * D + 512 + h * 64;
#pragma unroll
    for (int r4 = 0; r4 < 4; ++r4) {
        u32x2 a; a.x = pk2(o0[4 * r4] * inv, o0[4 * r4 + 1] * inv); a.y = pk2(o0[4 * r4 + 2] * inv, o0[4 * r4 + 3] * inv); *(u32x2*)(OC + 8 * r4 + 4 * hh) = a;
        u32x2 c; c.x = pk2(o1[4 * r4] * inv, o1[4 * r4 + 1] * inv); c.y = pk2(o1[4 * r4 + 2] * inv, o1[4 * r4 + 3] * inv); *(u32x2*)(OC + 32 + 8 * r4 + 4 * hh) = c; }
}

constexpr int R6_HP = 1032;
constexpr int R6_HBUF = 0, R6_HLO = 16 * R6_HP * 2, R6_PART = 2 * 16 * R6_HP * 2, R6_LCNT = R6_PART + 8 * 16 * 64 * 4, R6_GBASE = R6_LCNT + 256, R6_ENT = R6_GBASE + 256;
constexpr int R6_GB = R6_ENT + 6144;
__device__ __forceinline__ void phase_ln1_router(const Ptrs& p, LAS unsigned char* lds, int vcu, int G) {
    const int tid = threadIdx.x, lane = tid & 63, wave = __builtin_amdgcn_readfirstlane(tid >> 6);
    LAS bf16* hhi = (LAS bf16*)(lds + R6_HBUF); LAS bf16* hlo = (LAS bf16*)(lds + R6_HLO); LAS float* part = (LAS float*)(lds + R6_PART);
    LAS int* lcnt = (LAS int*)(lds + R6_LCNT); LAS int* gbase = (LAS int*)(lds + R6_GBASE); LAS int* ent = (LAS int*)(lds + R6_ENT);
    const float* pre = (const float*)(p.ws + WS_HB); bf16* H1B = (bf16*)(p.ws + WS_XB);
    const float* g1 = p.in[12]; const float* b1 = p.in[13]; const float* Wr = p.in[14]; const float rbias = p.in[15][lane];
    unsigned* cnt = (unsigned*)(p.ws + WS_CTL) + CW_CNT; int* LTOK = (int*)(p.ws + WS_LTOK); float* LW = (float*)(p.ws + WS_LW); unsigned* ROUTE = (unsigned*)(p.ws + WS_ROUTE);
    { LAS float* gb = (LAS float*)(lds + R6_GB); for (int i = tid; i < D; i += NTHR) { gb[i] = g1[i]; gb[D + i] = b1[i]; } }
    SEC_B(60);
    bf16x8 bhi[4][4], blo[4][4];
    { const float* bp = Wr + (size_t)(128 * wave + 8 * (lane >> 4)) * 64 + (lane & 15);
#pragma unroll
      for (int ks = 0; ks < 4; ++ks)
#pragma unroll
          for (int nt = 0; nt < 4; ++nt) { float wv[8];
#pragma unroll
              for (int jx = 0; jx < 8; ++jx) wv[jx] = bp[(size_t)(32 * ks + jx) * 64 + 16 * nt];
              unsigned hw[4], lw[4];
#pragma unroll
              for (int jx = 0; jx < 4; ++jx) { const unsigned h0 = f2bf(wv[2 * jx]), h1 = f2bf(wv[2 * jx + 1]); hw[jx] = h0 | (h1 << 16); lw[jx] = pk2(wv[2 * jx] - bf2f(h0), wv[2 * jx + 1] - bf2f(h1)); }
              bhi[ks][nt] = __builtin_bit_cast(bf16x8, (u32x4){hw[0], hw[1], hw[2], hw[3]}); blo[ks][nt] = __builtin_bit_cast(bf16x8, (u32x4){lw[0], lw[1], lw[2], lw[3]}); } }
    asm volatile("s_waitcnt vmcnt(0)" ::: "memory"); SEC_E(60);
    for (int tile = vcu; tile < T / 64; tile += G) {
        if (tid < 64) lcnt[tid] = 0;
        f32x4 vn[2][4];
#pragma unroll
        for (int j2 = 0; j2 < 2; ++j2)
#pragma unroll
            for (int jj = 0; jj < 4; ++jj) vn[j2][jj] = *(const f32x4*)(pre + (size_t)(tile * 64 + 2 * wave + j2) * D + 4 * lane + 256 * jj);
        for (int sub = 0; sub < 4; ++sub) {
            const int tok0 = tile * 64 + sub * 16;
            SEC_B(61);
            f32x4 v[2][4];
#pragma unroll
            for (int j2 = 0; j2 < 2; ++j2)
#pragma unroll
                for (int jj = 0; jj < 4; ++jj) v[j2][jj] = vn[j2][jj];
            if (sub < 3) {
#pragma unroll
                for (int j2 = 0; j2 < 2; ++j2)
#pragma unroll
                    for (int jj = 0; jj < 4; ++jj) vn[j2][jj] = *(const f32x4*)(pre + (size_t)(tok0 + 16 + 2 * wave + j2) * D + 4 * lane + 256 * jj); }
            SEC_B(66);
#pragma unroll
            for (int j2 = 0; j2 < 2; ++j2) { const int tl = 2 * wave + j2; const size_t tok = tok0 + tl;
                float s = 0.f;
#pragma unroll
                for (int jj = 0; jj < 4; ++jj) s += (v[j2][jj][0] + v[j2][jj][1]) + (v[j2][jj][2] + v[j2][jj][3]);
                const float mean = wave_sum(s) * (1.0f / D); float s2 = 0.f;
#pragma unroll
                for (int jj = 0; jj < 4; ++jj) { v[j2][jj] = v[j2][jj] - mean; s2 += (v[j2][jj][0] * v[j2][jj][0] + v[j2][jj][1] * v[j2][jj][1]) + (v[j2][jj][2] * v[j2][jj][2] + v[j2][jj][3] * v[j2][jj][3]); }
                const float rstd = 1.0f / sqrtf(wave_sum(s2) * (1.0f / D) + 1e-5f);
#pragma unroll
                for (int jj = 0; jj < 4; ++jj) { const int c0 = 4 * lane + 256 * jj; const f32x4 gg = *(const LAS f32x4*)((LAS float*)(lds + R6_GB) + c0), bb = *(const LAS f32x4*)((LAS float*)(lds + R6_GB) + D + c0);
                    const f32x4 hv = v[j2][jj] * rstd * gg + bb;
                    u32x2 o; o.x = cvt_pk_bf16(hv[0], hv[1]); o.y = cvt_pk_bf16(hv[2], hv[3]); *(u32x2*)(H1B + tok * D + c0) = o;
                    u32x2 lo2; lo2.x = cvt_pk_bf16(hv[0] - bflo(o.x), hv[1] - bfhi(o.x)); lo2.y = cvt_pk_bf16(hv[2] - bflo(o.y), hv[3] - bfhi(o.y));
                    *(LAS u32x2*)(hhi + tl * R6_HP + c0) = o; *(LAS u32x2*)(hlo + tl * R6_HP + c0) = lo2; } }
            SEC_E(66); SEC_B(67);
            __syncthreads();
            SEC_E(67);
            SEC_E(61); SEC_B(62);
            { f32x4 acc[4];
#pragma unroll
              for (int nt = 0; nt < 4; ++nt) acc[nt] = (f32x4){0.f, 0.f, 0.f, 0.f};
              const LAS bf16* ah = hhi + (lane & 15) * R6_HP + 128 * wave + 8 * (lane >> 4); const LAS bf16* al = hlo + (lane & 15) * R6_HP + 128 * wave + 8 * (lane >> 4);
#pragma unroll
              for (int ks = 0; ks < 4; ++ks) { const bf16x8 a_hi = *(const LAS bf16x8*)(ah + 32 * ks), a_lo = *(const LAS bf16x8*)(al + 32 * ks);
#pragma unroll
                  for (int nt = 0; nt < 4; ++nt) { acc[nt] = __builtin_amdgcn_mfma_f32_16x16x32_bf16(a_hi, bhi[ks][nt], acc[nt], 0, 0, 0);
                      acc[nt] = __builtin_amdgcn_mfma_f32_16x16x32_bf16(a_hi, blo[ks][nt], acc[nt], 0, 0, 0); acc[nt] = __builtin_amdgcn_mfma_f32_16x16x32_bf16(a_lo, bhi[ks][nt], acc[nt], 0, 0, 0); } }
#pragma unroll
              for (int nt = 0; nt < 4; ++nt)
#pragma unroll
                  for (int r = 0; r < 4; ++r) part[(wave * 16 + (lane >> 4) * 4 + r) * 64 + 16 * nt + (lane & 15)] = acc[nt][r]; }
            __syncthreads();
            SEC_E(62); SEC_B(63);
#pragma unroll
            for (int j2 = 0; j2 < 2; ++j2) { const int tl = 2 * wave + j2; float logit = 0.f;
#pragma unroll
                for (int ww = 0; ww < 8; ++ww) logit += part[(ww * 16 + tl) * 64 + lane];
                const float score = sigmoidf_(logit); const float sel = score + rbias;
                float m1 = sel; m1 = fmaxf(m1, __shfl_xor(m1, 1)); m1 = fmaxf(m1, __shfl_xor(m1, 2)); m1 = fmaxf(m1, __shfl_xor(m1, 4));
                const unsigned long long bm = __ballot(sel == m1) & (0xFFull << (lane & 56));
                const int first = __ffsll((long long)bm) - 1;
                float m2 = (lane == first) ? -INFINITY : sel; m2 = fmaxf(m2, __shfl_xor(m2, 1)); m2 = fmaxf(m2, __shfl_xor(m2, 2)); m2 = fmaxf(m2, __shfl_xor(m2, 4));
                const float gs = m1 + m2; const int grpi = lane >> 3; int grank = 0;
#pragma unroll
                for (int j = 0; j < 8; ++j) { const float gj = __shfl(gs, j * 8); grank += (gj > gs || (gj == gs && j < grpi)) ? 1 : 0; }
                const float selm = grank < 4 ? sel : -INFINITY; int rank = 0;
                const unsigned okey = ord_u32(selm);
#pragma unroll
                for (int j = 0; j < 64; ++j) cnt_lt_u32s(rank, okey, (unsigned)__builtin_amdgcn_readlane((int)okey, j));
                if (__popcll(__ballot(rank < TOPK)) != TOPK) {
                    rank = 0; const unsigned long long mykey = ((unsigned long long)okey << 8) | (unsigned)(63 - lane);
#pragma unroll 1
                    for (int j = 0; j < 64; ++j) { const unsigned long long kj = ((unsigned long long)(unsigned)__shfl((int)okey, j) << 8) | (unsigned)(63 - j); cnt_gt_u64(rank, kj, mykey); } }
                const bool chosen = rank < TOPK;
                const float wsum = wave_sum(chosen ? score : 0.f); const float wgt = score / wsum * 2.5f;
                const unsigned long long cm = __ballot(chosen); const int k = __popcll(cm & ((1ull << lane) - 1ull));
                if (chosen) { const int lpos = __hip_atomic_fetch_add(lcnt + lane, 1, __ATOMIC_RELAXED, __HIP_MEMORY_SCOPE_WORKGROUP);
                    LAS int* en = ent + ((sub * 16 + tl) * 8 + k) * 3; en[0] = lane; en[1] = lpos; en[2] = __builtin_bit_cast(int, wgt); } }
            __syncthreads();
            SEC_E(63);
        }
        SEC_B(64);
        if (tid < 64) gbase[tid] = (int)atomicAdd(cnt + 64 * tid, (unsigned)lcnt[tid]);
        __syncthreads();
        { const int tl = tid >> 3, k = tid & 7; const LAS int* en = ent + (tl * 8 + k) * 3; const int e = en[0], pos = gbase[e] + en[1], tok = tile * 64 + tl;
          LTOK[(size_t)e * T + pos] = tok; LW[(size_t)e * T + pos] = __builtin_bit_cast(float, en[2]); ROUTE[(size_t)tok * 8 + k] = ((unsigned)e << 16) | (unsigned)pos; }
        __syncthreads();
        SEC_E(64);
    }
}

__device__ __forceinline__ void moe_tables(const Ptrs& p, LAS int* tab, int v, int G) {
    const int tid = threadIdx.x;
    const unsigned* cnt = (const unsigned*)(p.ws + WS_CTL) + CW_CNT; const int* LTOK = (const int*)(p.ws + WS_LTOK);
    if (tid < 64) tab[66 + tid] = ((int)__hip_atomic_load(cnt + 64 * tid, __ATOMIC_RELAXED, __HIP_MEMORY_SCOPE_AGENT) + 255) >> 8;
    __syncthreads();
    if (tid == 0) { int s = 0; for (int e = 0; e < NE; ++e) { const int n = tab[66 + e]; tab[e] = s; s += n; } tab[NE] = s; tab[NE + 1] = s + T / 256; }
    __syncthreads();
    const int ntile = tab[NE + 1];
    int nu2 = 0, nu1 = 0;
    for (int i = 0; i < MOE_MAXU; ++i) { if ((long)i * G + v < 2 * ntile) nu2 = i + 1; if ((long)i * G + v < ntile) nu1 = i + 1; }
    if (tid < 16) { const int which = tid >> 3, i = tid & 7, nN = which ? 1 : 2, nu = which ? nu1 : nu2;
        if (i < nu) { const int L = i * G + v, tile = L / nN, pn = L % nN; int e = 0; while (tab[e + 1] <= tile) ++e;
            LAS int* u = tab + (which ? 192 : 128) + 4 * i; u[0] = tile; u[1] = pn; u[2] = e; u[3] = tile - tab[e]; } }
    if (tid == 0) { tab[126] = nu2; tab[127] = nu1; }
    __syncthreads();
    for (int idx = tid; idx < nu2 * 256; idx += NTHR) { const int i = idx >> 8, r = idx & 255, e = tab[130 + 4 * i], mt = tab[131 + 4 * i], pos = mt * 256 + r;
        tab[256 + idx] = e < NE ? (pos < (int)__hip_atomic_load(cnt + 64 * e, __ATOMIC_RELAXED, __HIP_MEMORY_SCOPE_AGENT) ? LTOK[(size_t)e * T + pos] : 0) : pos; }
    { const float* LW = (const float*)(p.ws + WS_LW);
      for (int idx = tid; idx < nu2 * 256; idx += NTHR) { const int i = idx >> 8, r = idx & 255, e = tab[130 + 4 * i], mt = tab[131 + 4 * i];
          ((LAS float*)tab)[1536 + idx] = e < NE ? LW[(size_t)e * T + mt * 256 + r] : 1.0f; } }
    __syncthreads();
}

__device__ __forceinline__ const bf16* yrow(const bf16* ylo, const bf16* yhi, size_t row) { return row < (size_t)YSPLIT ? ylo + row * 256 : yhi + (row - YSPLIT) * 256; }
__device__ __forceinline__ f32x4 combine_token(const Ptrs& p, LAS int* tab, int j, const bf16* ylo, const bf16* yhi, int tok, int lane) {
    const bf16* H1B = (const bf16*)(p.ws + WS_XB); const unsigned* ROUTE = (const unsigned*)(p.ws + WS_ROUTE);
    const u32x2 hv = *(const u32x2*)(H1B + (size_t)tok * D + 256 * j + 4 * lane);
    f32x4 a = {ALPHA * bflo(hv.x), ALPHA * bfhi(hv.x), ALPHA * bflo(hv.y), ALPHA * bfhi(hv.y)};
    { const u32x2 y = *(const u32x2*)(yrow(ylo, yhi, (size_t)tab[NE] * 256 + tok) + 4 * lane); a[0] += bflo(y.x); a[1] += bfhi(y.x); a[2] += bflo(y.y); a[3] += bfhi(y.y); }
#pragma unroll
    for (int k = 0; k < TOPK; ++k) { const unsigned r = ROUTE[(size_t)tok * 8 + k]; const size_t row = (size_t)tab[r >> 16] * 256 + (r & 0xffffu);
        const u32x2 y = *(const u32x2*)(yrow(ylo, yhi, row) + 4 * lane); a[0] += bflo(y.x); a[1] += bfhi(y.x); a[2] += bflo(y.y); a[3] += bfhi(y.y); }
    return a;
}
__device__ __forceinline__ void acc_row(f32x4& a, const bf16* rowp, int lane) { const u32x2 y = *(const u32x2*)(rowp + 4 * lane); a[0] += bflo(y.x); a[1] += bfhi(y.x); a[2] += bflo(y.y); a[3] += bfhi(y.y); }
__device__ __forceinline__ void phase_combine2(const Ptrs& p, LAS int* tab, int j, const bf16* alo, const bf16* ahi, const bf16* blo, const bf16* bhi, int vcu, int G) {
    const int tid = threadIdx.x, lane = tid & 63, wave = tid >> 6;
    bf16* H1B = (bf16*)(p.ws + WS_XB); const unsigned* ROUTE = (const unsigned*)(p.ws + WS_ROUTE);
    const int stride = G * NWAVES, sbase = tab[NE] * 256;
    for (int base = vcu * NWAVES + wave; base < T; base += 8 * stride) {
        int rowv = 0;
        { const int tl = base + (lane >> 3) * stride; if (tl < T) { const unsigned r = ROUTE[(size_t)tl * 8 + (lane & 7)]; rowv = tab[r >> 16] * 256 + (int)(r & 0xffffu); } }
#pragma unroll 2
        for (int i = 0; i < 8; ++i) { const int tok = base + i * stride; if (tok >= T) break;
            const u32x2 h0 = *(const u32x2*)(H1B + (size_t)tok * D + 256 * j + 4 * lane), h1v = *(const u32x2*)(H1B + (size_t)tok * D + 256 * (j + 1) + 4 * lane);
            f32x4 a = {ALPHA * bflo(h0.x), ALPHA * bfhi(h0.x), ALPHA * bflo(h0.y), ALPHA * bfhi(h0.y)}, c = {ALPHA * bflo(h1v.x), ALPHA * bfhi(h1v.x), ALPHA * bflo(h1v.y), ALPHA * bfhi(h1v.y)};
            acc_row(a, yrow(alo, ahi, (size_t)(sbase + tok)), lane); acc_row(c, yrow(blo, bhi, (size_t)(sbase + tok)), lane);
#pragma unroll
            for (int k = 0; k < TOPK; ++k) { const size_t row = (size_t)__builtin_amdgcn_readlane(rowv, i * 8 + k); acc_row(a, yrow(alo, ahi, row), lane); acc_row(c, yrow(blo, bhi, row), lane); }
            u32x2 o; o.x = cvt_pk_bf16(a[0], a[1]); o.y = cvt_pk_bf16(a[2], a[3]); *(u32x2*)(H1B + (size_t)tok * D + 256 * j + 4 * lane) = o;
            u32x2 q; q.x = cvt_pk_bf16(c[0], c[1]); q.y = cvt_pk_bf16(c[2], c[3]); *(u32x2*)(H1B + (size_t)tok * D + 256 * (j + 1) + 4 * lane) = q;
        }
    }
}
__device__ __forceinline__ void phase_ln2(const Ptrs& p, int vcu, int G) {
    const int tid = threadIdx.x, lane = tid & 63, wave = tid >> 6;
    const bf16* H1B = (const bf16*)(p.ws + WS_XB);
    const float* g2 = p.in[22]; const float* b2 = p.in[23];
#pragma unroll 2
    for (int tok = vcu * NWAVES + wave; tok < T; tok += G * NWAVES) {
        float* rowp = p.out + (size_t)tok * D;
        f32x4 v[4]; float s = 0.f;
#pragma unroll
        for (int jj = 0; jj < 4; ++jj) { const u32x2 pv = *(const u32x2*)(H1B + (size_t)tok * D + 256 * jj + 4 * lane); v[jj] = (f32x4){bflo(pv.x), bfhi(pv.x), bflo(pv.y), bfhi(pv.y)}; s += (v[jj][0] + v[jj][1]) + (v[jj][2] + v[jj][3]); }
        const float mean = wave_sum(s) * (1.0f / D); float s2 = 0.f;
#pragma unroll
        for (int jj = 0; jj < 4; ++jj) { v[jj] = v[jj] - mean; s2 += (v[jj][0] * v[jj][0] + v[jj][1] * v[jj][1]) + (v[jj][2] * v[jj][2] + v[jj][3] * v[jj][3]); }
        const float rstd = 1.0f / sqrtf(wave_sum(s2) * (1.0f / D) + 1e-5f);
#pragma unroll
        for (int jj = 0; jj < 4; ++jj) { const int c0 = 4 * lane + 256 * jj; *(f32x4*)(rowp + c0) = v[jj] * rstd * *(const f32x4*)(g2 + c0) + *(const f32x4*)(b2 + c0); }
    }
}
#define XB_TMO      128
#define XB_XCNT(j)  (256  + 64 * (j))
#define XB_XSUB(j)  (1280 + 64 * (j))
#define XB_XGEN(j)  (2304 + 64 * (j))
#define XB_TOP      3328
#define XB_TOPGEN   3392
#define XCD_BAR_WORDS 3456
#define XB_SPIN_CAP (1u << 18)
__device__ __forceinline__ unsigned xb_ld(unsigned* p)              { return __hip_atomic_load(p, __ATOMIC_RELAXED, __HIP_MEMORY_SCOPE_AGENT); }
__device__ __forceinline__ unsigned xb_add(unsigned* p, unsigned v) { return __hip_atomic_fetch_add(p, v, __ATOMIC_RELAXED, __HIP_MEMORY_SCOPE_AGENT); }
__device__ __forceinline__ unsigned xb_xcc_id() { return (unsigned)__builtin_amdgcn_s_getreg((3 << 11) | 20) & 0xFu; }
#define XB_SPIN(cond, bar) do { unsigned _sp = 0; while (cond) { __builtin_amdgcn_s_sleep(1); \
    if ((++_sp & 255u) == 0u) { if (xb_ld(&(bar)[XB_TMO])) break; if (_sp > XB_SPIN_CAP) { atomicAdd(&(bar)[XB_TMO], 1u); break; } } } } while (0)
struct XcdBarrier { unsigned* bar; unsigned x; volatile LAS unsigned* st; };
__device__ __forceinline__ XcdBarrier xcd_barrier_post(unsigned* bar, volatile LAS unsigned* st) {
    XcdBarrier b; b.bar = bar; b.x = xb_xcc_id(); b.st = st;
    if (threadIdx.x == 0) (void)xb_add(&bar[XB_XCNT(b.x)], 1u);
    return b;
}
__device__ __forceinline__ void xcd_barrier_complete(unsigned* bar, unsigned x, unsigned& nloc, unsigned& nx) {
    const unsigned G = gridDim.x * gridDim.y * gridDim.z;
    unsigned sum, cnt, mine, sp = 0u;
    for (;;) {
        sum = 0u; cnt = 0u; mine = 0u;
#pragma unroll
        for (unsigned j = 0; j < 16; ++j) { const unsigned c = xb_ld(&bar[XB_XCNT(j)]); sum += c; cnt += (c > 0u) ? 1u : 0u; mine = (j == x) ? c : mine; }
        if (sum == G) break;
        __builtin_amdgcn_s_sleep(1);
        if ((++sp & 255u) == 0u) { if (xb_ld(&bar[XB_TMO])) break; if (sp > XB_SPIN_CAP) { atomicAdd(&bar[XB_TMO], 1u); break; } }
    }
    nloc = mine > 0u ? mine : 1u; nx = cnt > 0u ? cnt : 1u;
}
__device__ __forceinline__ void xcd_barrier(const XcdBarrier& b) {
    asm volatile("s_waitcnt vmcnt(0)" ::: "memory");
    __syncthreads();
    if (threadIdx.x == 0) {
        unsigned* bar = b.bar;
        __builtin_amdgcn_s_waitcnt(0);
        unsigned nloc = b.st[0], nx = b.st[1];
        if (nloc == 0u) { xcd_barrier_complete(bar, b.x, nloc, nx); b.st[0] = nloc; b.st[1] = nx; }
        const unsigned old = xb_add(&bar[XB_XSUB(b.x)], 1u);
        const unsigned gen = old / nloc;
        if (old + 1u == (gen + 1u) * nloc) {
            __builtin_amdgcn_fence(__ATOMIC_RELEASE, "agent");
            asm volatile("s_waitcnt vmcnt(0)" ::: "memory");
            const unsigned og = xb_add(&bar[XB_TOP], 1u);
            const unsigned tg = og / nx;
            if (og + 1u == (tg + 1u) * nx) xb_add(&bar[XB_TOPGEN], 1u);
            else XB_SPIN(xb_ld(&bar[XB_TOPGEN]) == tg, bar);
            __builtin_amdgcn_fence(__ATOMIC_ACQUIRE, "agent");
            xb_add(&bar[XB_XGEN(b.x)], 1u);
            asm volatile("s_waitcnt vmcnt(0)" ::: "memory");
        } else {
            XB_SPIN(xb_ld(&bar[XB_XGEN(b.x)]) == gen, bar);
            __builtin_amdgcn_fence(__ATOMIC_ACQUIRE, "agent");
            asm volatile("s_waitcnt vmcnt(0)" ::: "memory");
        }
    }
    __syncthreads();
}

__device__ __forceinline__ void probe_between(const XcdBarrier& bar, int k, unsigned* cnt) {
    xcd_barrier(bar);
    if (k == 6) { if (blockIdx.x == 0 && threadIdx.x < 64) cnt[threadIdx.x] = 0u; xcd_barrier(bar); }
}
__device__ __forceinline__ const Ptrs* kargs() { auto k = __builtin_amdgcn_kernarg_segment_ptr(); asm volatile("" : "+s"(k)); return (const Ptrs*)k; }
constexpr int NPH = 13;
struct Args { Ptrs p; int ph_lo, ph_hi; };
__global__ void __launch_bounds__(NTHR, 2) mk_fwd(Args args) {
    extern __shared__ __attribute__((aligned(16))) unsigned char lds_raw[];
    LAS unsigned char* lds = (LAS unsigned char*)lds_raw;
    volatile LAS unsigned* MISC = (volatile LAS unsigned*)(lds + MISC_OFF);
    LAS int* tab = (LAS int*)(lds + TAB_OFF);
    const int tid = threadIdx.x, lane = tid & 63, wave = __builtin_amdgcn_readfirstlane(tid >> 6);
    const int G = gridDim.x, bx = blockIdx.x, vcu = (G % 8 == 0) ? (bx % 8) * (G / 8) + bx / 8 : bx;
    if (tid < 32) MISC[tid] = 0u;
    __syncthreads();
    XcdBarrier bar; bar.bar = (unsigned*)(kargs()->ws + WS_CTL) + CW_BAR; bar.x = 0; bar.st = nullptr;
    if (MK_N_LAUNCHES == 1) bar = xcd_barrier_post((unsigned*)(kargs()->ws + WS_CTL) + CW_BAR, MISC + 8);
    const int lo = args.ph_lo, hi = args.ph_hi;
#ifndef PHMASK
#define PHMASK 0x1FFFF
#endif
#define IN(k) (((PHMASK >> (k)) & 1) && lo <= (k) && (k) < hi)
#define SEAM(k) do { if (IN(k) && IN((k) + 1)) { SEC_B(99); xcd_barrier(bar); SEC_E(99); } } while (0)
#ifndef PROBE_REP
#define PROBE_REP 0
#endif
#define REPEAT(k) for (int rep_ = 0; rep_ <= ((PROBE_REP >> (k)) & 1); ++rep_, ((PROBE_REP >> (k)) & 1) ? probe_between(bar, (k), (unsigned*)(kargs()->ws + WS_CTL) + CW_CNT) : (void)0)

    if (IN(0)) REPEAT(0) { const Ptrs& p = *kargs(); unsigned char* const ws = p.ws; (void)ws; phase_prep(p, lds, vcu, G); } SEAM(0);

    if (IN(1)) REPEAT(1) { const Ptrs& p = *kargs(); unsigned char* const ws = p.ws; (void)ws;
        DenseSched S; S.init(T, DINP, D, D, (const bf16*)(ws + WS_XB), (const bf16*)(ws + WS_WIN), G, bx);
        EpiProj E{(bf16*)(ws + WS_P), (float*)(ws + WS_RSQ), (float*)(ws + WS_RSKV)};
        pg8::gemm_phase<EpiProj, DenseSched, false>(lds, D, D, S, E);
        { const int nfull = (T / 256) * (DINP / 256) - 2 * G;
          if (G == 256 && bx >= nfull) phase_convert_down(p, lds, bx - nfull, G - nfull); else if (G != 256) phase_convert_down(p, lds, bx, G); }
    } SEAM(1);

    if (IN(2)) REPEAT(2) { const Ptrs& p = *kargs(); unsigned char* const ws = p.ws; (void)ws;
        DenseSched S; S.init(T, NUP, KUP, DINP, (const bf16*)(ws + WS_P) + 2048, (const bf16*)(ws + WS_WUP), G, bx); S.asplit = 3; S.ashift = 256 * 2;
        { pg8::Unit uu;
          for (int i = 0; S.next(i, uu); ++i) { const bool isq = uu.pn < 3;
              if (tid < 256) { const f32x4 pr = *(const f32x4*)((const float*)(ws + (isq ? WS_RSQ : WS_RSKV)) + (size_t)(uu.pm * 256 + tid) * 4);
                  ((LAS float*)tab)[256 * i + tid] = __builtin_amdgcn_rsqf(((pr[0] + pr[1]) + (pr[2] + pr[3])) * (isq ? (1.0f / 256.0f) : (1.0f / 128.0f)) + 1e-6f); } }
          __syncthreads(); }
        EpiUp E{(bf16*)(ws + WS_Q), (bf16*)(ws + WS_QI), (bf16*)(ws + WS_K), (bf16*)(ws + WS_VT), (LAS const float*)tab};
        SEC_B(20); pg8::gemm_phase<EpiUp, DenseSched, false>(lds, KUP, DINP, S, E); SEC_E(20);
        SEC_B(21); phase_kidx(p, vcu, G); SEC_E(21);
        SEC_B(22); hgrn_lb_to_lds(p, lds); { HgIn nx = hg_load<1>(p, vcu < 1024 ? vcu : 0); for (int item = vcu; item < 1024; item += G) { const HgIn cur = nx; if (item + G < 1024) nx = hg_load<1>(p, item + G); hgrn1_item(p, item, lds, cur); } } SEC_E(22);
    } SEAM(2);

    if (IN(3)) REPEAT(3) { const Ptrs& p = *kargs(); unsigned char* const ws = p.ws; (void)ws;
        for (int L = vcu; L < 1024; L += G) { const int i = L >> 8, idx = L & 255, b = idx >> 5, j = idx & 31;
            const int qg = (i == 0) ? j : (i == 1) ? 63 - j : (i == 2) ? 64 + j : 127 - j;
            indexer_item(p, b * 128 + qg, lds); }
        SEC_B(31); phase_scan(p, vcu, G); SEC_E(31);
    } SEAM(3);

    if (IN(4)) REPEAT(4) { const Ptrs& p = *kargs(); unsigned char* const ws = p.ws; (void)ws;
        for (int pr = vcu; pr < 256; pr += G) { const int b = pr >> 5, h = (pr >> 2) & 7, j = pr & 3;
            SEC_B(40); attn_unit(p, b, h, 7 - j, lds); attn_unit(p, b, h, j, lds); SEC_E(40); }
        SEC_B(41); hgrn_lb_to_lds(p, lds); { HgIn nx = hg_load<3>(p, vcu < 1024 ? vcu : 0); for (int item = vcu; item < 1024; item += G) { const HgIn cur = nx; if (item + G < 1024) nx = hg_load<3>(p, item + G); hgrn3_item(p, item, lds, cur); } } SEC_E(41);
    } SEAM(4);

    if (IN(5)) REPEAT(5) { const Ptrs& p = *kargs(); unsigned char* const ws = p.ws; (void)ws;
        DenseSched S; S.init(T, D, D, D, (const bf16*)(ws + WS_XB), (const bf16*)(ws + WS_WOUT), G, bx);
        EpiOut E{p.in[0], (float*)(ws + WS_HB)};
        SEC_B(50); pg8::gemm_phase<EpiOut, DenseSched, false>(lds, D, D, S, E); SEC_E(50);
        SEC_B(51); phase_convert_gu(p, lds, vcu, G); SEC_E(51);
    } SEAM(5);

    if (IN(6)) REPEAT(6) { const Ptrs& p = *kargs(); unsigned char* const ws = p.ws; (void)ws; phase_ln1_router(p, lds, vcu, G); } SEAM(6);

    bool tab_ready = false;
#define MOE_TAB() do { if (!tab_ready) { moe_tables(p, tab, vcu, G); tab_ready = true; } } while (0)
    if (IN(7)) REPEAT(7) { const Ptrs& p = *kargs(); unsigned char* const ws = p.ws; (void)ws;
        MOE_TAB();
        MoeSched S{tab, 128, tab[126], (const char*)(ws + WS_XB), (const char*)(ws + WS_WGU), (size_t)0, (size_t)512 * D * 2, (size_t)256 * D * 2};
        EpiGU E{(bf16*)(ws + WS_HB)};
        pg8::gemm_phase<EpiGU, MoeSched, true>(lds, D, D, S, E);
    } SEAM(7);

#define YA_LO ((bf16*)p.out)
#define YA_HI ((bf16*)(ws + WS_YT))
#define YB_LO ((bf16*)(ws + WS_Y))
#define YB_HI ((bf16*)(ws + WS_Y) + (size_t)YSPLIT * 256)
#define DOWN_GEMM2(jj) do { \
        MoeSched S{tab, 128, tab[126], (const char*)(ws + WS_HB), (const char*)(ws + WS_WD) + (size_t)(2 * (jj)) * 256 * DE * 2, (size_t)256 * DE * 2, (size_t)D * DE * 2, (size_t)256 * DE * 2}; \
        EpiDown E{YA_LO, YA_HI, YB_LO, YB_HI, (LAS const float*)(tab + 1536)}; \
        pg8::gemm_phase<EpiDown, MoeSched, false>(lds, DE, DE, S, E); } while (0)
    if (IN(8)) { const Ptrs& p = *kargs(); unsigned char* const ws = p.ws; MOE_TAB(); DOWN_GEMM2(0); } SEAM(8);
    if (IN(9)) { const Ptrs& p = *kargs(); unsigned char* const ws = p.ws; MOE_TAB(); phase_combine2(p, tab, 0, YA_LO, YA_HI, YB_LO, YB_HI, vcu, G); } SEAM(9);
    if (IN(10)) { const Ptrs& p = *kargs(); unsigned char* const ws = p.ws; MOE_TAB(); DOWN_GEMM2(1); } SEAM(10);
    if (IN(11)) { const Ptrs& p = *kargs(); unsigned char* const ws = p.ws; MOE_TAB(); phase_combine2(p, tab, 2, YA_LO, YA_HI, YB_LO, YB_HI, vcu, G); } SEAM(11);
    if (IN(12)) { const Ptrs& p = *kargs(); phase_ln2(p, vcu, G); }
#undef IN
#undef SEAM
}

extern "C" void kernel_launch(void* const* d_in, const int* in_sizes, int n_in, void* d_out, int out_size, void* d_ws, size_t ws_size, hipStream_t stream) {
    static int grid = 0;
    if (grid == 0) {
        if (n_in != 24 || out_size != T * D || ws_size < WS_END) { fprintf(stderr, "kernel_launch: unexpected problem (n_in %d, out %d, ws %zu)\n", n_in, out_size, ws_size); grid = -1; return; }
        int dev = 0, cus = 0, per_cu = 0;
        if (hipGetDevice(&dev) != hipSuccess || hipDeviceGetAttribute(&cus, hipDeviceAttributeMultiprocessorCount, dev) != hipSuccess) { grid = -1; return; }
        if (hipFuncSetAttribute((const void*)mk_fwd, hipFuncAttributeMaxDynamicSharedMemorySize, LDS_BYTES) != hipSuccess) { fprintf(stderr, "kernel_launch: hipFuncSetAttribute failed\n"); grid = -1; return; }
        if (hipOccupancyMaxActiveBlocksPerMultiprocessor(&per_cu, (const void*)mk_fwd, NTHR, LDS_BYTES) != hipSuccess || per_cu < 1) { fprintf(stderr, "kernel_launch: occupancy query says %d blocks per CU\n", per_cu); }
        (void)hipGetLastError();
        grid = cus;
    }
    if (grid < 0) return;
    (void)hipMemsetAsync((char*)d_ws + WS_CTL, 0, CTL_ZERO_BYTES, stream);
    Args a{};
    for (int i = 0; i < 24; ++i) a.p.in[i] = (const float*)d_in[i];
    a.p.out = (float*)d_out; a.p.ws = (unsigned char*)d_ws;
    if (MK_N_LAUNCHES == 1) { a.ph_lo = 0; a.ph_hi = NPH; hipLaunchKernelGGL(mk_fwd, dim3(grid), dim3(NTHR), LDS_BYTES, stream, a); }
    else for (int ph = 0; ph < NPH; ++ph) { a.ph_lo = ph; a.ph_hi = ph + 1; hipLaunchKernelGGL(mk_fwd, dim3(grid), dim3(NTHR), LDS_BYTES, stream, a); }
}
```
